# Optimizing an MI355X kernel written in HIP

```python
import math
import jax, jax.numpy as jnp
from jax import lax
import numpy as np

D_MODEL = 1024
BATCH = 8
SEQ = 4096
DEPTH = 1

HG_HEADS = 4
HG_DK = 128
HG_DV = 128
HG_WIDTH = HG_HEADS * HG_DK
HG_CHUNK = 64
DA_HEADS = 4
DA_HEAD = 64
DA_VDIM = 2 * DA_HEAD
DA_QK_WIDTH = DA_HEADS * 2 * DA_HEAD
DA_WIDTH = DA_HEADS * DA_VDIM
Q_BLOCK = 128
ROPE_THETA = 10000.0
N_GROUPS = 4
EXPERTS_PER_GROUP = 8
N_EXPERTS = N_GROUPS * EXPERTS_PER_GROUP
TOP_K = 2
D_FF_EXPERT = 512
MOE_BLOCK = 128
EPS = 1e-6
IN_COLS = 4 * HG_WIDTH + 2 * DA_QK_WIDTH + DA_WIDTH + 2 * D_MODEL

kernel_name = "hybrid_hgrn2_diffattn_hiermoe"


def rms_norm(x, gain):
    xf = x.astype(jnp.float32)
    y = xf * lax.rsqrt(jnp.mean(xf * xf, axis=-1, keepdims=True) + EPS)
    return (y * gain.astype(jnp.float32)).astype(x.dtype)


def rope(x, pos):
    half = x.shape[-1] // 2
    inv = ROPE_THETA ** (-jnp.arange(half, dtype=jnp.float32) / half)
    ang = pos.astype(jnp.float32)[:, None] * inv[None, :]
    cos = jnp.cos(ang)[None, :, None, :]
    sin = jnp.sin(ang)[None, :, None, :]
    x1, x2 = x[..., :half].astype(jnp.float32), x[..., half:].astype(jnp.float32)
    return jnp.concatenate([x1 * cos - x2 * sin, x1 * sin + x2 * cos], axis=-1).astype(x.dtype)


def hgrn2_chunked(q, k, v, log_f):
    B, S, H, DK = q.shape
    DV = v.shape[-1]
    C = HG_CHUNK
    NC = S // C

    def to_chunks(t):
        return t.astype(jnp.float32).reshape(B, NC, C, H, t.shape[-1]).transpose(1, 0, 3, 2, 4)

    qc, kc, vc, gc = to_chunks(q), to_chunks(k), to_chunks(v), to_chunks(log_f)
    causal = jnp.tril(jnp.ones((C, C), dtype=bool))

    def step(state, inp):
        qi, ki, vi, gi = inp
        b = jnp.cumsum(gi, axis=-2)
        b_ref = b[..., C // 2 - 1:C // 2, :]
        q_rel = qi * jnp.exp(b - b_ref)
        k_rel = ki * jnp.exp(b_ref - b)
        scores = jnp.einsum('bhtk,bhsk->bhts', q_rel, k_rel)
        scores = jnp.where(causal, scores, 0.0)
        o = (jnp.einsum('bhts,bhsv->bhtv', scores, vi)
             + jnp.einsum('bhtk,bhkv->bhtv', qi * jnp.exp(b), state))
        b_end = b[..., -1:, :]
        k_end = ki * jnp.exp(b_end - b)
        new_state = (jnp.exp(b_end[..., 0, :])[..., None] * state
                     + jnp.einsum('bhsk,bhsv->bhkv', k_end, vi))
        return new_state, o

    state0 = jnp.zeros((B, H, DK, DV), jnp.float32)
    _, o = lax.scan(step, state0, (qc, kc, vc, gc))
    return o.transpose(1, 0, 3, 2, 4).reshape(B, S, H, DV)


def diff_attention(q1, q2, k1, k2, v, lam):
    B, S, H, D = q1.shape
    NQ = S // Q_BLOCK
    scale = D ** -0.5
    key_pos = jnp.arange(S)

    def block(i):
        start = i * Q_BLOCK
        qb1 = lax.dynamic_slice_in_dim(q1, start, Q_BLOCK, axis=1)
        qb2 = lax.dynamic_slice_in_dim(q2, start, Q_BLOCK, axis=1)
        qpos = start + jnp.arange(Q_BLOCK)
        mask = key_pos[None, :] <= qpos[:, None]

        def probs(qb, kk):
            s = jnp.einsum('bqhd,bshd->bhqs', qb, kk).astype(jnp.float32) * scale
            return jax.nn.softmax(jnp.where(mask, s, -jnp.inf), axis=-1)

        a = probs(qb1, k1) - lam * probs(qb2, k2)
        return jnp.einsum('bhqs,bshv->bqhv', a.astype(v.dtype), v)

    o = lax.map(block, jnp.arange(NQ))
    return o.transpose(1, 0, 2, 3, 4).reshape(B, S, H, v.shape[-1])


def hier_moe(xn, w_rg, b_rg, w_re, b_re, w1, w3, w2):
    B, S, D = xn.shape
    T = B * S
    xt = xn.reshape(T, D)
    g_logits = (xt @ w_rg).astype(jnp.float32) + b_rg.astype(jnp.float32)
    g_sel = jnp.argmax(g_logits, axis=-1)
    g_w = jnp.max(jax.nn.softmax(g_logits, axis=-1), axis=-1, keepdims=True)
    e_logits = ((xt @ w_re).astype(jnp.float32) + b_re.astype(jnp.float32)).reshape(
        T, N_GROUPS, EXPERTS_PER_GROUP)
    e_in_group = jnp.sum(e_logits * jax.nn.one_hot(g_sel, N_GROUPS, dtype=jnp.float32)[:, :, None], axis=1)
    top_v, top_i = lax.top_k(e_in_group, TOP_K)
    e_w = jax.nn.softmax(top_v, axis=-1) * g_w

    A = T * TOP_K
    expert_id = (g_sel[:, None] * EXPERTS_PER_GROUP + top_i).reshape(A).astype(jnp.int32)
    token_id = jnp.repeat(jnp.arange(T, dtype=jnp.int32), TOP_K)
    weight = e_w.reshape(A)

    order = jnp.argsort(expert_id)
    se = expert_id[order]
    counts = jnp.zeros((N_EXPERTS,), jnp.int32).at[expert_id].add(1)
    padded = (counts + MOE_BLOCK - 1) // MOE_BLOCK * MOE_BLOCK
    pad_end = jnp.cumsum(padded)
    pad_start = pad_end - padded
    start = jnp.cumsum(counts) - counts
    dest = pad_start[se] + jnp.arange(A, dtype=jnp.int32) - start[se]
    P = A + N_EXPERTS * MOE_BLOCK
    NB = P // MOE_BLOCK
    buf_tok = jnp.full((P,), T, jnp.int32).at[dest].set(token_id[order])
    buf_w = jnp.zeros((P,), jnp.float32).at[dest].set(weight[order])
    block_start = jnp.arange(NB, dtype=jnp.int32) * MOE_BLOCK
    block_expert = jnp.minimum(
        jnp.sum(pad_end[None, :] <= block_start[:, None], axis=1), N_EXPERTS - 1).astype(jnp.int32)
    x_pad = jnp.concatenate([xt, jnp.zeros((1, D), xt.dtype)], axis=0)

    def run_block(args):
        tok, w, e = args
        xb = x_pad[tok]
        hid = jax.nn.silu(xb @ w1[e]) * (xb @ w3[e])
        return (hid @ w2[e]) * w[:, None].astype(xb.dtype)

    y = lax.map(run_block, (buf_tok.reshape(NB, MOE_BLOCK), buf_w.reshape(NB, MOE_BLOCK), block_expert))
    out = jnp.zeros((T + 1, D), xt.dtype).at[buf_tok].add(y.reshape(P, D))
    return out[:T].reshape(B, S, D)


def setup_inputs(seed: int = 0) -> dict:
    key = jax.random.key(seed)
    ks = jax.random.split(key, 20)

    def nrm(k, shape, scale):
        return jax.random.normal(k, shape, jnp.float32) * scale

    def gain(k, shape):
        return 1.0 + nrm(k, shape, 0.02)

    return {
        "x": nrm(ks[0], (BATCH, SEQ, D_MODEL), 1.0),
        "norm_mix": gain(ks[1], (DEPTH, D_MODEL)),
        "w_in": nrm(ks[2], (DEPTH, D_MODEL, IN_COLS), D_MODEL ** -0.5),
        "hg_lb": nrm(ks[3], (DEPTH + 1, HG_WIDTH), 0.1),
        "hg_out_norm": gain(ks[4], (DEPTH, HG_DV)),
        "da_q_norm": gain(ks[5], (DEPTH, DA_HEAD)),
        "da_k_norm": gain(ks[6], (DEPTH, DA_HEAD)),
        "da_lambda": nrm(ks[7], (DEPTH, 4, DA_HEAD), 0.1),
        "da_out_norm": gain(ks[8], (DEPTH, DA_VDIM)),
        "w_branch_hg": nrm(ks[9], (DEPTH, HG_WIDTH, D_MODEL), HG_WIDTH ** -0.5),
        "w_branch_da": nrm(ks[10], (DEPTH, DA_WIDTH, D_MODEL), DA_WIDTH ** -0.5),
        "w_out": nrm(ks[11], (DEPTH, D_MODEL, D_MODEL), D_MODEL ** -0.5),
        "norm_moe": gain(ks[12], (DEPTH, D_MODEL)),
        "w_router_group": nrm(ks[13], (DEPTH, D_MODEL, N_GROUPS), D_MODEL ** -0.5),
        "b_router_group": nrm(ks[14], (DEPTH, N_GROUPS), 0.01),
        "w_router_expert": nrm(ks[15], (DEPTH, D_MODEL, N_EXPERTS), D_MODEL ** -0.5),
        "b_router_expert": nrm(ks[16], (DEPTH, N_EXPERTS), 0.01),
        "w1": nrm(ks[17], (DEPTH, N_EXPERTS, D_MODEL, D_FF_EXPERT), D_MODEL ** -0.5),
        "w3": nrm(ks[18], (DEPTH, N_EXPERTS, D_MODEL, D_FF_EXPERT), D_MODEL ** -0.5),
        "w2": nrm(ks[19], (DEPTH, N_EXPERTS, D_FF_EXPERT, D_MODEL), D_FF_EXPERT ** -0.5),
    }


def reference(x, norm_mix, w_in, hg_lb, hg_out_norm, da_q_norm, da_k_norm, da_lambda,
              da_out_norm, w_branch_hg, w_branch_da, w_out, norm_moe, w_router_group,
              b_router_group, w_router_expert, b_router_expert, w1, w3, w2):
    B, S, _ = x.shape
    pos = jnp.arange(S)
    widths = [HG_WIDTH] * 4 + [DA_QK_WIDTH, DA_QK_WIDTH, DA_WIDTH, D_MODEL, D_MODEL]
    splits = [int(v) for v in np.cumsum(widths)[:-1]]
    lb_all = jnp.cumsum(jax.nn.softmax(hg_lb.astype(jnp.float32), axis=0), axis=0)

    for l in range(DEPTH):
        h = rms_norm(x, norm_mix[l])
        proj = h @ w_in[l]
        hq, hf, hi, hog, dq, dk, dv, gate_hg, gate_da = jnp.split(proj, splits, axis=-1)

        lb = lb_all[l]
        f = lb + (1.0 - lb) * jax.nn.sigmoid(hf.astype(jnp.float32))
        heads_hg = lambda t: t.reshape(B, S, HG_HEADS, t.shape[-1] // HG_HEADS)
        o_hg = hgrn2_chunked(heads_hg(hq), heads_hg(1.0 - f), heads_hg(hi), heads_hg(jnp.log(f)))
        o_hg = rms_norm(o_hg, hg_out_norm[l]) * jax.nn.silu(heads_hg(hog).astype(jnp.float32))
        y_hg = o_hg.reshape(B, S, HG_WIDTH).astype(x.dtype) @ w_branch_hg[l]

        qn = rope(rms_norm(dq.reshape(B, S, 2 * DA_HEADS, DA_HEAD), da_q_norm[l]), pos)
        kn = rope(rms_norm(dk.reshape(B, S, 2 * DA_HEADS, DA_HEAD), da_k_norm[l]), pos)
        qn = qn.reshape(B, S, DA_HEADS, 2, DA_HEAD)
        kn = kn.reshape(B, S, DA_HEADS, 2, DA_HEAD)
        v = dv.reshape(B, S, DA_HEADS, DA_VDIM)
        lam_p = da_lambda[l].astype(jnp.float32)
        lam_init = 0.8 - 0.6 * math.exp(-0.3 * l)
        lam = jnp.exp(jnp.sum(lam_p[0] * lam_p[1])) - jnp.exp(jnp.sum(lam_p[2] * lam_p[3])) + lam_init
        o_da = diff_attention(qn[..., 0, :], qn[..., 1, :], kn[..., 0, :], kn[..., 1, :], v, lam)
        o_da = rms_norm(o_da, da_out_norm[l]) * (1.0 - lam_init)
        y_da = o_da.reshape(B, S, DA_WIDTH).astype(x.dtype) @ w_branch_da[l]

        mixed = jax.nn.sigmoid(gate_hg) * y_hg + jax.nn.sigmoid(gate_da) * y_da
        x = x + (mixed @ w_out[l]).astype(x.dtype)

        x = x + hier_moe(rms_norm(x, norm_moe[l]), w_router_group[l], b_router_group[l],
                         w_router_expert[l], b_router_expert[l], w1[l], w3[l], w2[l]).astype(x.dtype)
    return x
```

```cpp
#include <hip/hip_runtime.h>
#include <cstdio>
#include <cstdint>

#define GAS __attribute__((address_space(1)))
#define LAS __attribute__((address_space(3)))
typedef unsigned short bf16;
typedef unsigned v4u __attribute__((ext_vector_type(4)));
typedef unsigned v2u __attribute__((ext_vector_type(2)));
typedef float f32x4 __attribute__((ext_vector_type(4)));
typedef float f32x2 __attribute__((ext_vector_type(2)));
typedef float f32x16 __attribute__((ext_vector_type(16)));
typedef short bf16x8 __attribute__((ext_vector_type(8)));
typedef short s16x4 __attribute__((ext_vector_type(4)));
typedef __bf16 bf16x2_t __attribute__((ext_vector_type(2)));

constexpr int NB = 8, SEQ = 4096, DM = 1024, NT = NB * SEQ;
constexpr int NCOLS = 5632;
constexpr int NEXP = 32, DFF = 512;
constexpr float EPS = 1e-6f;
constexpr float LOG2E = 1.4426950408889634f;
constexpr int RCAP = NT;

constexpr size_t MiB = 1u << 20;
constexpr size_t WS_CTL = 0, CTL_ZERO_BYTES = 1 * MiB;
constexpr size_t WS_SMALL = 1 * MiB;
constexpr size_t WS_ROPE = 2 * MiB;
constexpr size_t WS_WHG = 3 * MiB, WS_WDA = 4 * MiB, WS_WOUT = 5 * MiB;
constexpr size_t WS_WIN = 7 * MiB;
constexpr size_t WS_W2T = 18 * MiB;
constexpr size_t WS_H = 50 * MiB;
constexpr size_t WS_W13T = WS_H;
constexpr size_t WS_HQ = 114 * MiB, WS_HF = 146 * MiB, WS_HI = 178 * MiB, WS_HOG = 210 * MiB;
constexpr size_t WS_MIXED = 114 * MiB;
constexpr size_t WS_XN = 178 * MiB;
constexpr size_t WS_Y = 114 * MiB;
constexpr size_t WS_YS = 50 * MiB;
constexpr size_t WS_TOKPOS = 322 * MiB;
constexpr size_t WS_QT = 242 * MiB, WS_KIMG = 274 * MiB, WS_VIMG = 306 * MiB;
constexpr size_t WS_HID = 242 * MiB;
constexpr size_t WS_ROWTOK = 306 * MiB;
constexpr size_t WS_WT = 314 * MiB;
constexpr size_t WS_DST = 338 * MiB;
constexpr size_t WS_DECAY = 402 * MiB;
constexpr size_t WS_OHG = 403 * MiB, WS_ODA = 435 * MiB;
constexpr size_t WS_END = 467 * MiB;
constexpr int CW_BAR = 4096;
constexpr int CW_GCNT = 16384;
constexpr int CW_GRP = 20480;

__device__ __forceinline__ unsigned f2bf(float f) { unsigned u = __float_as_uint(f); return (u + 0x7fffu + ((u >> 16) & 1u)) >> 16; }
__device__ __forceinline__ float bf2f(unsigned short b) { return __uint_as_float((unsigned)b << 16); }
__device__ __forceinline__ unsigned cvtpk(float lo, float hi) { f32x2 v = {lo, hi}; bf16x2_t b = __builtin_convertvector(v, bf16x2_t); return __builtin_bit_cast(unsigned, b); }
__device__ __forceinline__ v4u pack8(const f32x4 a, const f32x4 b) { v4u w; w.x = cvtpk(a[0], a[1]); w.y = cvtpk(a[2], a[3]); w.z = cvtpk(b[0], b[1]); w.w = cvtpk(b[2], b[3]); return w; }
__host__ __device__ __forceinline__ unsigned off_b(unsigned row, unsigned ch) { return 256u * row + 16u * (ch ^ (((row & 3u) << 2) | ((row >> 2) & 3u))); }
__host__ __device__ __forceinline__ unsigned img_off(unsigned row, unsigned col) { return off_b(row, col >> 3) + (col & 7u) * 2u; }
__host__ __device__ __forceinline__ unsigned off_a(unsigned row, unsigned ch) { return 2048u * (row >> 3) + 512u * (ch >> 2) + 64u * (row & 7u) + 16u * ((ch & 3u) ^ ((row >> 2) & 3u)); }
__host__ __device__ __forceinline__ unsigned img_off_a(unsigned row, unsigned col) { return off_a(row, col >> 3) + (col & 7u) * 2u; }
__host__ __device__ __forceinline__ unsigned kappa(unsigned r) { return (r & ~12u) | ((r & 4u) << 1) | ((r & 8u) >> 1); }
template <int M> __device__ __forceinline__ float swz_xor(float v) { return __int_as_float(__builtin_amdgcn_ds_swizzle(__float_as_int(v), (M << 10) | 0x1f)); }
__device__ __forceinline__ float wave_sum(float v) {
    v += swz_xor<1>(v); v += swz_xor<2>(v); v += swz_xor<4>(v); v += swz_xor<8>(v); v += swz_xor<16>(v);
    { auto rr = __builtin_amdgcn_permlane32_swap(__float_as_uint(v), __float_as_uint(v), false, false); v = __uint_as_float(rr[0]) + __uint_as_float(rr[1]); }
    return v;
}
__device__ __forceinline__ float wave_max(float v) {
    v = fmaxf(v, swz_xor<1>(v)); v = fmaxf(v, swz_xor<2>(v)); v = fmaxf(v, swz_xor<4>(v)); v = fmaxf(v, swz_xor<8>(v)); v = fmaxf(v, swz_xor<16>(v));
    { auto rr = __builtin_amdgcn_permlane32_swap(__float_as_uint(v), __float_as_uint(v), false, false); v = fmaxf(__uint_as_float(rr[0]), __uint_as_float(rr[1])); }
    return v;
}
extern __shared__ __attribute__((aligned(16))) unsigned char lds_raw[];
constexpr int LDS_BYTES = 159744;
constexpr int MISC_OFF = LDS_BYTES - 512;
__device__ __forceinline__ int wave_idx() { const unsigned k = (unsigned)__builtin_amdgcn_s_getreg((5 << 11) | 4) & 63u;
    return __builtin_amdgcn_readfirstlane(*(volatile LAS int*)((LAS unsigned char*)lds_raw + MISC_OFF + 256 + 4 * k)); }
__device__ __forceinline__ unsigned lane_id() { unsigned l; asm volatile("v_mbcnt_lo_u32_b32 %0, -1, 0\n\tv_mbcnt_hi_u32_b32 %0, -1, %0" : "=v"(l)); return l; }
__device__ __forceinline__ int tid_x() { return wave_idx() * 64 + (int)lane_id(); }
typedef int v8i __attribute__((ext_vector_type(8)));
typedef int v4i __attribute__((ext_vector_type(4)));
__device__ __forceinline__ unsigned pk4_fp8(float a, float b, float c, float d) { int p = __builtin_amdgcn_cvt_pk_fp8_f32(a, b, 0, false); p = __builtin_amdgcn_cvt_pk_fp8_f32(c, d, p, true); return (unsigned)p; }
__device__ __forceinline__ float rcpf_(float x) { return __builtin_amdgcn_rcpf(x); }
__device__ __forceinline__ float sigmoidf_(float x) { return rcpf_(1.0f + __expf(-x)); }

#define XB_TMO      128
#define XB_XCNT(j)  (256  + 64 * (j))
#define XB_XSUB(j)  (1280 + 64 * (j))
#define XB_XGEN(j)  (2304 + 64 * (j))
#define XB_TOP      3328
#define XB_TOPGEN   3392
#define XCD_BAR_WORDS 3456
#define XB_SPIN_CAP (1u << 18)
__device__ __forceinline__ unsigned xb_ld(unsigned* p)              { return __hip_atomic_load(p, __ATOMIC_RELAXED, __HIP_MEMORY_SCOPE_AGENT); }
__device__ __forceinline__ unsigned xb_add(unsigned* p, unsigned v) { return __hip_atomic_fetch_add(p, v, __ATOMIC_RELAXED, __HIP_MEMORY_SCOPE_AGENT); }
__device__ __forceinline__ unsigned xb_xcc_id() { return (unsigned)__builtin_amdgcn_s_getreg((3 << 11) | 20) & 0xFu; }
#define XB_SPIN(cond, bar) do { unsigned _sp = 0; while (cond) { __builtin_amdgcn_s_sleep(1); \
    if ((++_sp & 255u) == 0u) { if (xb_ld(&(bar)[XB_TMO])) break; if (_sp > XB_SPIN_CAP) { atomicAdd(&(bar)[XB_TMO], 1u); break; } } } } while (0)
struct XcdBarrier { unsigned* bar; unsigned x; volatile LAS unsigned* st; };
__device__ __forceinline__ XcdBarrier xcd_barrier_post(unsigned* bar, volatile LAS unsigned* st) {
    XcdBarrier b; b.bar = bar; b.x = xb_xcc_id(); b.st = st;
    if (tid_x() == 0) (void)xb_add(&bar[XB_XCNT(b.x)], 1u);
    return b;
}
__device__ __forceinline__ void xcd_barrier_complete(unsigned* bar, unsigned x, unsigned& nloc, unsigned& nx) {
    const unsigned G = gridDim.x * gridDim.y * gridDim.z;
    unsigned sum, cnt, mine, sp = 0u;
    for (;;) {
        sum = 0u; cnt = 0u; mine = 0u;
#pragma unroll
        for (unsigned j = 0; j < 16; ++j) { const unsigned c = xb_ld(&bar[XB_XCNT(j)]); sum += c; cnt += (c > 0u) ? 1u : 0u; mine = (j == x) ? c : mine; }
        if (sum == G) break;
        __builtin_amdgcn_s_sleep(1);
        if ((++sp & 255u) == 0u) { if (xb_ld(&bar[XB_TMO])) break; if (sp > XB_SPIN_CAP) { atomicAdd(&bar[XB_TMO], 1u); break; } }
    }
    nloc = mine > 0u ? mine : 1u; nx = cnt > 0u ? cnt : 1u;
}
__device__ __forceinline__ void xcd_barrier(const XcdBarrier& b) {
    asm volatile("s_waitcnt vmcnt(0)" ::: "memory");
    __syncthreads();
    if (tid_x() == 0) {
        unsigned* bar = b.bar;
        __builtin_amdgcn_s_waitcnt(0);
        unsigned nloc = b.st[0], nx = b.st[1];
        if (nloc == 0u) { xcd_barrier_complete(bar, b.x, nloc, nx); b.st[0] = nloc; b.st[1] = nx; }
        const unsigned old = xb_add(&bar[XB_XSUB(b.x)], 1u);
        const unsigned gen = old / nloc;
        if (old + 1u == (gen + 1u) * nloc) {
            __builtin_amdgcn_fence(__ATOMIC_RELEASE, "agent");
            asm volatile("s_waitcnt vmcnt(0)" ::: "memory");
            const unsigned og = xb_add(&bar[XB_TOP], 1u);
            const unsigned tg = og / nx;
            if (og + 1u == (tg + 1u) * nx) xb_add(&bar[XB_TOPGEN], 1u);
            else XB_SPIN(xb_ld(&bar[XB_TOPGEN]) == tg, bar);
            __builtin_amdgcn_fence(__ATOMIC_ACQUIRE, "agent");
            xb_add(&bar[XB_XGEN(b.x)], 1u);
            asm volatile("s_waitcnt vmcnt(0)" ::: "memory");
        } else {
            XB_SPIN(xb_ld(&bar[XB_XGEN(b.x)]) == gen, bar);
            __builtin_amdgcn_fence(__ATOMIC_ACQUIRE, "agent");
            asm volatile("s_waitcnt vmcnt(0)" ::: "memory");
        }
    }
    __syncthreads();
}

namespace pg8 {
constexpr int BM = 256, BK = 64, HALF = 128, HTB = HALF * BK * 2, STAGE_BYTES = 8 * HTB, NXCD = 8, WGM = 8;
__host__ __device__ __forceinline__ int lds_byte(int r, int c) { const int st = (r >> 4) * 2 + (c >> 5), rr = r & 15, cc = c & 31, ob = rr * 64 + cc * 2; return st * 1024 + (ob ^ (((ob >> 9) & 1) << 5)); }
__host__ __device__ __forceinline__ void stage_rc(int b, int& R, int& C) { const int st = b / 1024, sb = b % 1024, swz = sb ^ (((sb >> 9) & 1) << 5); R = (st >> 1) * 16 + swz / 64; C = (st & 1) * 32 + (swz % 64) / 2; }
__host__ __device__ __forceinline__ int perm32(int rho) { const int n = rho >> 4, i = rho & 15; return 8 * (i >> 2) + 4 * n + (i & 3); }
struct Unit { int pm, pn, aux; };

template <class Epi, class Sched, bool ALIGN_EPI, bool F8 = false, int WSC = 127>
__device__ __forceinline__ void gemm_phase(LAS unsigned char* lds, const int K, const Sched& S, const Epi& E) {
    const int tid = tid_x(), wid = __builtin_amdgcn_readfirstlane(tid >> 6), lane = tid & 63, wr = wid >> 2, wc = wid & 3, fr = lane & 15, fq = lane >> 4;
    const int nt = K / BK;
    int Rr[2], Cc[2]; unsigned voffB[2];
#pragma unroll
    for (int i = 0; i < 2; ++i) { int R, C; stage_rc(tid * 16 + i * 8192, R, C); Rr[i] = R; Cc[i] = C; const int Rb = Epi::PERM ? ((R & ~31) + perm32(R & 31)) : R; voffB[i] = (unsigned)(Rb * K + C) * 2u; }
    const size_t kstep = (size_t)(BK * 2);
    const size_t hstep = (size_t)HALF * K * 2;
    const unsigned ldsw = (unsigned)wid * 1024u;
    const int aoff = lds_byte(wr * 64 + fr, fq * 8), boff = lds_byte(wc * 32 + fr, fq * 8);
#define PG8_SA(b, h) (((b) * 2 + (h)) * HTB)
#define PG8_SB(b, h) ((4 + (b) * 2 + (h)) * HTB)
#define PG8_STAGE(bufoff, gbase, voff) do { _Pragma("unroll") for (int _i = 0; _i < 2; ++_i) \
        __builtin_amdgcn_global_load_lds((const unsigned*)((const char*)(gbase) + (voff)[_i]), (LAS unsigned*)(lds + (bufoff) + ldsw + _i * 8192), 16, 0, 0); } while (0)
#define PG8_LD8(off_) __builtin_shufflevector(*(const LAS v4i*)(lds + (off_)), *(const LAS v4i*)(lds + (off_) + 1024), 0, 1, 2, 3, 4, 5, 6, 7)
#define PG8_LDA(dst, b, h) do { if constexpr (F8) { _Pragma("unroll") for (int m = 0; m < 4; ++m) dst##8[m] = PG8_LD8(PG8_SA(b, h) + aoff + m * 2048); } \
        else { _Pragma("unroll") for (int m = 0; m < 4; ++m) _Pragma("unroll") for (int k = 0; k < 2; ++k) dst[m][k] = *(const LAS bf16x8*)(lds + PG8_SA(b, h) + aoff + m * 2048 + k * 1024); } } while (0)
#define PG8_LDB(dst, b, h) do { if constexpr (F8) { _Pragma("unroll") for (int n = 0; n < 2; ++n) dst##8[n] = PG8_LD8(PG8_SB(b, h) + boff + n * 2048); } \
        else { _Pragma("unroll") for (int n = 0; n < 2; ++n) _Pragma("unroll") for (int k = 0; k < 2; ++k) dst[n][k] = *(const LAS bf16x8*)(lds + PG8_SB(b, h) + boff + n * 2048 + k * 1024); } } while (0)
#define PG8_MMA(ai, bj, At, Bt) do { __builtin_amdgcn_s_setprio(1); \
        if constexpr (F8) { _Pragma("unroll") for (int m = 0; m < 4; ++m) _Pragma("unroll") for (int n = 0; n < 2; ++n) \
            asm volatile("v_mfma_scale_f32_16x16x128_f8f6f4 %0, %1, %2, %0, %3, %4 op_sel_hi:[0,0,0]" : "+v"(acc[ai][bj][m][n]) : "v"(Bt##8[n]), "v"(At##8[m]), "v"(wsc_), "v"(asc_)); } \
        else { _Pragma("unroll") for (int m = 0; m < 4; ++m) _Pragma("unroll") for (int n = 0; n < 2; ++n) _Pragma("unroll") for (int k = 0; k < 2; ++k) \
            acc[ai][bj][m][n] = __builtin_amdgcn_mfma_f32_16x16x32_bf16(Bt[n][k], At[m][k], acc[ai][bj][m][n], 0, 0, 0); } \
        __builtin_amdgcn_s_setprio(0); } while (0)
#define PG8_WAIT_V(n) asm volatile("s_waitcnt vmcnt(" #n ")" ::: "memory")
#define PG8_WAIT_L(n) asm volatile("s_waitcnt lgkmcnt(" #n ")" ::: "memory")
#define PG8_BAR __builtin_amdgcn_s_barrier()
#define PG8_SCHED __builtin_amdgcn_sched_barrier(0)
    Unit cur, nxt; int ui = 0;
    if (!S.next(0, cur)) return;
    f32x4 acc[2][2][4][2];
#pragma unroll
    for (int a = 0; a < 2; ++a)
#pragma unroll
        for (int b = 0; b < 2; ++b)
#pragma unroll
            for (int m = 0; m < 4; ++m)
#pragma unroll
                for (int n = 0; n < 2; ++n) acc[a][b][m][n] = (f32x4){0.f, 0.f, 0.f, 0.f};
    bf16x8 At[4][2], B0[2][2], B1[2][2]; v8i At8[4], B08[2], B18[2];
    int wsc_ = WSC, asc_ = 127; asm volatile("" : "+v"(wsc_), "+v"(asc_));
    const char* cA; const char* cB; unsigned cA0[2], cA1[2];
    S.addr(cur, Rr, Cc, cA, cB, cA0, cA1);
    LAS unsigned* nslot = (LAS unsigned*)(lds + STAGE_BYTES) + tid * 4;
    PG8_STAGE(PG8_SB(0, 0), cB, voffB); PG8_STAGE(PG8_SB(0, 1), cB + hstep, voffB); PG8_STAGE(PG8_SA(0, 0), cA, cA0); PG8_STAGE(PG8_SA(0, 1), cA, cA1);
    if (wr == 1) PG8_BAR;
    PG8_WAIT_V(2); PG8_BAR;
    PG8_STAGE(PG8_SB(1, 0), cB + kstep, voffB); PG8_STAGE(PG8_SA(1, 0), cA + kstep, cA0); PG8_STAGE(PG8_SB(1, 1), cB + hstep + kstep, voffB);
    PG8_WAIT_V(6); PG8_BAR;
    for (;;) {
        const bool has_next = S.next(ui + 1, nxt);
        const char* nA = cA; const char* nB = cB;
        { unsigned nA0[2] = {cA0[0], cA0[1]}, nA1[2] = {cA1[0], cA1[1]};
          if (has_next) { int R2[2], C2[2]; const int t2 = tid_x();
#pragma unroll
              for (int i = 0; i < 2; ++i) stage_rc(t2 * 16 + i * 8192, R2[i], C2[i]);
              S.addr(nxt, R2, C2, nA, nB, nA0, nA1); }
          nslot[0] = nA0[0]; nslot[1] = nA0[1]; nslot[2] = nA1[0]; nslot[3] = nA1[1]; }
#pragma unroll 1
        for (int t = 0; t < nt; t += 2) {
            const bool last = (t == nt - 2);
            const char* a1 = cA + (size_t)(t + 1) * kstep;
            const char* a2 = last ? nA : cA + (size_t)(t + 2) * kstep; const char* b2 = last ? nB : cB + (size_t)(t + 2) * kstep;
            const char* a3 = a2 + kstep; const char* b3 = b2 + kstep;
            unsigned x0[2], x1[2];
#pragma unroll
            for (int i = 0; i < 2; ++i) { x0[i] = last ? nslot[i] : cA0[i]; x1[i] = last ? nslot[2 + i] : cA1[i]; }
            PG8_LDB(B0, 0, 0); PG8_LDB(B1, 0, 1); PG8_SCHED; PG8_LDA(At, 0, 0); PG8_STAGE(PG8_SA(1, 1), a1, cA1);
            PG8_WAIT_V(8); PG8_WAIT_L(0); PG8_BAR; PG8_MMA(0, 0, At, B0); PG8_MMA(0, 1, At, B1); PG8_BAR; PG8_SCHED;
            PG8_LDA(At, 0, 1); PG8_STAGE(PG8_SB(0, 0), b2, voffB); PG8_STAGE(PG8_SB(0, 1), b2 + hstep, voffB); PG8_STAGE(PG8_SA(0, 0), a2, x0);
            PG8_WAIT_V(8); PG8_WAIT_L(0); PG8_BAR; PG8_MMA(1, 0, At, B0); PG8_MMA(1, 1, At, B1); PG8_BAR; PG8_SCHED;
            PG8_LDB(B0, 1, 0); PG8_LDB(B1, 1, 1); PG8_SCHED; PG8_LDA(At, 1, 0); PG8_STAGE(PG8_SA(0, 1), a2, x1);
            PG8_WAIT_V(8); PG8_WAIT_L(0); PG8_BAR; PG8_MMA(0, 0, At, B0); PG8_MMA(0, 1, At, B1); PG8_BAR; PG8_SCHED;
            PG8_LDA(At, 1, 1); PG8_STAGE(PG8_SB(1, 0), b3, voffB); PG8_STAGE(PG8_SB(1, 1), b3 + hstep, voffB); PG8_STAGE(PG8_SA(1, 0), a3, x0);
            PG8_WAIT_V(8); PG8_WAIT_L(0); PG8_BAR; PG8_MMA(1, 0, At, B0); PG8_MMA(1, 1, At, B1); PG8_BAR; PG8_SCHED;
        }
        if constexpr (ALIGN_EPI) { if (wr == 0) PG8_BAR; }
        if constexpr (F8) asm volatile("s_nop 15\n\ts_nop 15" ::: "memory");
        E(acc, cur, wr, wc, fr, fq);
        if (!has_next) break;
        if (!E.keep(cur)) {
#pragma unroll
            for (int a = 0; a < 2; ++a)
#pragma unroll
                for (int b = 0; b < 2; ++b)
#pragma unroll
                    for (int m = 0; m < 4; ++m)
#pragma unroll
                        for (int n = 0; n < 2; ++n) acc[a][b][m][n] = (f32x4){0.f, 0.f, 0.f, 0.f};
        }
        cur = nxt; cA = nA; cB = nB; cA0[0] = nslot[0]; cA0[1] = nslot[1]; cA1[0] = nslot[2]; cA1[1] = nslot[3]; ++ui;
        if constexpr (ALIGN_EPI) { if (wr == 1) PG8_BAR; }
    }
    PG8_WAIT_V(0);
    if constexpr (!ALIGN_EPI) { if (wr == 0) PG8_BAR; }
    PG8_BAR;
#undef PG8_SA
#undef PG8_SB
#undef PG8_STAGE
#undef PG8_LDA
#undef PG8_LD8
#undef PG8_LDB
#undef PG8_MMA
#undef PG8_WAIT_V
#undef PG8_WAIT_L
#undef PG8_BAR
#undef PG8_SCHED
}

struct DenseOrder {
    const char* A; const char* Bt; int K, nM, nN, nwg, G, c;
    __device__ __forceinline__ void init(const void* A_, const void* Bt_, int M, int N, int K_, int G_, int c_) { A = (const char*)A_; Bt = (const char*)Bt_; K = K_; nM = M / BM; nN = N / BM; nwg = nM * nN; G = G_; c = c_; }
    __device__ __forceinline__ bool next(int i, Unit& u) const {
        const long L = (long)i * G + c; if (L >= nwg) return false;
        int wgid = (int)L; { const int q = nwg / NXCD, r = nwg % NXCD, xcd = wgid % NXCD, off = wgid / NXCD; wgid = (xcd < r ? xcd * (q + 1) : r * (q + 1) + (xcd - r) * q) + off; }
        const int nig = WGM * nN, gid = wgid / nig, fm = gid * WGM, gsz = (nM - fm) < WGM ? (nM - fm) : WGM;
        u.pm = fm + ((wgid % nig) % gsz); u.pn = (wgid % nig) / gsz; u.aux = 0; return true;
    }
    __device__ __forceinline__ void addr(const Unit& u, const int (&R)[2], const int (&C)[2], const char*& a, const char*& b, unsigned (&a0)[2], unsigned (&a1)[2]) const {
        a = A + (size_t)u.pm * ((size_t)BM * K * 2); b = Bt + (size_t)u.pn * ((size_t)BM * K * 2);
#pragma unroll
        for (int i = 0; i < 2; ++i) { a0[i] = (unsigned)(R[i] * K + C[i]) * 2u; a1[i] = a0[i] + (unsigned)(HALF * K * 2); }
    }
};
}

__host__ __device__ __forceinline__ int proj_logical_col(int c) {
    if (c >= 3584) { const int t = (c - 3584) >> 8, l = (c - 3584) & 255; return ((l >> 7) ? 4608 : 3584) + 128 * t + (l & 127); }
    if (c < 2048 || c >= 3072) return c;
    const int tb = c & ~255, l = c & 255, bj = l >> 7, wc = (l >> 5) & 3, i = l & 31;
    return tb + 64 * wc + 32 * bj + i;
}
struct EpiProj {
    static constexpr bool PERM = true;
    unsigned char* ws; bf16* gates; const float* qg; const float* kg;
    __device__ __forceinline__ bool keep(const pg8::Unit&) const { return false; }
    __device__ __forceinline__ void operator()(f32x4 (&acc)[2][2][4][2], const pg8::Unit& u, int wr, int wc, int fr, int fq) const {
        const int pn = u.pn; const int tok0 = u.pm * 256 + wr * 64 + fr;
        if (pn < 8 || pn == 12 || pn == 13) {
            unsigned char* base = ws + ((pn < 8) ? (WS_HQ + (size_t)(pn >> 1) * (32 * MiB)) : WS_VIMG);
#pragma unroll
            for (int ai = 0; ai < 2; ++ai)
#pragma unroll
                for (int m = 0; m < 4; ++m) {
                    const int tok = tok0 + ai * 128 + m * 16; const int b = tok >> 12, s = tok & 4095, chunk = s >> 6, row = s & 63;
#pragma unroll
                    for (int bj = 0; bj < 2; ++bj) { const int h = 2 * (pn & 1) + bj;
                        unsigned char* dst = base + ((size_t)((b * 4 + h) * 64 + chunk) << 14) + off_a(row, 4 * wc + fq);
                        *(v4u*)dst = pack8(acc[ai][bj][m][0], acc[ai][bj][m][1]); }
                }
        } else if (pn < 12) {
            const bool isq = pn < 10; const float* gn = isq ? qg : kg;
            const int j = 4 * (pn & 1) + wc, h = j >> 1, mp = j & 1;
            const f32x4 ga0 = *(const f32x4*)(gn + 8 * fq), ga1 = *(const f32x4*)(gn + 8 * fq + 4), gb0 = *(const f32x4*)(gn + 32 + 8 * fq), gb1 = *(const f32x4*)(gn + 36 + 8 * fq);
            const f32x4* rope = (const f32x4*)(ws + WS_ROPE);
            const float qs = isq ? 0.125f * LOG2E : 1.0f;
#pragma unroll
            for (int ai = 0; ai < 2; ++ai)
#pragma unroll
                for (int m = 0; m < 4; ++m) {
                    const int tok = tok0 + ai * 128 + m * 16; const int b = tok >> 12, s = tok & 4095;
                    f32x4 x10 = acc[ai][0][m][0], x11 = acc[ai][0][m][1], x20 = acc[ai][1][m][0], x21 = acc[ai][1][m][1];
                    float ss = 0.f;
#pragma unroll
                    for (int e = 0; e < 4; ++e) ss += x10[e] * x10[e] + x11[e] * x11[e] + x20[e] * x20[e] + x21[e] * x21[e];
                    ss += swz_xor<16>(ss); { auto rr = __builtin_amdgcn_permlane32_swap(__float_as_uint(ss), __float_as_uint(ss), false, false); ss = __uint_as_float(rr[0]) + __uint_as_float(rr[1]); }
                    const float rstd = qs / sqrtf(ss * (1.0f / 64.0f) + EPS);
                    x10 = x10 * ga0 * rstd; x11 = x11 * ga1 * rstd; x20 = x20 * gb0 * rstd; x21 = x21 * gb1 * rstd;
                    const f32x4* rp = rope + (size_t)s * 16 + 4 * fq;
                    const f32x4 r0 = rp[0], r1 = rp[1], r2 = rp[2], r3 = rp[3];
                    f32x4 o10, o11, o20, o21;
                    o10[0] = x10[0] * r0[0] - x20[0] * r0[1]; o20[0] = x10[0] * r0[1] + x20[0] * r0[0];
                    o10[1] = x10[1] * r0[2] - x20[1] * r0[3]; o20[1] = x10[1] * r0[3] + x20[1] * r0[2];
                    o10[2] = x10[2] * r1[0] - x20[2] * r1[1]; o20[2] = x10[2] * r1[1] + x20[2] * r1[0];
                    o10[3] = x10[3] * r1[2] - x20[3] * r1[3]; o20[3] = x10[3] * r1[3] + x20[3] * r1[2];
                    o11[0] = x11[0] * r2[0] - x21[0] * r2[1]; o21[0] = x11[0] * r2[1] + x21[0] * r2[0];
                    o11[1] = x11[1] * r2[2] - x21[1] * r2[3]; o21[1] = x11[1] * r2[3] + x21[1] * r2[2];
                    o11[2] = x11[2] * r3[0] - x21[2] * r3[1]; o21[2] = x11[2] * r3[1] + x21[2] * r3[0];
                    o11[3] = x11[3] * r3[2] - x21[3] * r3[3]; o21[3] = x11[3] * r3[3] + x21[3] * r3[2];
                    const v4u w1 = pack8(o10, o11), w2 = pack8(o20, o21);
                    if (isq) {
                        bf16* q = (bf16*)(ws + WS_QT) + ((size_t)((b * 4 + h) * 4096 + s) * 128 + 64 * mp + 8 * fq);
                        *(v4u*)q = w1; *(v4u*)(q + 32) = w2;
                    } else {
                        unsigned char* kb = ws + WS_KIMG + ((size_t)((b * 4 + h) * 64 + (s >> 6)) << 14);
                        const unsigned rho = kappa((unsigned)(s & 63));
                        *(v4u*)(kb + off_a(rho, 8 * mp + fq)) = w1; *(v4u*)(kb + off_a(rho, 8 * mp + 4 + fq)) = w2;
                    }
                }
        } else {
            unsigned char* gblk = (unsigned char*)gates + ((size_t)(u.pm * 8 + (pn - 14)) << 17) + (size_t)(((wr * 4) * 4 + wc) * 64 + fr + 16 * fq) * 16;
#pragma unroll
            for (int ai = 0; ai < 2; ++ai)
#pragma unroll
                for (int m = 0; m < 4; ++m) {
                    bf16* dst = (bf16*)(gblk + (size_t)(ai * 2 * 4 + m) * 4 * 1024);
                    f32x4 r0, r1, s0, s1;
#pragma unroll
                    for (int e = 0; e < 4; ++e) {
                        const float ea0 = __expf(-acc[ai][0][m][0][e]), ea1 = __expf(-acc[ai][0][m][1][e]), eb0 = __expf(-acc[ai][1][m][0][e]), eb1 = __expf(-acc[ai][1][m][1][e]);
                        r0[e] = (1.0f + eb0) * rcpf_(1.0f + ea0); r1[e] = (1.0f + eb1) * rcpf_(1.0f + ea1); s0[e] = rcpf_(1.0f + eb0); s1[e] = rcpf_(1.0f + eb1);
                    }
                    *(v4u*)dst = pack8(r0, r1); *(v4u*)(dst + 32768) = pack8(s0, s1);
                }
        }
    }
};

struct BranchOrder {
    pg8::DenseOrder d; const char* A2; const char* B2;
    __device__ __forceinline__ bool next(int i, pg8::Unit& u) const { if (!d.next(i >> 1, u)) return false; u.aux = i & 1; return true; }
    __device__ __forceinline__ void addr(const pg8::Unit& u, const int (&R)[2], const int (&C)[2], const char*& a, const char*& b, unsigned (&a0)[2], unsigned (&a1)[2]) const {
        d.addr(u, R, C, a, b, a0, a1);
        if (u.aux) { a = A2 + (size_t)u.pm * ((size_t)pg8::BM * d.K * 2); b = B2 + (size_t)u.pn * ((size_t)pg8::BM * d.K * 2); }
    }
};
struct EpiBranch {
    static constexpr bool PERM = true;
    const bf16* gates; bf16* mixed;
    __device__ __forceinline__ bool keep(const pg8::Unit& u) const { return u.aux == 0; }
    __device__ __forceinline__ void operator()(f32x4 (&acc)[2][2][4][2], const pg8::Unit& u, int wr, int wc, int fr, int fq) const {
        const int tok0 = u.pm * 256 + wr * 64 + fr, c0 = u.pn * 256 + 32 * wc + 8 * fq;
        const unsigned char* gb = (const unsigned char*)gates + ((size_t)(u.pm * 8 + 2 * u.pn) << 17) + (u.aux ? 65536 : 0) + (size_t)(((wr * 4) * 4 + wc) * 64 + fr + 16 * fq) * 16;
        v4u g[2][4][2];
#pragma unroll
        for (int ai = 0; ai < 2; ++ai)
#pragma unroll
            for (int m = 0; m < 4; ++m)
#pragma unroll
                for (int bj = 0; bj < 2; ++bj) g[ai][m][bj] = *(const v4u*)(gb + ((size_t)bj << 17) + (size_t)(ai * 2 * 4 + m) * 4 * 1024);
#pragma unroll
        for (int ai = 0; ai < 2; ++ai) {
#pragma unroll
            for (int m = 0; m < 4; ++m)
#pragma unroll
                for (int bj = 0; bj < 2; ++bj) {
#pragma unroll
                    for (int e = 0; e < 2; ++e) { acc[ai][bj][m][0][2 * e] *= __uint_as_float(g[ai][m][bj][e] << 16); acc[ai][bj][m][0][2 * e + 1] *= __uint_as_float(g[ai][m][bj][e] & 0xffff0000u);
                                                  acc[ai][bj][m][1][2 * e] *= __uint_as_float(g[ai][m][bj][2 + e] << 16); acc[ai][bj][m][1][2 * e + 1] *= __uint_as_float(g[ai][m][bj][2 + e] & 0xffff0000u); }
                    if (u.aux) *(v4u*)(mixed + (size_t)(tok0 + ai * 128 + m * 16) * DM + c0 + 128 * bj) = pack8(acc[ai][bj][m][0], acc[ai][bj][m][1]);
                }
        }
    }
};
struct EpiOut {
    static constexpr bool PERM = false;
    const float* x; float* out;
    __device__ __forceinline__ bool keep(const pg8::Unit&) const { return false; }
    __device__ __forceinline__ void operator()(f32x4 (&acc)[2][2][4][2], const pg8::Unit& u, int wr, int wc, int fr, int fq) const {
        const int tok0 = u.pm * 256 + wr * 64 + fr, c0 = u.pn * 256 + 32 * wc + 4 * fq;
#pragma unroll
        for (int ai = 0; ai < 2; ++ai)
#pragma unroll
            for (int mp = 0; mp < 2; ++mp) {
                f32x4 xv[2][2][2];
#pragma unroll
                for (int mm = 0; mm < 2; ++mm) { const size_t ro = (size_t)(tok0 + ai * 128 + (2 * mp + mm) * 16) * DM + c0;
#pragma unroll
                    for (int bj = 0; bj < 2; ++bj)
#pragma unroll
                        for (int n = 0; n < 2; ++n) xv[mm][bj][n] = *(const f32x4*)(x + ro + 128 * bj + 16 * n); }
#pragma unroll
                for (int mm = 0; mm < 2; ++mm) { const size_t ro = (size_t)(tok0 + ai * 128 + (2 * mp + mm) * 16) * DM + c0;
#pragma unroll
                    for (int bj = 0; bj < 2; ++bj)
#pragma unroll
                        for (int n = 0; n < 2; ++n) *(f32x4*)(out + ro + 128 * bj + 16 * n) = xv[mm][bj][n] + acc[ai][bj][2 * mp + mm][n]; }
            }
    }
};
template <int rmul> struct MoeOrderT {
    const LAS int* pref; const LAS int* cnt; const v2u* rowtok; const char* A; const char* Bt; int K; size_t bstride; int rmul_unused; int b_lo, b_hi, ncol, G, c;
    __device__ __forceinline__ bool next(int i, pg8::Unit& u) const {
        const int L = i * G + c; const int t0 = pref[b_lo], total = (pref[b_hi] - t0) * ncol; if (L >= total) return false;
        const int rt = t0 + (L >> 2); int b = b_lo;
#pragma unroll 1
        for (int st = 32; st >= 1; st >>= 1) { const int nb_ = b + st; if (nb_ < b_hi && __builtin_amdgcn_readfirstlane(pref[nb_]) <= rt) b = nb_; }
        u.pm = rt - pref[b]; u.pn = L & 3; u.aux = b; return true;
    }
    __device__ __forceinline__ void addr(const pg8::Unit& u, const int (&R)[2], const int (&C)[2], const char*& a, const char*& b, unsigned (&a0)[2], unsigned (&a1)[2]) const {
        a = A; b = Bt + (size_t)(u.aux & 31) * bstride + (size_t)u.pn * ((size_t)pg8::BM * K * 2);
        if constexpr (rmul == 0) {
            const unsigned base = (unsigned)(pref[u.aux] + u.pm) * 256u;
#pragma unroll
            for (int i = 0; i < 2; ++i) { a0[i] = ((base + (unsigned)R[i]) * (unsigned)K + (unsigned)C[i]) * 2u; a1[i] = a0[i] + (unsigned)(128 * K * 2); }
        } else {
        const int n = cnt[u.aux]; const v2u* rt = rowtok + (size_t)u.aux * RCAP;
#pragma unroll
        for (int i = 0; i < 2; ++i) {
            const int r0 = u.pm * 256 + R[i], r1 = r0 + 128;
            const int t0 = (r0 < n) ? (int)rt[r0].x : 0, t1 = (r1 < n) ? (int)rt[r1].x : 0;
            a0[i] = (unsigned)(t0 * K + C[i]) * 2u; a1[i] = (unsigned)(t1 * K + C[i]) * 2u;
        }
        }
    }
};
struct EpiUp {
    static constexpr bool PERM = true;
    const LAS int* pref; const LAS int* cnt; unsigned char* hid;
    __device__ __forceinline__ bool keep(const pg8::Unit&) const { return false; }
    __device__ __forceinline__ void operator()(f32x4 (&acc)[2][2][4][2], const pg8::Unit& u, int wr, int wc, int fr, int fq) const {
        const int n = cnt[u.aux] - u.pm * 256;
        int frl = fr, fql = fq; asm volatile("" : "+v"(frl), "+v"(fql));
        const int r0 = wr * 64 + frl, c0 = u.pn * 128 + 32 * wc + 8 * fql;
        unsigned char* hb = hid + (size_t)(pref[u.aux] + u.pm) * (256 * DFF) + c0;
#pragma unroll
        for (int ai = 0; ai < 2; ++ai)
#pragma unroll
            for (int m = 0; m < 4; ++m) {
                const int r = r0 + ai * 128 + m * 16;
                f32x4 h0, h1;
#pragma unroll
                for (int e = 0; e < 4; ++e) { const float a0 = acc[ai][0][m][0][e], a1 = acc[ai][0][m][1][e];
                    h0[e] = a0 * rcpf_(1.0f + __expf(-a0)) * acc[ai][1][m][0][e]; h1[e] = a1 * rcpf_(1.0f + __expf(-a1)) * acc[ai][1][m][1][e]; }
                if (r < n) *(v2u*)(hb + (size_t)r * DFF) = (v2u){pk4_fp8(h0[0], h0[1], h0[2], h0[3]), pk4_fp8(h1[0], h1[1], h1[2], h1[3])};
            }
    }
};
struct EpiDown {
    static constexpr bool PERM = true;
    const LAS int* pref; const LAS int* cnt; bf16* y;
    __device__ __forceinline__ bool keep(const pg8::Unit&) const { return false; }
    __device__ __forceinline__ void operator()(f32x4 (&acc)[2][2][4][2], const pg8::Unit& u, int wr, int wc, int fr, int fq) const {
        const int n = cnt[u.aux] - u.pm * 256;
        int frl = fr, fql = fq; asm volatile("" : "+v"(frl), "+v"(fql));
        const int r0 = wr * 64 + frl, c0 = u.pn * 256 + 32 * wc + 8 * fql;
        bf16* yb = y + (size_t)(pref[u.aux] + u.pm) * (256 * DM) + c0;
#pragma unroll
        for (int ai = 0; ai < 2; ++ai)
#pragma unroll
            for (int m = 0; m < 4; ++m) {
                const int r = r0 + ai * 128 + m * 16;
                if (r < n) {
#pragma unroll
                    for (int bj = 0; bj < 2; ++bj) *(v4u*)(yb + (size_t)r * DM + 128 * bj) = pack8(acc[ai][bj][m][0], acc[ai][bj][m][1]);
                }
            }
    }
};

constexpr int NWAVES = 8;
constexpr int RING_OFF = 0, RING_BYTES = 131072;
struct Args { const float* in[20]; float* out; unsigned char* ws; int ph_lo, ph_hi, li, pad; };
constexpr int SCHED_OFF = RING_BYTES + 8192;

template <class F>
__device__ __forceinline__ void transpose_item(const float* W, int N, bf16* WT, int K, LAS float* scr, int kb, int nb, int lane, F srccol) {
    const int k0 = 64 * kb, n0 = 32 * nb; const int sc = srccol(n0);
#pragma unroll 8
    for (int i = 0; i < 32; ++i) { const int kk = 2 * i + (lane >> 5); scr[kk * 33 + (lane & 31)] = W[(size_t)(k0 + kk) * N + sc + (lane & 31)]; }
    asm volatile("s_waitcnt lgkmcnt(0)" ::: "memory");
    const int c = lane & 7;
#pragma unroll
    for (int j = 0; j < 4; ++j) { const int n = (lane >> 3) + 8 * j; const LAS float* s = scr + (8 * c) * 33 + n;
        v4u o; o.x = cvtpk(s[0 * 33], s[1 * 33]); o.y = cvtpk(s[2 * 33], s[3 * 33]); o.z = cvtpk(s[4 * 33], s[5 * 33]); o.w = cvtpk(s[6 * 33], s[7 * 33]);
        *(v4u*)(WT + (size_t)(n0 + n) * K + k0 + 8 * c) = o; }
    asm volatile("s_waitcnt lgkmcnt(0)" ::: "memory");
}

template <class F>
__device__ __forceinline__ void transpose_item8(const float* W, int N, unsigned char* WT, int K, float sc, LAS float* scr, int kb, int nb, int lane, F srccol) {
    const int k0 = 64 * kb, n0 = 32 * nb; const int scol = srccol(n0);
#pragma unroll 8
    for (int i = 0; i < 32; ++i) { const int kk = 2 * i + (lane >> 5); scr[kk * 33 + (lane & 31)] = W[(size_t)(k0 + kk) * N + scol + (lane & 31)] * sc; }
    asm volatile("s_waitcnt lgkmcnt(0)" ::: "memory");
    const int n = lane & 31, hf = lane >> 5; const LAS float* sp = scr + (32 * hf) * 33 + n;
    v4u o0, o1;
    o0.x = pk4_fp8(sp[0 * 33], sp[1 * 33], sp[2 * 33], sp[3 * 33]); o0.y = pk4_fp8(sp[4 * 33], sp[5 * 33], sp[6 * 33], sp[7 * 33]);
    o0.z = pk4_fp8(sp[8 * 33], sp[9 * 33], sp[10 * 33], sp[11 * 33]); o0.w = pk4_fp8(sp[12 * 33], sp[13 * 33], sp[14 * 33], sp[15 * 33]);
    o1.x = pk4_fp8(sp[16 * 33], sp[17 * 33], sp[18 * 33], sp[19 * 33]); o1.y = pk4_fp8(sp[20 * 33], sp[21 * 33], sp[22 * 33], sp[23 * 33]);
    o1.z = pk4_fp8(sp[24 * 33], sp[25 * 33], sp[26 * 33], sp[27 * 33]); o1.w = pk4_fp8(sp[28 * 33], sp[29 * 33], sp[30 * 33], sp[31 * 33]);
    unsigned char* d = WT + (size_t)(n0 + n) * K + k0 + 32 * hf;
    *(v4u*)d = o0; *(v4u*)(d + 16) = o1;
    asm volatile("s_waitcnt lgkmcnt(0)" ::: "memory");
}
__device__ __forceinline__ void p0_prologue(const Args& a, LAS unsigned char* lds, int vcu, int G, int wave, int lane) {
    LAS float* scr = (LAS float*)(lds + wave * 16384);
    unsigned char* ws = a.ws;
    const int gw = vcu * NWAVES + wave, NGW = G * NWAVES;
    constexpr int I_IN = 16 * (NCOLS / 32), I_BR = 8 * 32, I_OUT = 16 * 32;
    constexpr int NITEMS = I_IN + 2 * I_BR + I_OUT;
    for (int it = gw; it < NITEMS; it += NGW) {
        int r = it;
        if (r < I_IN) { transpose_item(a.in[2], NCOLS, (bf16*)(ws + WS_WIN), DM, scr, r / (NCOLS / 32), r % (NCOLS / 32), lane, [](int n) { return proj_logical_col(n); }); continue; } r -= I_IN;
        if (r < I_BR) { transpose_item(a.in[9], DM, (bf16*)(ws + WS_WHG), 512, scr, r / 32, r % 32, lane, [](int n) { return n; }); continue; } r -= I_BR;
        if (r < I_BR) { transpose_item(a.in[10], DM, (bf16*)(ws + WS_WDA), 512, scr, r / 32, r % 32, lane, [](int n) { return n; }); continue; } r -= I_BR;
        transpose_item(a.in[11], DM, (bf16*)(ws + WS_WOUT), DM, scr, r / 32, r % 32, lane, [](int n) { return n; });
    }
    const f32x4 g0 = ((const f32x4*)a.in[1])[lane], g1 = ((const f32x4*)a.in[1])[lane + 64], g2 = ((const f32x4*)a.in[1])[lane + 128], g3 = ((const f32x4*)a.in[1])[lane + 192];
    for (int m = gw; m < NT; m += NGW) {
        const f32x4* xr = (const f32x4*)(a.in[0] + (size_t)m * DM) + lane;
        f32x4 v0 = xr[0], v1 = xr[64], v2 = xr[128], v3 = xr[192];
        float s = 0.f;
#pragma unroll
        for (int e = 0; e < 4; ++e) s += v0[e] * v0[e] + v1[e] * v1[e] + v2[e] * v2[e] + v3[e] * v3[e];
        const float rstd = 1.0f / sqrtf(wave_sum(s) * (1.0f / DM) + EPS);
        v0 = v0 * g0 * rstd; v1 = v1 * g1 * rstd; v2 = v2 * g2 * rstd; v3 = v3 * g3 * rstd;
        v2u* o = (v2u*)((bf16*)(ws + WS_H) + (size_t)m * DM) + lane;
        o[0] = (v2u){cvtpk(v0[0], v0[1]), cvtpk(v0[2], v0[3])}; o[64] = (v2u){cvtpk(v1[0], v1[1]), cvtpk(v1[2], v1[3])};
        o[128] = (v2u){cvtpk(v2[0], v2[1]), cvtpk(v2[2], v2[3])}; o[192] = (v2u){cvtpk(v3[0], v3[1]), cvtpk(v3[2], v3[3])};
    }
    const int gt = (vcu * NWAVES + wave) * 64 + lane, NGT = NGW * 64;
    for (int i = gt; i < 4096 * 32; i += NGT) { const int pos = i >> 5, f = i & 31;
        const float inv = powf(10000.0f, -(float)f / 32.0f); const float ang = (float)pos * inv;
        ((f32x2*)(ws + WS_ROPE))[i] = (f32x2){cosf(ang), sinf(ang)}; }
    if (vcu == 0) {
        float* sm = (float*)(ws + WS_SMALL); const int t = wave * 64 + lane;
        { const float a0 = a.in[3][t], a1 = a.in[3][512 + t], mx = fmaxf(a0, a1), e0 = expf(a0 - mx), e1 = expf(a1 - mx); sm[t] = e0 / (e0 + e1); }
        if (wave == 0) {
            const float* lp = a.in[7];
            const float d01 = wave_sum(lp[lane] * lp[64 + lane]), d23 = wave_sum(lp[128 + lane] * lp[192 + lane]);
            float mq = fabsf(a.in[5][lane]), mk = fabsf(a.in[6][lane]);
            mq = wave_max(mq); mk = wave_max(mk);
            if (lane == 0) { sm[512] = expf(d01) - expf(d23) + 0.2f; sm[513] = 8.0f * mq * mk * LOG2E * 1.001f + 0.01f; }
        }
    }
}

__device__ __forceinline__ void router_phase(const Args& a, LAS unsigned char* lds, int G, int wave, int lane) {
    LAS float* wl = (LAS float*)lds;
    LAS float* gl = (LAS float*)(lds + 73728 + 256);
    LAS float* lg = gl + 1024 + wave * (16 * 48);
    LAS int* lhist = (LAS int*)(gl + 1024 + 8 * 16 * 48);
    LAS int* lbase = lhist + 64;
    LAS int* tbk = lbase + 64;
    LAS int* trk = tbk + 256;
    LAS float* twt = (LAS float*)(trk + 256);
    unsigned char* ws = a.ws; const int tid = tid_x();
    const float* wrg = a.in[13]; const float* wre = a.in[15];
    const float* x1 = a.out; const float* brg = a.in[14]; const float* bre = a.in[16];
    unsigned* gcnt = (unsigned*)(ws + WS_CTL) + CW_GCNT; v2u* rowtok = (v2u*)(ws + WS_ROWTOK);
    const int c16 = lane & 15, g4 = lane >> 4;
    for (int i = tid; i < 1024; i += 512) gl[i] = a.in[12][i];
    for (int batch = blockIdx.x; batch < NT / 128; batch += G) {
        const int t0 = batch * 128 + wave * 16;
        f32x4 acc0 = {0.f, 0.f, 0.f, 0.f}, acc1 = acc0, acc2 = acc0; float ss = 0.f;
        for (int half = 0; half < 2; ++half) {
            __syncthreads();
            if (half == 0 && tid < 64) lhist[tid] = 0;
#pragma unroll 8
            for (int i = tid; i < 512 * 32; i += 512) wl[(i >> 5) * 36 + 4 + (i & 31)] = wre[(size_t)half * 512 * 32 + i];
#pragma unroll
            for (int i = tid; i < 512 * 4; i += 512) wl[(i >> 2) * 36 + (i & 3)] = wrg[(size_t)half * 512 * 4 + i];
            __syncthreads();
            const float* xr = x1 + (size_t)(t0 + c16) * DM + 512 * half + 4 * g4;
#pragma unroll 4
            for (int sp = 0; sp < 32; ++sp) {
                const f32x4 xv = *(const f32x4*)(xr + 16 * sp); const f32x4 gv = *(const LAS f32x4*)(gl + 512 * half + 16 * sp + 4 * g4);
                ss += xv[0] * xv[0] + xv[1] * xv[1] + xv[2] * xv[2] + xv[3] * xv[3];
                const f32x4 u = xv * gv;
                const LAS float* wp = wl + (16 * sp + 4 * g4) * 36 + c16;
#pragma unroll
                for (int i = 0; i < 4; ++i) {
                    acc0 = __builtin_amdgcn_mfma_f32_16x16x4f32(u[i], wp[i * 36], acc0, 0, 0, 0);
                    acc1 = __builtin_amdgcn_mfma_f32_16x16x4f32(u[i], wp[i * 36 + 16], acc1, 0, 0, 0);
                    acc2 = __builtin_amdgcn_mfma_f32_16x16x4f32(u[i], wp[i * 36 + 32], acc2, 0, 0, 0);
                }
            }
        }
        ss += swz_xor<16>(ss); { auto rr = __builtin_amdgcn_permlane32_swap(__float_as_uint(ss), __float_as_uint(ss), false, false); ss = __uint_as_float(rr[0]) + __uint_as_float(rr[1]); }
        const float rstd = 1.0f / sqrtf(ss * (1.0f / DM) + EPS);
#pragma unroll
        for (int r = 0; r < 4; ++r) { lg[(4 * g4 + r) * 48 + c16] = acc0[r]; lg[(4 * g4 + r) * 48 + 16 + c16] = acc1[r]; lg[(4 * g4 + r) * 48 + 32 + c16] = acc2[r]; }
        asm volatile("s_waitcnt lgkmcnt(0)" ::: "memory");
        if (lane < 16) {
            const LAS float* lt = lg + lane * 48; const int t = t0 + lane, li = wave * 16 + lane;
            float gl4[4]; int gsel = 0;
#pragma unroll
            for (int q = 0; q < 4; ++q) gl4[q] = lt[q] * rstd + brg[q];
            float gmax = gl4[0];
#pragma unroll
            for (int q = 1; q < 4; ++q) if (gl4[q] > gmax) { gmax = gl4[q]; gsel = q; }
            float den = 0.f;
#pragma unroll
            for (int q = 0; q < 4; ++q) den += expf(gl4[q] - gmax);
            const float gw_ = 1.0f / den;
            float el[8];
#pragma unroll
            for (int q = 0; q < 8; ++q) el[q] = lt[4 + 8 * gsel + q] * rstd + bre[gsel * 8 + q];
            int i0 = 0; float v0 = el[0];
#pragma unroll
            for (int q = 1; q < 8; ++q) if (el[q] > v0) { v0 = el[q]; i0 = q; }
            int i1 = -1; float v1 = -3.0e38f;
#pragma unroll
            for (int q = 0; q < 8; ++q) if (q != i0 && el[q] > v1) { v1 = el[q]; i1 = q; }
            const float w1f = 1.0f / (1.0f + expf(v0 - v1)), w0f = 1.0f - w1f;
            const int b0 = gsel * 8 + i0, b1 = 32 + gsel * 8 + i1;
            tbk[2 * li] = b0; tbk[2 * li + 1] = b1;
            trk[2 * li] = atomicAdd((int*)&lhist[b0], 1); trk[2 * li + 1] = atomicAdd((int*)&lhist[b1], 1);
            twt[2 * li] = w0f * gw_; twt[2 * li + 1] = w1f * gw_;
        }
#pragma unroll
        for (int r = 0; r < 16; ++r) {
            const float rs = __uint_as_float(__builtin_amdgcn_readlane(__float_as_uint(rstd), r));
            const f32x4* xr = (const f32x4*)(x1 + (size_t)(t0 + r) * DM) + lane;
            unsigned* o = (unsigned*)(ws + WS_XN + (size_t)(t0 + r) * DM) + lane;
#pragma unroll
            for (int j = 0; j < 4; ++j) { const f32x4 v = xr[64 * j] * *(const LAS f32x4*)(gl + 4 * lane + 256 * j) * rs; o[64 * j] = pk4_fp8(v[0], v[1], v[2], v[3]); }
        }
        __syncthreads();
        if (tid < 64) { const int c = lhist[tid]; lbase[tid] = c ? (int)atomicAdd(&gcnt[tid * 16], (unsigned)c) : 0; }
        __syncthreads();
        if (tid < 256) { const int bk = tbk[tid]; const int slot = lbase[bk] + trk[tid]; rowtok[(size_t)bk * RCAP + slot] = (v2u){(unsigned)(batch * 128 + (tid >> 1)), __float_as_uint(twt[tid])};
            ((v2u*)(ws + WS_TOKPOS))[(size_t)batch * 256 + tid] = (v2u){((unsigned)bk << 16) | (unsigned)slot, __float_as_uint(twt[tid])}; }
    }
    __syncthreads();
}

__device__ __forceinline__ void w13_convert(const Args& a, LAS unsigned char* lds, int vcu, int G, int wave, int lane) {
    LAS float* scr = (LAS float*)(lds + wave * 16384);
    const int gw = vcu * NWAVES + wave, NGW = G * NWAVES;
    for (int it = gw; it < NEXP * 512; it += NGW) {
        const int e = it >> 9, q = it & 511, kb = q >> 5, nb = q & 31, n0 = nb * 32, bj = (n0 >> 7) & 1;
        const float* W = (bj ? a.in[18] : a.in[17]) + (size_t)e * DM * DFF;
        transpose_item8(W, DFF, a.ws + WS_W13T + (size_t)e * DM * DM, DM, 32.0f, scr, kb, nb, lane, [](int n) { return 128 * (n >> 8) + (n & 127); });
    }
    for (int it = gw; it < NEXP * 256; it += NGW) {
        const int e = it >> 8, q = it & 255;
        transpose_item8(a.in[19] + (size_t)e * DFF * DM, DM, a.ws + WS_W2T + (size_t)e * DM * DFF, DFF, 16.0f, scr, q / 32, q % 32, lane, [](int n) { return n; });
    }
}
__device__ __forceinline__ void moe_sched_setup(const Args& a, LAS unsigned char* lds) {
    LAS int* pref = (LAS int*)(lds + SCHED_OFF); LAS int* cnt = pref + 80;
    const unsigned* gcnt = (const unsigned*)(a.ws + WS_CTL) + CW_GCNT;
    const int t_ = tid_x();
    if (t_ < 64) {
        const int c = (int)gcnt[t_ * 16]; cnt[t_] = c;
        int v = (c + 255) >> 8;
        volatile LAS int* tmp = (volatile LAS int*)(pref + 160);
#pragma unroll
        for (int o = 1; o < 64; o <<= 1) { tmp[t_] = v; const int up = tmp[t_ >= o ? t_ - o : 0]; if (t_ >= o) v += up; }
        pref[t_ + 1] = v; if (t_ == 0) pref[0] = 0;
    }
    __syncthreads();
}

namespace att {
constexpr int SLOT = 16384;
constexpr int LDS_K = 0, LDS_V = 2 * SLOT, LDS_L = 4 * SLOT, LDS_STG = 4 * SLOT + 4096;
typedef short v4i16_t __attribute__((ext_vector_type(4)));
__device__ __forceinline__ s16x4 vtr(const LAS unsigned char* p) { return __builtin_bit_cast(s16x4, __builtin_amdgcn_ds_read_tr16_b64_v4i16((LAS v4i16_t*)p)); }
#define ATT_WAIT_BAR(N) asm volatile("s_waitcnt vmcnt(" #N ")\n\ts_barrier" ::: "memory")
#define ATT_MFMA(a, b, c) __builtin_amdgcn_mfma_f32_32x32x16_bf16((a), (b), (c), 0, 0, 0)
__device__ __forceinline__ void softmax_tile(f32x16& p0, f32x16& p1, bf16x8 (&pa)[4], float& lsum, int jb, int qrel, int hh, float mshift) {
    if (jb >= 0) {
#pragma unroll
        for (int r = 0; r < 16; ++r) { const int kr = 64 * jb + (r & 7) + 8 * hh + 16 * (r >> 3);
            if (kr > qrel) p0[r] = -INFINITY; if (kr + 32 > qrel) p1[r] = -INFINITY; }
    }
    float s = 0.f;
#pragma unroll
    for (int r = 0; r < 16; ++r) { p0[r] = __builtin_amdgcn_exp2f(p0[r] - mshift); p1[r] = __builtin_amdgcn_exp2f(p1[r] - mshift); s += p0[r] + p1[r]; }
    lsum += s;
    v4u w;
    w.x = cvtpk(p0[0], p0[1]); w.y = cvtpk(p0[2], p0[3]); w.z = cvtpk(p0[4], p0[5]); w.w = cvtpk(p0[6], p0[7]); pa[0] = __builtin_bit_cast(bf16x8, w);
    w.x = cvtpk(p0[8], p0[9]); w.y = cvtpk(p0[10], p0[11]); w.z = cvtpk(p0[12], p0[13]); w.w = cvtpk(p0[14], p0[15]); pa[1] = __builtin_bit_cast(bf16x8, w);
    w.x = cvtpk(p1[0], p1[1]); w.y = cvtpk(p1[2], p1[3]); w.z = cvtpk(p1[4], p1[5]); w.w = cvtpk(p1[6], p1[7]); pa[2] = __builtin_bit_cast(bf16x8, w);
    w.x = cvtpk(p1[8], p1[9]); w.y = cvtpk(p1[10], p1[11]); w.z = cvtpk(p1[12], p1[13]); w.w = cvtpk(p1[14], p1[15]); pa[3] = __builtin_bit_cast(bf16x8, w);
}
struct E16 { float v[16]; };
__device__ __forceinline__ void soft_half(f32x16& p, bf16x8& paA, bf16x8& paB, float& lsum, int jb, int wid, int half) {
    if (jb >= 0) {
        const int ln = (int)lane_id(), hh = ln >> 5, qrel = wid * 32 + (ln & 31);
#pragma unroll
        for (int r = 0; r < 16; ++r) { const int kr = 64 * jb + 32 * half + (r & 7) + 8 * hh + 16 * (r >> 3); if (kr > qrel) p[r] = -INFINITY; }
    }
    float e[16];
#pragma unroll
    for (int r = 0; r < 16; ++r) e[r] = __builtin_amdgcn_exp2f(p[r]);
    const float s0 = (e[0] + e[1]) + (e[2] + e[3]), s1 = (e[4] + e[5]) + (e[6] + e[7]), s2 = (e[8] + e[9]) + (e[10] + e[11]), s3 = (e[12] + e[13]) + (e[14] + e[15]);
    lsum += (s0 + s1) + (s2 + s3);
    v4u w;
    w.x = cvtpk(e[0], e[1]); w.y = cvtpk(e[2], e[3]); w.z = cvtpk(e[4], e[5]); w.w = cvtpk(e[6], e[7]); paA = __builtin_bit_cast(bf16x8, w);
    w.x = cvtpk(e[8], e[9]); w.y = cvtpk(e[10], e[11]); w.z = cvtpk(e[12], e[13]); w.w = cvtpk(e[14], e[15]); paB = __builtin_bit_cast(bf16x8, w);
    asm volatile("" : "+v"(paA), "+v"(paB), "+v"(lsum));
}
__device__ __forceinline__ void exp_half(f32x16& p, E16& e, int jb, int wid, int half) {
    if (jb >= 0) {
        const int ln = (int)lane_id(), hh = ln >> 5, qrel = wid * 32 + (ln & 31);
#pragma unroll
        for (int r = 0; r < 16; ++r) { const int kr = 64 * jb + 32 * half + (r & 7) + 8 * hh + 16 * (r >> 3); if (kr > qrel) p[r] = -INFINITY; }
    }
#pragma unroll
    for (int r = 0; r < 16; ++r) e.v[r] = __builtin_amdgcn_exp2f(p[r]);
    asm volatile("" : "+v"(e.v[0]), "+v"(e.v[1]), "+v"(e.v[2]), "+v"(e.v[3]), "+v"(e.v[4]), "+v"(e.v[5]), "+v"(e.v[6]), "+v"(e.v[7]),
                      "+v"(e.v[8]), "+v"(e.v[9]), "+v"(e.v[10]), "+v"(e.v[11]), "+v"(e.v[12]), "+v"(e.v[13]), "+v"(e.v[14]), "+v"(e.v[15]));
}
__device__ __forceinline__ void pack_half(const E16& e, bf16x8& paA, bf16x8& paB, float& lsum) {
    const float* p = e.v;
    float s0 = (p[0] + p[1]) + (p[2] + p[3]), s1 = (p[4] + p[5]) + (p[6] + p[7]), s2 = (p[8] + p[9]) + (p[10] + p[11]), s3 = (p[12] + p[13]) + (p[14] + p[15]);
    lsum += (s0 + s1) + (s2 + s3);
    v4u w;
    w.x = cvtpk(p[0], p[1]); w.y = cvtpk(p[2], p[3]); w.z = cvtpk(p[4], p[5]); w.w = cvtpk(p[6], p[7]); paA = __builtin_bit_cast(bf16x8, w);
    w.x = cvtpk(p[8], p[9]); w.y = cvtpk(p[10], p[11]); w.z = cvtpk(p[12], p[13]); w.w = cvtpk(p[14], p[15]); paB = __builtin_bit_cast(bf16x8, w);
}
__device__ __forceinline__ void softmax_half(f32x16& p, bf16x8& paA, bf16x8& paB, float& lsum, int jb, int qrel, int hh, float mshift, int half) {
    if (jb >= 0) {
#pragma unroll
        for (int r = 0; r < 16; ++r) { const int kr = 64 * jb + 32 * half + (r & 7) + 8 * hh + 16 * (r >> 3); if (kr > qrel) p[r] = -INFINITY; }
    }
    float s = 0.f;
#pragma unroll
    for (int r = 0; r < 16; ++r) { p[r] = __builtin_amdgcn_exp2f(p[r] - mshift); s += p[r]; }
    lsum += s;
    v4u w;
    w.x = cvtpk(p[0], p[1]); w.y = cvtpk(p[2], p[3]); w.z = cvtpk(p[4], p[5]); w.w = cvtpk(p[6], p[7]); paA = __builtin_bit_cast(bf16x8, w);
    w.x = cvtpk(p[8], p[9]); w.y = cvtpk(p[10], p[11]); w.z = cvtpk(p[12], p[13]); w.w = cvtpk(p[14], p[15]); paB = __builtin_bit_cast(bf16x8, w);
}
__device__ __forceinline__ void attn_unit(int bh, int qb, unsigned char* ws, LAS unsigned char* lds, float mshift, float lam, const float* gain) {
    int tid = tid_x(); asm volatile("" : "+v"(tid));
    const int lane = tid & 63, wid = __builtin_amdgcn_readfirstlane(tid >> 6), r32 = lane & 31, hh = lane >> 5;
    const int NTL = 4 * (qb + 1);
    const unsigned char* kgu = ws + WS_KIMG + ((size_t)bh << 20) + wid * 1024;
    const unsigned char* vgu = ws + WS_VIMG + ((size_t)bh << 20) + wid * 1024;

    {
        const unsigned char* Qg = ws + WS_QT + ((size_t)bh * 4096 + qb * 256 + wid * 32) * 256;
#pragma unroll
        for (int i = 0; i < 8; ++i) { const unsigned row = 8u * (i >> 1) + (((unsigned)lane >> 2) & 7u), ch = 4u * (2u * (i & 1) + ((unsigned)lane >> 5)) + (((unsigned)lane & 3u) ^ ((row >> 2) & 3u));
            __builtin_amdgcn_global_load_lds((const unsigned*)(Qg + row * 256 + ch * 16), (LAS unsigned*)(lds + LDS_STG + wid * 8192 + i * 1024), 16, 0, 0); }
    }
    const LAS unsigned char* Qb = lds + LDS_STG + wid * 8192;
#define ATT_DMA_K(t, slot) do { const unsigned char* tb_ = kgu + ((size_t)(t) << 14); \
        const unsigned lo16 = lane_id() * 16u; __builtin_amdgcn_global_load_lds((const unsigned*)(tb_ + lo16), (LAS unsigned*)(lds + LDS_K + (slot) * SLOT + wid * 1024), 16, 0, 0); \
        __builtin_amdgcn_global_load_lds((const unsigned*)(tb_ + 8192 + lo16), (LAS unsigned*)(lds + LDS_K + (slot) * SLOT + 8192 + wid * 1024), 16, 0, 0); } while (0)
#define ATT_DMA_V(t, slot) do { const unsigned char* tb_ = vgu + ((size_t)(t) << 14); \
        const unsigned lo16 = lane_id() * 16u; __builtin_amdgcn_global_load_lds((const unsigned*)(tb_ + lo16), (LAS unsigned*)(lds + LDS_V + (slot) * SLOT + wid * 1024), 16, 0, 0); \
        __builtin_amdgcn_global_load_lds((const unsigned*)(tb_ + 8192 + lo16), (LAS unsigned*)(lds + LDS_V + (slot) * SLOT + 8192 + wid * 1024), 16, 0, 0); } while (0)
    ATT_DMA_K(0, 0); ATT_DMA_V(0, 0);
    f32x16 o1[4], o2[4];
#pragma unroll
    for (int c = 0; c < 4; ++c)
#pragma unroll
        for (int r = 0; r < 16; ++r) { o1[c][r] = 0.f; o2[c][r] = 0.f; }
    float l1 = 0.f, l2 = 0.f;
    const unsigned krb = 2048u * ((unsigned)r32 >> 3) + 64u * ((unsigned)r32 & 7u), krs = ((unsigned)r32 >> 2) & 3u;
    const unsigned kr0 = krb + 16u * (hh ^ krs);
    const unsigned tq = ((unsigned)lane & 15u) >> 2, tp = (unsigned)lane & 3u, tblk = ((unsigned)lane >> 4) & 1u;
    const unsigned tvb = 2048u * hh + 64u * tq + 8u * (tp & 1u), tvx = (2u * tblk + (tp >> 1)) ^ (2u * hh);
    const unsigned tv0 = tvb + 16u * tvx;
    const int NPH = 2 * NTL;
#define ATT_BOUNDARY(ph_) do { const int ph__ = (ph_); \
        if (ph__ + 1 < NPH) asm volatile("s_waitcnt vmcnt(2) lgkmcnt(0)\n\ts_barrier" ::: "memory"); else asm volatile("s_waitcnt vmcnt(0) lgkmcnt(0)\n\ts_barrier" ::: "memory"); \
        const int m__ = ph__ + 2; if (m__ < NPH) { if (m__ & 1) ATT_DMA_V(m__ >> 1, (m__ >> 1) & 1); else ATT_DMA_K(m__ >> 1, (m__ >> 1) & 1); } } while (0)
#define ATT_SB() __builtin_amdgcn_sched_barrier(0)
#define ATT_KADDR(m_, j_) ((((j_) & 1) ? (kr0 ^ 32u) : kr0) + 512u * (2 * (m_) + ((j_) >> 1)))
#define ATT_LDQ(m_) do { _Pragma("unroll") for (int j = 0; j < 4; ++j) qF[j] = *(const LAS bf16x8*)(Qb + ATT_KADDR(m_, j)); } while (0)
#define ATT_LDK(m_, h_) do { _Pragma("unroll") for (int j = 0; j < 4; ++j) kF[j] = *(const LAS bf16x8*)(Kb + ATT_KADDR(m_, j) + 8192 * (h_)); } while (0)
#define ATT_CHAIN() do { _Pragma("unroll") for (int r = 0; r < 16; ++r) p[r] = -mshift; _Pragma("unroll") for (int j = 0; j < 4; ++j) p = ATT_MFMA(kF[j], qF[j], p); } while (0)
#define ATT_X(t_) do { const int jb = (t_) - (NTL - 4); const LAS unsigned char* Kb = lds + LDS_K + ((t_) & 1) * SLOT; bf16x8 qF[4], kF[4]; f32x16 p; \
        ATT_LDQ(0); ATT_LDK(0, 0); ATT_SB(); \
        ATT_CHAIN(); ATT_SB(); ATT_LDK(0, 1); ATT_SB(); soft_half(p, pa1[0], pa1[1], l1, jb, wid, 0); ATT_SB(); \
        ATT_CHAIN(); ATT_SB(); ATT_LDQ(1); ATT_LDK(1, 0); ATT_SB(); soft_half(p, pa1[2], pa1[3], l1, jb, wid, 1); ATT_SB(); \
        ATT_CHAIN(); ATT_SB(); ATT_LDK(1, 1); ATT_SB(); soft_half(p, pa2[0], pa2[1], l2, jb, wid, 0); ATT_SB(); \
        ATT_CHAIN(); ATT_SB(); soft_half(p, pa2[2], pa2[3], l2, jb, wid, 1); ATT_SB(); } while (0)
#define ATT_VLOAD(buf, i) asm volatile("ds_read_b64_tr_b16 %0, %2 offset:%c4\n\tds_read_b64_tr_b16 %1, %3 offset:%c4" : "=&v"(vlo[buf]), "=&v"(vhi[buf]) : "v"(va0), "v"(va1), "i"(4096 * ((i) & 3) + 512 * ((i) >> 2)) : "memory")
#define ATT_Y(t_) do { const unsigned va0 = (unsigned)(uintptr_t)(lds + LDS_V + ((t_) & 1) * SLOT) + tv0, va1 = (unsigned)(uintptr_t)(lds + LDS_V + ((t_) & 1) * SLOT) + (tv0 ^ 16u) + 256u; \
        s16x4 vlo[3], vhi[3]; ATT_VLOAD(0, 0); ATT_VLOAD(1, 1); \
        _Pragma("unroll") for (int i = 0; i < 16; ++i) { if (i + 2 < 16) ATT_VLOAD((i + 2) % 3, i + 2); \
            if (i + 2 < 16) asm volatile("s_waitcnt lgkmcnt(4)" : "+v"(vlo[i % 3]), "+v"(vhi[i % 3]) :: "memory"); \
            else if (i + 1 < 16) asm volatile("s_waitcnt lgkmcnt(2)" : "+v"(vlo[i % 3]), "+v"(vhi[i % 3]) :: "memory"); \
            else asm volatile("s_waitcnt lgkmcnt(0)" : "+v"(vlo[i % 3]), "+v"(vhi[i % 3]) :: "memory"); \
            const bf16x8 vf = __builtin_shufflevector(vlo[i % 3], vhi[i % 3], 0, 1, 2, 3, 4, 5, 6, 7); \
            o1[i >> 2] = ATT_MFMA(pa1[i & 3], vf, o1[i >> 2]); o2[i >> 2] = ATT_MFMA(pa2[i & 3], vf, o2[i >> 2]); } } while (0)
    if (wid < 4) {
        for (int t = 0; t < NTL; ++t) {
            const bool on = (t - (NTL - 4)) <= (wid >> 1);
            bf16x8 pa1[4], pa2[4];
            ATT_BOUNDARY(2 * t);
            if (on) { __builtin_amdgcn_s_setprio(3); ATT_X(t); __builtin_amdgcn_s_setprio(0); }
            ATT_BOUNDARY(2 * t + 1);
            if (on) ATT_Y(t);
        }
        ATT_BOUNDARY(NPH);
    } else {
        ATT_BOUNDARY(0);
        for (int t = 0; t < NTL; ++t) {
            const bool on = (t - (NTL - 4)) <= (wid >> 1);
            bf16x8 pa1[4], pa2[4];
            ATT_BOUNDARY(2 * t + 1);
            if (on) { __builtin_amdgcn_s_setprio(3); ATT_X(t); __builtin_amdgcn_s_setprio(0); }
            ATT_BOUNDARY(2 * t + 2);
            if (on) ATT_Y(t);
        }
    }
#undef ATT_BOUNDARY
#undef ATT_X
#undef ATT_Y
#undef ATT_KADDR
#undef ATT_LDQ
#undef ATT_LDK
#undef ATT_CHAIN
#undef ATT_VLOAD
#undef ATT_SB
    { auto rr = __builtin_amdgcn_permlane32_swap(__float_as_uint(l1), __float_as_uint(l1), false, false); l1 = __uint_as_float(rr[0]) + __uint_as_float(rr[1]); }
    { auto rr = __builtin_amdgcn_permlane32_swap(__float_as_uint(l2), __float_as_uint(l2), false, false); l2 = __uint_as_float(rr[0]) + __uint_as_float(rr[1]); }
    int lane_e = (int)lane_id(); asm volatile("" : "+v"(lane_e));
    const int hh_e = lane_e >> 5, r32_e = lane_e & 31;
    LAS float* lw = (LAS float*)(lds + LDS_L) + wid * 64;
    if (hh_e == 0) { lw[r32_e] = 1.0f / l1; lw[32 + r32_e] = lam / l2; }
    asm volatile("s_waitcnt lgkmcnt(0)" ::: "memory");
    float ssq[16];
#pragma unroll
    for (int r = 0; r < 16; ++r) { const int qr = (r & 3) + 8 * (r >> 2) + 4 * hh_e; const float i1 = lw[qr], i2 = lw[32 + qr]; float s = 0.f;
#pragma unroll
        for (int c = 0; c < 4; ++c) { const float o = o1[c][r] * i1 - o2[c][r] * i2; o1[c][r] = o; s += o * o; }
        ssq[r] = s; }
#pragma unroll
    for (int r = 0; r < 16; ++r) { float s = ssq[r]; s += swz_xor<1>(s); s += swz_xor<2>(s); s += swz_xor<4>(s); s += swz_xor<8>(s); s += swz_xor<16>(s); ssq[r] = 0.8f / sqrtf(s * (1.0f / 128.0f) + EPS); }
    LAS bf16* stg = (LAS bf16*)(lds + LDS_STG) + wid * 4096;
    float gn[4];
#pragma unroll
    for (int c = 0; c < 4; ++c) gn[c] = gain[32 * c + r32_e];
#pragma unroll
    for (int r = 0; r < 16; ++r) { const int qr = (r & 3) + 8 * (r >> 2) + 4 * hh_e;
#pragma unroll
        for (int c = 0; c < 4; ++c) stg[qr * 128 + 32 * c + r32_e] = (bf16)f2bf(o1[c][r] * ssq[r] * gn[c]); }
    asm volatile("s_waitcnt lgkmcnt(0)" ::: "memory");
    bf16* og = (bf16*)(ws + WS_ODA) + ((size_t)(bh >> 2) * 4096 + qb * 256 + wid * 32) * 512 + 128 * (bh & 3);
#pragma unroll
    for (int i = 0; i < 8; ++i) { const int row = i * 4 + (lane_e >> 4), chk = lane_e & 15; *(v4u*)(og + (size_t)row * 512 + chk * 8) = *(const LAS v4u*)(stg + row * 128 + chk * 8); }
    asm volatile("s_waitcnt vmcnt(0) lgkmcnt(0)\n\ts_barrier" ::: "memory");
#undef ATT_DMA_K
#undef ATT_DMA_V
}
__device__ __forceinline__ void attn_phase(unsigned char* ws, LAS unsigned char* lds, int vcu, int G, const float* gain) {
    const float* sm = (const float*)(ws + WS_SMALL);
    const float lam = __uint_as_float(__builtin_amdgcn_readfirstlane(__float_as_uint(sm[512]))), mshift = __uint_as_float(__builtin_amdgcn_readfirstlane(__float_as_uint(sm[513])));
    for (int p = vcu; p < 256; p += G) {
        const int bh = p >> 3, s = p & 7;
        for (int uu = 0; uu < 2; ++uu) attn_unit(bh, uu ? s : 15 - s, ws, lds, mshift, lam, gain);
    }
}
}

namespace hg {
constexpr int L_HQ = 0, L_HF = 16384, L_HI = 32768, L_HOG = 49152, L_QD = 65536, L_ST = 81920, L_O = 114688, L_PS = 147456;
#define HG_MFMA(a, b, c) __builtin_amdgcn_mfma_f32_32x32x16_bf16((a), (b), (c), 0, 0, 0)
__device__ __forceinline__ void dma16k(const unsigned char* g, LAS unsigned char* l, int wid, int lane) {
    __builtin_amdgcn_global_load_lds((const unsigned*)(g + wid * 1024 + lane * 16), (LAS unsigned*)(l + wid * 1024), 16, 0, 0);
    __builtin_amdgcn_global_load_lds((const unsigned*)(g + 8192 + wid * 1024 + lane * 16), (LAS unsigned*)(l + 8192 + wid * 1024), 16, 0, 0);
}
__device__ __forceinline__ bf16x8 trfrag(const LAS unsigned char* base, unsigned tv0, unsigned tv1, int c, int ks) {
    const s16x4 lo = att::vtr(base + tv0 + 4096 * ks + 512 * c), hi = att::vtr(base + tv1 + 4096 * ks + 512 * c);
    return __builtin_shufflevector(lo, hi, 0, 1, 2, 3, 4, 5, 6, 7);
}
__device__ __forceinline__ void tr3_asm(bf16x8& f0, bf16x8& f1, bf16x8& f2, unsigned a00, unsigned a01, unsigned a10, unsigned a11, unsigned a20, unsigned a21) {
    s16x4 l0, h0, l1, h1, l2, h2;
    asm volatile("ds_read_b64_tr_b16 %0, %6\n\tds_read_b64_tr_b16 %1, %7\n\tds_read_b64_tr_b16 %2, %8\n\tds_read_b64_tr_b16 %3, %9\n\tds_read_b64_tr_b16 %4, %10\n\tds_read_b64_tr_b16 %5, %11\n\ts_waitcnt lgkmcnt(0)"
                 : "=&v"(l0), "=&v"(h0), "=&v"(l1), "=&v"(h1), "=&v"(l2), "=&v"(h2) : "v"(a00), "v"(a01), "v"(a10), "v"(a11), "v"(a20), "v"(a21) : "memory");
    f0 = __builtin_shufflevector(l0, h0, 0, 1, 2, 3, 4, 5, 6, 7); f1 = __builtin_shufflevector(l1, h1, 0, 1, 2, 3, 4, 5, 6, 7); f2 = __builtin_shufflevector(l2, h2, 0, 1, 2, 3, 4, 5, 6, 7);
}
__device__ __forceinline__ void tr2_asm(bf16x8& f0, bf16x8& f1, unsigned a00, unsigned a01, unsigned a10, unsigned a11) {
    s16x4 l0, h0, l1, h1;
    asm volatile("ds_read_b64_tr_b16 %0, %4\n\tds_read_b64_tr_b16 %1, %5\n\tds_read_b64_tr_b16 %2, %6\n\tds_read_b64_tr_b16 %3, %7\n\ts_waitcnt lgkmcnt(0)"
                 : "=&v"(l0), "=&v"(h0), "=&v"(l1), "=&v"(h1) : "v"(a00), "v"(a01), "v"(a10), "v"(a11) : "memory");
    f0 = __builtin_shufflevector(l0, h0, 0, 1, 2, 3, 4, 5, 6, 7); f1 = __builtin_shufflevector(l1, h1, 0, 1, 2, 3, 4, 5, 6, 7);
}
__device__ __forceinline__ bf16x8 rowfrag(const LAS unsigned char* base, unsigned kr0, unsigned kr1, int rblk, int s) {
    return *(const LAS bf16x8*)(base + 8192 * rblk + ((s & 1) ? kr1 : kr0) + 512 * (s >> 1));
}
__device__ __forceinline__ bf16x8 pack_lo(const f32x16& p) { v4u w; w.x = cvtpk(p[0], p[1]); w.y = cvtpk(p[2], p[3]); w.z = cvtpk(p[4], p[5]); w.w = cvtpk(p[6], p[7]); return __builtin_bit_cast(bf16x8, w); }
__device__ __forceinline__ bf16x8 pack_hi(const f32x16& p) { v4u w; w.x = cvtpk(p[8], p[9]); w.y = cvtpk(p[10], p[11]); w.z = cvtpk(p[12], p[13]); w.w = cvtpk(p[14], p[15]); return __builtin_bit_cast(bf16x8, w); }

__device__ __forceinline__ void b1_group(int bh, int s8, unsigned char* ws, LAS unsigned char* lds) {
    int tid = tid_x(); asm volatile("" : "+v"(tid));
    const int lane = tid & 63, wid = __builtin_amdgcn_readfirstlane(tid >> 6), r32 = lane & 31, hh = lane >> 5;
    const int k2 = lane;
    const float lb0 = ((const float*)(ws + WS_SMALL))[128 * (bh & 3) + 2 * k2], lb1 = ((const float*)(ws + WS_SMALL))[128 * (bh & 3) + 2 * k2 + 1];
    LAS float* ps = (LAS float*)(lds + L_PS);
    const unsigned tq = ((unsigned)lane & 15u) >> 2, tp = (unsigned)lane & 3u, tblk = ((unsigned)lane >> 4) & 1u;
    const unsigned tvb = 2048u * hh + 64u * tq + 8u * (tp & 1u), tvx = (2u * tblk + (tp >> 1)) ^ (2u * hh);
    const unsigned tv0 = tvb + 16u * tvx, tv1 = tvb + 256u + 16u * (tvx ^ 1u);
    const int kb = wid >> 1, vb0 = 2 * (wid & 1);
    { const int item = bh * 64 + s8; dma16k(ws + WS_HF + ((size_t)item << 14), lds, wid, lane); dma16k(ws + WS_HI + ((size_t)item << 14), lds + 16384, wid, lane); }
    for (int j = 0; j < 8; ++j) {
        const int item = bh * 64 + s8 + 8 * j; LAS unsigned char* B = lds + (j & 1) * 32768;
        if (j + 1 < 8) { LAS unsigned char* Bn = lds + ((j + 1) & 1) * 32768; dma16k(ws + WS_HF + ((size_t)(item + 8) << 14), Bn, wid, lane); dma16k(ws + WS_HI + ((size_t)(item + 8) << 14), Bn + 16384, wid, lane);
            asm volatile("s_waitcnt vmcnt(4)\n\ts_barrier" ::: "memory"); }
        else asm volatile("s_waitcnt vmcnt(0)\n\ts_barrier" ::: "memory");
        float f0[8], f1[8], c0[8], c1[8]; float r0 = 0.f, r1 = 0.f;
#pragma unroll
        for (int i = 0; i < 8; ++i) { const unsigned w = *(const LAS unsigned*)(B + img_off_a(8 * wid + i, 2 * k2));
            const float h0 = __uint_as_float(w << 16), h1 = __uint_as_float(w & 0xffff0000u);
            f0[i] = lb0 + (1.0f - lb0) * rcpf_(1.0f + __expf(-h0)); f1[i] = lb1 + (1.0f - lb1) * rcpf_(1.0f + __expf(-h1));
            r0 += __logf(f0[i]); r1 += __logf(f1[i]); c0[i] = r0; c1[i] = r1; }
        *(LAS f32x2*)(ps + wid * 128 + 2 * k2) = (f32x2){r0, r1};
        asm volatile("s_waitcnt lgkmcnt(0)\n\ts_barrier" ::: "memory");
        float base0 = 0.f, base1 = 0.f, tot0 = 0.f, tot1 = 0.f;
#pragma unroll
        for (int w = 0; w < 8; ++w) { const f32x2 p = *(const LAS f32x2*)(ps + w * 128 + 2 * k2); if (w < wid) { base0 += p[0]; base1 += p[1]; } tot0 += p[0]; tot1 += p[1]; }
#pragma unroll
        for (int i = 0; i < 8; ++i) { const float b0 = base0 + c0[i], b1 = base1 + c1[i];
            *(LAS unsigned*)(B + img_off_a(8 * wid + i, 2 * k2)) = cvtpk((1.0f - f0[i]) * __expf(tot0 - b0), (1.0f - f1[i]) * __expf(tot1 - b1)); }
        if (wid == 0) *(f32x2*)((float*)(ws + WS_DECAY) + (size_t)item * 128 + 2 * k2) = (f32x2){__expf(tot0), __expf(tot1)};
        asm volatile("s_waitcnt lgkmcnt(0)\n\ts_barrier" ::: "memory");
        f32x16 a0, a1;
#pragma unroll
        for (int r = 0; r < 16; ++r) { a0[r] = 0.f; a1[r] = 0.f; }
        const unsigned bA = (unsigned)(uintptr_t)B, bI = bA + 16384u;
#pragma unroll
        for (int ks = 0; ks < 4; ++ks) { bf16x8 A, B0, B1;
            tr3_asm(A, B0, B1, bA + tv0 + 4096 * ks + 512 * kb, bA + tv1 + 4096 * ks + 512 * kb, bI + tv0 + 4096 * ks + 512 * vb0, bI + tv1 + 4096 * ks + 512 * vb0, bI + tv0 + 4096 * ks + 512 * (vb0 + 1), bI + tv1 + 4096 * ks + 512 * (vb0 + 1));
            a0 = HG_MFMA(A, B0, a0); a1 = HG_MFMA(A, B1, a1); }
        unsigned char* dst = ws + WS_DST + ((size_t)item << 15);
#pragma unroll
        for (int g = 0; g < 4; ++g) { const unsigned k0 = 32u * kb + 8u * g + 4u * hh;
            *(v2u*)(dst + off_a(32u * vb0 + r32, k0 >> 3) + (k0 & 7u) * 2u) = (v2u){cvtpk(a0[4 * g], a0[4 * g + 1]), cvtpk(a0[4 * g + 2], a0[4 * g + 3])};
            *(v2u*)(dst + off_a(32u * (vb0 + 1) + r32, k0 >> 3) + (k0 & 7u) * 2u) = (v2u){cvtpk(a1[4 * g], a1[4 * g + 1]), cvtpk(a1[4 * g + 2], a1[4 * g + 3])}; }
        asm volatile("s_waitcnt lgkmcnt(0)\n\ts_barrier" ::: "memory");
    }
}

__device__ __forceinline__ void scan_slice(unsigned char* ws, int bh, int e) {
    const unsigned pos = 8u * (unsigned)e;
    const unsigned row = 8u * (pos >> 11) + ((pos >> 6) & 7u), ch = 4u * ((pos >> 9) & 3u) + (((pos >> 4) & 3u) ^ ((row >> 2) & 3u)), k0 = 8u * ch + 4u * ((pos >> 3) & 1u);
    unsigned char* img = ws + WS_DST + ((size_t)bh << 21) + pos; const float* dec = (const float*)(ws + WS_DECAY) + (size_t)bh * 64 * 128 + k0;
    float S0 = 0.f, S1 = 0.f, S2 = 0.f, S3 = 0.f;
    for (int c0 = 0; c0 < 64; c0 += 8) {
        v2u d[8]; f32x4 dc[8];
#pragma unroll
        for (int j = 0; j < 8; ++j) { d[j] = *(const v2u*)(img + ((size_t)(c0 + j) << 15)); dc[j] = *(const f32x4*)(dec + (c0 + j) * 128); }
#pragma unroll
        for (int j = 0; j < 8; ++j) {
            *(v2u*)(img + ((size_t)(c0 + j) << 15)) = (v2u){cvtpk(S0, S1), cvtpk(S2, S3)};
            S0 = dc[j][0] * S0 + __uint_as_float(d[j].x << 16); S1 = dc[j][1] * S1 + __uint_as_float(d[j].x & 0xffff0000u);
            S2 = dc[j][2] * S2 + __uint_as_float(d[j].y << 16); S3 = dc[j][3] * S3 + __uint_as_float(d[j].y & 0xffff0000u);
        }
    }
}
__device__ __forceinline__ void group_barrier(unsigned* w, unsigned target) {
    asm volatile("s_waitcnt vmcnt(0)" ::: "memory");
    __syncthreads();
    if (tid_x() == 0) {
        __builtin_amdgcn_fence(__ATOMIC_RELEASE, "agent");
        asm volatile("s_waitcnt vmcnt(0)" ::: "memory");
        __hip_atomic_fetch_add(w, 1u, __ATOMIC_RELAXED, __HIP_MEMORY_SCOPE_AGENT);
        unsigned sp = 0;
        while (__hip_atomic_load(w, __ATOMIC_RELAXED, __HIP_MEMORY_SCOPE_AGENT) < target) { __builtin_amdgcn_s_sleep(2); if (++sp > (1u << 22)) break; }
        __builtin_amdgcn_fence(__ATOMIC_ACQUIRE, "agent");
        asm volatile("s_waitcnt vmcnt(0)" ::: "memory");
    }
    __syncthreads();
}

__device__ __forceinline__ void b3_group(int bh, int s8, unsigned char* ws, LAS unsigned char* lds, const float* gain) {
    constexpr int B_HQ = 0, B_HF = 16384, B_QD = 32768, B_HI = 49152, B_ST = 81920, B_O = 0;
    int tid = tid_x(); asm volatile("" : "+v"(tid));
    const int lane = tid & 63, wid = __builtin_amdgcn_readfirstlane(tid >> 6), r32 = lane & 31, hh = lane >> 5;
    const int k2 = lane;
    const float lb0 = ((const float*)(ws + WS_SMALL))[128 * (bh & 3) + 2 * k2], lb1 = ((const float*)(ws + WS_SMALL))[128 * (bh & 3) + 2 * k2 + 1];
    LAS float* ps = (LAS float*)(lds + L_PS);
    const unsigned krb = 2048u * ((unsigned)r32 >> 3) + 64u * ((unsigned)r32 & 7u), krs = ((unsigned)r32 >> 2) & 3u;
    const unsigned kr0 = krb + 16u * (hh ^ krs), kr1 = krb + 16u * ((2u + hh) ^ krs);
    const unsigned tq = ((unsigned)lane & 15u) >> 2, tp = (unsigned)lane & 3u, tblk = ((unsigned)lane >> 4) & 1u;
    const unsigned tvb = 2048u * hh + 64u * tq + 8u * (tp & 1u), tvx = (2u * tblk + (tp >> 1)) ^ (2u * hh);
    const unsigned tv0 = tvb + 16u * tvx, tv1 = tvb + 256u + 16u * (tvx ^ 1u);
    const int tb = wid >> 2, vb = wid & 3;
    const int erow = tid >> 3, seg = tid & 7;
    const f32x4 n0 = ((const f32x4*)(gain + 16 * seg))[0], n1 = ((const f32x4*)(gain + 16 * seg))[1], n2 = ((const f32x4*)(gain + 16 * seg))[2], n3 = ((const f32x4*)(gain + 16 * seg))[3];
    { const int item = bh * 64 + s8;
      dma16k(ws + WS_HI + ((size_t)item << 14), lds + B_HI, wid, lane);
      dma16k(ws + WS_DST + ((size_t)item << 15), lds + B_ST, wid, lane); dma16k(ws + WS_DST + ((size_t)item << 15) + 16384, lds + B_ST + 16384, wid, lane); }
    for (int j = 0; j < 8; ++j) {
        const int item = bh * 64 + s8 + 8 * j, bb = j & 1;
        dma16k(ws + WS_HQ + ((size_t)item << 14), lds + B_HQ, wid, lane);
        dma16k(ws + WS_HF + ((size_t)item << 14), lds + B_HF, wid, lane);
        if (j + 1 < 8) { const int nb = bb ^ 1;
            dma16k(ws + WS_HI + ((size_t)(item + 8) << 14), lds + B_HI + nb * 16384, wid, lane);
            dma16k(ws + WS_DST + ((size_t)(item + 8) << 15), lds + B_ST + nb * 32768, wid, lane); dma16k(ws + WS_DST + ((size_t)(item + 8) << 15) + 16384, lds + B_ST + nb * 32768 + 16384, wid, lane); }
        const unsigned char* hogp = ws + WS_HOG + ((size_t)item << 14);
        const v4u g0 = *(const v4u*)(hogp + off_a((unsigned)erow, 2u * seg)), g1 = *(const v4u*)(hogp + off_a((unsigned)erow, 2u * seg + 1u));
        if (j + 1 < 8) asm volatile("s_waitcnt vmcnt(8)\n\ts_barrier" ::: "memory"); else asm volatile("s_waitcnt vmcnt(2)\n\ts_barrier" ::: "memory");
        {
            float f0[8], f1[8], c0[8], c1[8]; float r0 = 0.f, r1 = 0.f;
#pragma unroll
            for (int i = 0; i < 8; ++i) { const unsigned w = *(const LAS unsigned*)(lds + B_HF + img_off_a(8 * wid + i, 2 * k2));
                const float h0 = __uint_as_float(w << 16), h1 = __uint_as_float(w & 0xffff0000u);
                f0[i] = lb0 + (1.0f - lb0) * rcpf_(1.0f + __expf(-h0)); f1[i] = lb1 + (1.0f - lb1) * rcpf_(1.0f + __expf(-h1));
                r0 += __logf(f0[i]); r1 += __logf(f1[i]); c0[i] = r0; c1[i] = r1; }
            *(LAS f32x2*)(ps + wid * 128 + 2 * k2) = (f32x2){r0, r1};
            asm volatile("s_waitcnt lgkmcnt(0)\n\ts_barrier" ::: "memory");
            float base0 = 0.f, base1 = 0.f, ref0 = 0.f, ref1 = 0.f;
#pragma unroll
            for (int w = 0; w < 7; ++w) { const f32x2 p = *(const LAS f32x2*)(ps + w * 128 + 2 * k2); if (w < wid) { base0 += p[0]; base1 += p[1]; } if (w < 4) { ref0 += p[0]; ref1 += p[1]; } }
#pragma unroll
            for (int i = 0; i < 8; ++i) { const unsigned row = 8u * wid + i; const float b0 = base0 + c0[i], b1 = base1 + c1[i];
                const unsigned qw = *(const LAS unsigned*)(lds + B_HQ + img_off_a(row, 2 * k2));
                const float q0 = __uint_as_float(qw << 16), q1 = __uint_as_float(qw & 0xffff0000u);
                *(LAS unsigned*)(lds + B_HQ + img_off_a(row, 2 * k2)) = cvtpk(q0 * __expf(b0 - ref0), q1 * __expf(b1 - ref1));
                *(LAS unsigned*)(lds + B_QD + img_off_a(row, 2 * k2)) = cvtpk(q0 * __expf(b0), q1 * __expf(b1));
                *(LAS unsigned*)(lds + B_HF + img_off_a(kappa(row), 2 * k2)) = cvtpk((1.0f - f0[i]) * __expf(ref0 - b0), (1.0f - f1[i]) * __expf(ref1 - b1)); }
        }
        asm volatile("s_waitcnt lgkmcnt(0)\n\ts_barrier" ::: "memory");
        f32x16 o;
#pragma unroll
        for (int r = 0; r < 16; ++r) o[r] = 0.f;
        const int tcol = 32 * tb + r32;
        const unsigned bI = (unsigned)(uintptr_t)(lds + B_HI + bb * 16384);
        {
            f32x16 p;
#pragma unroll
            for (int r = 0; r < 16; ++r) p[r] = 0.f;
#pragma unroll
            for (int sI = 0; sI < 8; ++sI) p = HG_MFMA(rowfrag(lds + B_HF, kr0, kr1, 0, sI), rowfrag(lds + B_HQ, kr0, kr1, tb, sI), p);
#pragma unroll
            for (int r = 0; r < 16; ++r) { const int srel = (r & 7) + 8 * hh + 16 * (r >> 3); if (srel > tcol) p[r] = 0.f; }
            bf16x8 v0, v1; tr2_asm(v0, v1, bI + tv0 + 512 * vb, bI + tv1 + 512 * vb, bI + tv0 + 4096 + 512 * vb, bI + tv1 + 4096 + 512 * vb);
            o = HG_MFMA(pack_lo(p), v0, o); o = HG_MFMA(pack_hi(p), v1, o);
        }
        if (tb == 1) {
            f32x16 p;
#pragma unroll
            for (int r = 0; r < 16; ++r) p[r] = 0.f;
#pragma unroll
            for (int sI = 0; sI < 8; ++sI) p = HG_MFMA(rowfrag(lds + B_HF, kr0, kr1, 1, sI), rowfrag(lds + B_HQ, kr0, kr1, 1, sI), p);
#pragma unroll
            for (int r = 0; r < 16; ++r) { const int srel = 32 + (r & 7) + 8 * hh + 16 * (r >> 3); if (srel > tcol) p[r] = 0.f; }
            bf16x8 v0, v1; tr2_asm(v0, v1, bI + tv0 + 8192 + 512 * vb, bI + tv1 + 8192 + 512 * vb, bI + tv0 + 12288 + 512 * vb, bI + tv1 + 12288 + 512 * vb);
            o = HG_MFMA(pack_lo(p), v0, o); o = HG_MFMA(pack_hi(p), v1, o);
        }
#pragma unroll
        for (int sI = 0; sI < 8; ++sI) o = HG_MFMA(rowfrag(lds + B_QD, kr0, kr1, tb, sI), rowfrag(lds + B_ST + bb * 32768, kr0, kr1, vb, sI), o);
        asm volatile("s_waitcnt lgkmcnt(0)\n\ts_barrier" ::: "memory");
        LAS float* O = (LAS float*)(lds + B_O);
#pragma unroll
        for (int r = 0; r < 16; ++r) O[(32 * tb + (r & 3) + 8 * (r >> 2) + 4 * hh) * 128 + 32 * vb + r32] = o[r];
        asm volatile("s_waitcnt lgkmcnt(0)\n\ts_barrier" ::: "memory");
        {
            const LAS f32x4* op = (const LAS f32x4*)(O + erow * 128 + 16 * seg);
            f32x4 v0 = op[0], v1 = op[1], v2 = op[2], v3 = op[3];
            float sq = 0.f;
#pragma unroll
            for (int e = 0; e < 4; ++e) sq += v0[e] * v0[e] + v1[e] * v1[e] + v2[e] * v2[e] + v3[e] * v3[e];
            sq += swz_xor<1>(sq); sq += swz_xor<2>(sq); sq += swz_xor<4>(sq);
            const float rstd = __builtin_amdgcn_rsqf(sq * (1.0f / 128.0f) + EPS);
            float y[16];
#pragma unroll
            for (int e = 0; e < 4; ++e) { y[e] = v0[e] * n0[e]; y[4 + e] = v1[e] * n1[e]; y[8 + e] = v2[e] * n2[e]; y[12 + e] = v3[e] * n3[e]; }
#pragma unroll
            for (int e = 0; e < 4; ++e) { const float a = __uint_as_float(g0[e] << 16), b = __uint_as_float(g0[e] & 0xffff0000u), c = __uint_as_float(g1[e] << 16), d = __uint_as_float(g1[e] & 0xffff0000u);
                y[2 * e] *= rstd * a * rcpf_(1.0f + __expf(-a)); y[2 * e + 1] *= rstd * b * rcpf_(1.0f + __expf(-b)); y[8 + 2 * e] *= rstd * c * rcpf_(1.0f + __expf(-c)); y[9 + 2 * e] *= rstd * d * rcpf_(1.0f + __expf(-d)); }
            const int c = item & 63;
            bf16* dst = (bf16*)(ws + WS_OHG) + ((size_t)(bh >> 2) * 4096 + 64 * c + erow) * 512 + 128 * (bh & 3) + 16 * seg;
            v4u w0, w1;
            w0.x = cvtpk(y[0], y[1]); w0.y = cvtpk(y[2], y[3]); w0.z = cvtpk(y[4], y[5]); w0.w = cvtpk(y[6], y[7]);
            w1.x = cvtpk(y[8], y[9]); w1.y = cvtpk(y[10], y[11]); w1.z = cvtpk(y[12], y[13]); w1.w = cvtpk(y[14], y[15]);
            *(v4u*)dst = w0; *(v4u*)(dst + 8) = w1;
        }
        asm volatile("s_waitcnt lgkmcnt(0)\n\ts_barrier" ::: "memory");
    }
}
}

__global__ void __launch_bounds__(NWAVES * 64, 2) mega(Args args) {
    LAS unsigned char* lds = (LAS unsigned char*)lds_raw;
    volatile LAS unsigned* MISC = (volatile LAS unsigned*)(lds + MISC_OFF);
    { const int t0_ = threadIdx.x; if ((t0_ & 63) == 0) *(volatile LAS int*)(lds + MISC_OFF + 256 + 4 * ((unsigned)__builtin_amdgcn_s_getreg((5 << 11) | 4) & 63u)) = t0_ >> 6; if (t0_ < 64) MISC[t0_] = 0u; }
    __syncthreads();
    const int wave = wave_idx();
    const int G = gridDim.x; const int bx = blockIdx.x; const int vcu = (G % 8 == 0) ? (bx % 8) * (G / 8) + bx / 8 : bx;
    unsigned char* ws = args.ws;
    const int lo = args.ph_lo, hi = args.ph_hi;
    XcdBarrier bar; bar.bar = (unsigned*)(ws + WS_CTL) + CW_BAR + args.li * XCD_BAR_WORDS; bar.x = 0; bar.st = nullptr;
    if (hi - lo > 1) bar = xcd_barrier_post((unsigned*)(ws + WS_CTL) + CW_BAR + args.li * XCD_BAR_WORDS, MISC + 8);
#define IN(k) (lo <= (k) && (k) < hi)
#define BOTH(k) (IN(k) && IN((k) + 1))
    if (IN(0)) { p0_prologue(args, lds, vcu, G, wave, (int)lane_id()); if (BOTH(0)) xcd_barrier(bar); }
    if (IN(1)) {
        pg8::DenseOrder S; S.init(ws + WS_H, ws + WS_WIN, NT, NCOLS, DM, G, bx);
        EpiProj E{ws, (bf16*)args.out, args.in[5], args.in[6]};
        pg8::gemm_phase<EpiProj, pg8::DenseOrder, true>(lds + RING_OFF, DM, S, E);
        if (BOTH(1)) xcd_barrier(bar);
    }
    if (IN(2)) {
        const int bh = vcu >> 3, s8 = vcu & 7; unsigned* gw = (unsigned*)(ws + WS_CTL) + CW_GRP + bh * 64;
        if (G != 256) { if (tid_x() == 0) __hip_atomic_store((unsigned*)(ws + WS_CTL) + CW_BAR + XB_TMO, 0x7f0u, __ATOMIC_RELAXED, __HIP_MEMORY_SCOPE_AGENT); }
        if (bh & 1) att::attn_phase(ws, lds, vcu, G, args.in[8]);
        w13_convert(args, lds, vcu, G, wave, (int)lane_id()); __syncthreads();
        hg::b1_group(bh, s8, ws, lds);
        hg::group_barrier(gw, 8u);
        hg::scan_slice(ws, bh, s8 * 512 + tid_x());
        hg::group_barrier(gw, 16u);
        hg::b3_group(bh, s8, ws, lds, args.in[4]);
        if (!(bh & 1)) att::attn_phase(ws, lds, vcu, G, args.in[8]);
        if (BOTH(2)) xcd_barrier(bar);
    }
    if (IN(5)) {
        BranchOrder S; S.d.init(ws + WS_OHG, ws + WS_WHG, NT, DM, 512, G, bx); S.A2 = (const char*)(ws + WS_ODA); S.B2 = (const char*)(ws + WS_WDA);
        EpiBranch E{(const bf16*)args.out, (bf16*)(ws + WS_MIXED)};
        pg8::gemm_phase<EpiBranch, BranchOrder, true>(lds + RING_OFF, 512, S, E);
        if (BOTH(5)) xcd_barrier(bar);
    }
    if (IN(6)) {
        pg8::DenseOrder S; S.init(ws + WS_MIXED, ws + WS_WOUT, NT, DM, DM, G, bx);
        EpiOut E{args.in[0], args.out};
        pg8::gemm_phase<EpiOut, pg8::DenseOrder, true>(lds + RING_OFF, DM, S, E);
        if (BOTH(6)) xcd_barrier(bar);
    }
    if (IN(7)) { router_phase(args, lds, G, wave, (int)lane_id()); if (BOTH(7)) xcd_barrier(bar); }
    if (IN(8)) {
        moe_sched_setup(args, lds);
        const LAS int* pref = (const LAS int*)(lds + SCHED_OFF); const LAS int* cnt = pref + 80;
        MoeOrderT<1> S{pref, cnt, (const v2u*)(ws + WS_ROWTOK), (const char*)(ws + WS_XN), (const char*)(ws + WS_W13T), DM / 2, (size_t)DM * DM, 1, 0, 64, 4, G, bx};
        EpiUp E{pref, cnt, ws + WS_HID};
        pg8::gemm_phase<EpiUp, MoeOrderT<1>, true, true, 122>(lds + RING_OFF, DM / 2, S, E);
        if (BOTH(8)) xcd_barrier(bar);
    }
    if (IN(9)) {
        moe_sched_setup(args, lds);
        const LAS int* pref = (const LAS int*)(lds + SCHED_OFF); const LAS int* cnt = pref + 80;
        MoeOrderT<0> S{pref, cnt, (const v2u*)(ws + WS_ROWTOK), (const char*)(ws + WS_HID), (const char*)(ws + WS_W2T), DFF / 2, (size_t)DM * DFF, 0, 0, 64, 4, G, bx};
        EpiDown E{pref, cnt, (bf16*)(ws + WS_YS)};
        pg8::gemm_phase<EpiDown, MoeOrderT<0>, true, true, 123>(lds + RING_OFF, DFF / 2, S, E);
        if (BOTH(9)) xcd_barrier(bar);
    }
    if (IN(10)) {
        moe_sched_setup(args, lds);
        const LAS int* pref = (const LAS int*)(lds + SCHED_OFF);
        float* out = args.out; const bf16* y = (const bf16*)(ws + WS_YS); const v2u* tp = (const v2u*)(ws + WS_TOKPOS);
        for (int i = bx * 512 + tid_x(); i < NT * (DM / 8); i += G * 512) {
            const int t = i >> 7, c = (i & 127) * 8;
            const v2u p0 = tp[2 * (size_t)t], p1 = tp[2 * (size_t)t + 1];
            const size_t r0 = (size_t)(pref[p0.x >> 16] * 256 + (int)(p0.x & 0xffffu)), r1 = (size_t)(pref[p1.x >> 16] * 256 + (int)(p1.x & 0xffffu));
            const float w0 = __uint_as_float(p0.y), w1 = __uint_as_float(p1.y);
            f32x4* op = (f32x4*)(out + (size_t)t * DM + c);
            const v4u y0 = *(const v4u*)(y + r0 * DM + c), y1 = *(const v4u*)(y + r1 * DM + c);
            f32x4 a0 = op[0], a1 = op[1];
            a0[0] += w0 * __uint_as_float(y0.x << 16) + w1 * __uint_as_float(y1.x << 16); a0[1] += w0 * __uint_as_float(y0.x & 0xffff0000u) + w1 * __uint_as_float(y1.x & 0xffff0000u);
            a0[2] += w0 * __uint_as_float(y0.y << 16) + w1 * __uint_as_float(y1.y << 16); a0[3] += w0 * __uint_as_float(y0.y & 0xffff0000u) + w1 * __uint_as_float(y1.y & 0xffff0000u);
            a1[0] += w0 * __uint_as_float(y0.z << 16) + w1 * __uint_as_float(y1.z << 16); a1[1] += w0 * __uint_as_float(y0.z & 0xffff0000u) + w1 * __uint_as_float(y1.z & 0xffff0000u);
            a1[2] += w0 * __uint_as_float(y0.w << 16) + w1 * __uint_as_float(y1.w << 16); a1[3] += w0 * __uint_as_float(y0.w & 0xffff0000u) + w1 * __uint_as_float(y1.w & 0xffff0000u);
            op[0] = a0; op[1] = a1;
        }
    }
#undef IN
#undef BOTH
}

extern "C" void kernel_launch(void* const* d_in, const int* in_sizes, int n_in, void* d_out, int out_size, void* d_ws, size_t ws_size, hipStream_t stream) {
    static int grid = 0;
    if (grid == 0) {
        if (n_in != 20 || out_size != NT * DM || ws_size < WS_END) { fprintf(stderr, "kernel_launch: unexpected shapes (n_in %d out %d ws %zu)\n", n_in, out_size, ws_size); grid = -1; return; }
        int dev = 0, cus = 0, per_cu = 0;
        if (hipGetDevice(&dev) != hipSuccess || hipDeviceGetAttribute(&cus, hipDeviceAttributeMultiprocessorCount, dev) != hipSuccess) { grid = -1; return; }
        if (hipFuncSetAttribute((const void*)mega, hipFuncAttributeMaxDynamicSharedMemorySize, LDS_BYTES) != hipSuccess) { fprintf(stderr, "kernel_launch: hipFuncSetAttribute failed\n"); grid = -1; return; }
        if (hipOccupancyMaxActiveBlocksPerMultiprocessor(&per_cu, (const void*)mega, NWAVES * 64, LDS_BYTES) != hipSuccess || per_cu < 1) fprintf(stderr, "kernel_launch: occupancy query says %d\n", per_cu);
        (void)hipGetLastError();
        grid = cus;
    }
    if (grid < 0) return;
    (void)hipMemsetAsync((char*)d_ws + WS_CTL, 0, CTL_ZERO_BYTES, stream);
    Args a{};
    for (int i = 0; i < 20; ++i) a.in[i] = (const float*)d_in[i];
    a.out = (float*)d_out; a.ws = (unsigned char*)d_ws;
    unsigned char* ws = (unsigned char*)d_ws;
    a.ph_lo = 0; a.ph_hi = 11; a.li = 0; hipLaunchKernelGGL(mega, dim3(grid), dim3(NWAVES * 64), LDS_BYTES, stream, a);
}
```

```cpp
#include <hip/hip_runtime.h>
#include <cstdio>
#include <cstdint>

#define GAS __attribute__((address_space(1)))
#define LAS __attribute__((address_space(3)))
typedef unsigned short bf16;
typedef unsigned v4u __attribute__((ext_vector_type(4)));
typedef unsigned v2u __attribute__((ext_vector_type(2)));
typedef float f32x4 __attribute__((ext_vector_type(4)));
typedef float f32x2 __attribute__((ext_vector_type(2)));
typedef float f32x16 __attribute__((ext_vector_type(16)));
typedef short bf16x8 __attribute__((ext_vector_type(8)));
typedef short s16x4 __attribute__((ext_vector_type(4)));
typedef __bf16 bf16x2_t __attribute__((ext_vector_type(2)));

constexpr int NB = 8, SEQ = 4096, DM = 1024, NT = NB * SEQ;
constexpr int NCOLS = 5632;
constexpr int NEXP = 32, DFF = 512;
constexpr float EPS = 1e-6f;
constexpr float LOG2E = 1.4426950408889634f;
constexpr int RCAP = NT;

constexpr size_t MiB = 1u << 20;
constexpr size_t WS_CTL = 0, CTL_ZERO_BYTES = 1 * MiB;
constexpr size_t WS_SMALL = 1 * MiB;
constexpr size_t WS_ROPE = 2 * MiB;
constexpr size_t WS_WHG = 3 * MiB, WS_WDA = 4 * MiB, WS_WOUT = 5 * MiB;
constexpr size_t WS_WIN = 7 * MiB;
constexpr size_t WS_W2T = 18 * MiB;
constexpr size_t WS_H = 50 * MiB;
constexpr size_t WS_W13T = WS_H;
constexpr size_t WS_HQ = 114 * MiB, WS_HF = 146 * MiB, WS_HI = 178 * MiB, WS_HOG = 210 * MiB;
constexpr size_t WS_MIXED = 114 * MiB;
constexpr size_t WS_XN = 178 * MiB;
constexpr size_t WS_Y = 114 * MiB;
constexpr size_t WS_YS = 50 * MiB;
constexpr size_t WS_TOKPOS = 322 * MiB;
constexpr size_t WS_QT = 242 * MiB, WS_KIMG = 274 * MiB, WS_VIMG = 306 * MiB;
constexpr size_t WS_HID = 242 * MiB;
constexpr size_t WS_ROWTOK = 306 * MiB;
constexpr size_t WS_WT = 314 * MiB;
constexpr size_t WS_DST = 338 * MiB;
constexpr size_t WS_X1B = 338 * MiB;
constexpr size_t WS_DECAY = 402 * MiB;
constexpr size_t WS_OHG = 403 * MiB, WS_ODA = 435 * MiB;
constexpr size_t WS_END = 467 * MiB;
constexpr int CW_BAR = 4096;
constexpr int CW_GCNT = 16384;
constexpr int CW_GRP = 20480;

__device__ __forceinline__ unsigned f2bf(float f) { unsigned u = __float_as_uint(f); return (u + 0x7fffu + ((u >> 16) & 1u)) >> 16; }
__device__ __forceinline__ float bf2f(unsigned short b) { return __uint_as_float((unsigned)b << 16); }
__device__ __forceinline__ unsigned cvtpk(float lo, float hi) { f32x2 v = {lo, hi}; bf16x2_t b = __builtin_convertvector(v, bf16x2_t); return __builtin_bit_cast(unsigned, b); }
__device__ __forceinline__ v4u pack8(const f32x4 a, const f32x4 b) { v4u w; w.x = cvtpk(a[0], a[1]); w.y = cvtpk(a[2], a[3]); w.z = cvtpk(b[0], b[1]); w.w = cvtpk(b[2], b[3]); return w; }
__host__ __device__ __forceinline__ unsigned off_b(unsigned row, unsigned ch) { return 256u * row + 16u * (ch ^ (((row & 3u) << 2) | ((row >> 2) & 3u))); }
__host__ __device__ __forceinline__ unsigned img_off(unsigned row, unsigned col) { return off_b(row, col >> 3) + (col & 7u) * 2u; }
__host__ __device__ __forceinline__ unsigned off_a(unsigned row, unsigned ch) { return 2048u * (row >> 3) + 512u * (ch >> 2) + 64u * (row & 7u) + 16u * ((ch & 3u) ^ ((row >> 2) & 3u)); }
__host__ __device__ __forceinline__ unsigned img_off_a(unsigned row, unsigned col) { return off_a(row, col >> 3) + (col & 7u) * 2u; }
__host__ __device__ __forceinline__ unsigned kappa(unsigned r) { return (r & ~12u) | ((r & 4u) << 1) | ((r & 8u) >> 1); }
template <int M> __device__ __forceinline__ float swz_xor(float v) { return __int_as_float(__builtin_amdgcn_ds_swizzle(__float_as_int(v), (M << 10) | 0x1f)); }
__device__ __forceinline__ float wave_sum(float v) {
    v += swz_xor<1>(v); v += swz_xor<2>(v); v += swz_xor<4>(v); v += swz_xor<8>(v); v += swz_xor<16>(v);
    { auto rr = __builtin_amdgcn_permlane32_swap(__float_as_uint(v), __float_as_uint(v), false, false); v = __uint_as_float(rr[0]) + __uint_as_float(rr[1]); }
    return v;
}
__device__ __forceinline__ float wave_max(float v) {
    v = fmaxf(v, swz_xor<1>(v)); v = fmaxf(v, swz_xor<2>(v)); v = fmaxf(v, swz_xor<4>(v)); v = fmaxf(v, swz_xor<8>(v)); v = fmaxf(v, swz_xor<16>(v));
    { auto rr = __builtin_amdgcn_permlane32_swap(__float_as_uint(v), __float_as_uint(v), false, false); v = fmaxf(__uint_as_float(rr[0]), __uint_as_float(rr[1])); }
    return v;
}
extern __shared__ __attribute__((aligned(16))) unsigned char lds_raw[];
constexpr int LDS_BYTES = 159744;
constexpr int MISC_OFF = LDS_BYTES - 512;
__device__ __forceinline__ int wave_idx() { const unsigned k = (unsigned)__builtin_amdgcn_s_getreg((5 << 11) | 4) & 63u;
    return __builtin_amdgcn_readfirstlane(*(volatile LAS int*)((LAS unsigned char*)lds_raw + MISC_OFF + 256 + 4 * k)); }
__device__ __forceinline__ unsigned lane_id() { unsigned l; asm volatile("v_mbcnt_lo_u32_b32 %0, -1, 0\n\tv_mbcnt_hi_u32_b32 %0, -1, %0" : "=v"(l)); return l; }
__device__ __forceinline__ int tid_x() { return wave_idx() * 64 + (int)lane_id(); }
typedef int v8i __attribute__((ext_vector_type(8)));
typedef int v4i __attribute__((ext_vector_type(4)));
__device__ __forceinline__ unsigned pk4_fp8(float a, float b, float c, float d) { int p = __builtin_amdgcn_cvt_pk_fp8_f32(a, b, 0, false); p = __builtin_amdgcn_cvt_pk_fp8_f32(c, d, p, true); return (unsigned)p; }
__device__ __forceinline__ float rcpf_(float x) { return __builtin_amdgcn_rcpf(x); }
__device__ __forceinline__ float sigmoidf_(float x) { return rcpf_(1.0f + __expf(-x)); }

#define XB_TMO      128
#define XB_XCNT(j)  (256  + 64 * (j))
#define XB_XSUB(j)  (1280 + 64 * (j))
#define XB_XGEN(j)  (2304 + 64 * (j))
#define XB_TOP      3328
#define XB_TOPGEN   3392
#define XCD_BAR_WORDS 3456
#define XB_SPIN_CAP (1u << 18)
__device__ __forceinline__ unsigned xb_ld(unsigned* p)              { return __hip_atomic_load(p, __ATOMIC_RELAXED, __HIP_MEMORY_SCOPE_AGENT); }
__device__ __forceinline__ unsigned xb_add(unsigned* p, unsigned v) { return __hip_atomic_fetch_add(p, v, __ATOMIC_RELAXED, __HIP_MEMORY_SCOPE_AGENT); }
__device__ __forceinline__ unsigned xb_xcc_id() { return (unsigned)__builtin_amdgcn_s_getreg((3 << 11) | 20) & 0xFu; }
#define XB_SPIN(cond, bar) do { unsigned _sp = 0; while (cond) { __builtin_amdgcn_s_sleep(1); \
    if ((++_sp & 255u) == 0u) { if (xb_ld(&(bar)[XB_TMO])) break; if (_sp > XB_SPIN_CAP) { atomicAdd(&(bar)[XB_TMO], 1u); break; } } } } while (0)
struct XcdBarrier { unsigned* bar; unsigned x; volatile LAS unsigned* st; };
__device__ __forceinline__ XcdBarrier xcd_barrier_post(unsigned* bar, volatile LAS unsigned* st) {
    XcdBarrier b; b.bar = bar; b.x = xb_xcc_id(); b.st = st;
    if (tid_x() == 0) (void)xb_add(&bar[XB_XCNT(b.x)], 1u);
    return b;
}
__device__ __forceinline__ void xcd_barrier_complete(unsigned* bar, unsigned x, unsigned& nloc, unsigned& nx) {
    const unsigned G = gridDim.x * gridDim.y * gridDim.z;
    unsigned sum, cnt, mine, sp = 0u;
    for (;;) {
        sum = 0u; cnt = 0u; mine = 0u;
#pragma unroll
        for (unsigned j = 0; j < 16; ++j) { const unsigned c = xb_ld(&bar[XB_XCNT(j)]); sum += c; cnt += (c > 0u) ? 1u : 0u; mine = (j == x) ? c : mine; }
        if (sum == G) break;
        __builtin_amdgcn_s_sleep(1);
        if ((++sp & 255u) == 0u) { if (xb_ld(&bar[XB_TMO])) break; if (sp > XB_SPIN_CAP) { atomicAdd(&bar[XB_TMO], 1u); break; } }
    }
    nloc = mine > 0u ? mine : 1u; nx = cnt > 0u ? cnt : 1u;
}
__device__ __forceinline__ void xcd_barrier(const XcdBarrier& b) {
    asm volatile("s_waitcnt vmcnt(0)" ::: "memory");
    __syncthreads();
    if (tid_x() == 0) {
        unsigned* bar = b.bar;
        __builtin_amdgcn_s_waitcnt(0);
        unsigned nloc = b.st[0], nx = b.st[1];
        if (nloc == 0u) { xcd_barrier_complete(bar, b.x, nloc, nx); b.st[0] = nloc; b.st[1] = nx; }
        const unsigned old = xb_add(&bar[XB_XSUB(b.x)], 1u);
        const unsigned gen = old / nloc;
        if (old + 1u == (gen + 1u) * nloc) {
            __builtin_amdgcn_fence(__ATOMIC_RELEASE, "agent");
            asm volatile("s_waitcnt vmcnt(0)" ::: "memory");
            const unsigned og = xb_add(&bar[XB_TOP], 1u);
            const unsigned tg = og / nx;
            if (og + 1u == (tg + 1u) * nx) xb_add(&bar[XB_TOPGEN], 1u);
            else XB_SPIN(xb_ld(&bar[XB_TOPGEN]) == tg, bar);
            __builtin_amdgcn_fence(__ATOMIC_ACQUIRE, "agent");
            xb_add(&bar[XB_XGEN(b.x)], 1u);
            asm volatile("s_waitcnt vmcnt(0)" ::: "memory");
        } else {
            XB_SPIN(xb_ld(&bar[XB_XGEN(b.x)]) == gen, bar);
            __builtin_amdgcn_fence(__ATOMIC_ACQUIRE, "agent");
            asm volatile("s_waitcnt vmcnt(0)" ::: "memory");
        }
    }
    __syncthreads();
}

namespace pg8 {
constexpr int BM = 256, BK = 64, HALF = 128, HTB = HALF * BK * 2, STAGE_BYTES = 8 * HTB, NXCD = 8, WGM = 8;
__host__ __device__ __forceinline__ int lds_byte(int r, int c) { const int st = (r >> 4) * 2 + (c >> 5), rr = r & 15, cc = c & 31, ob = rr * 64 + cc * 2; return st * 1024 + (ob ^ (((ob >> 9) & 1) << 5)); }
__host__ __device__ __forceinline__ void stage_rc(int b, int& R, int& C) { const int st = b / 1024, sb = b % 1024, swz = sb ^ (((sb >> 9) & 1) << 5); R = (st >> 1) * 16 + swz / 64; C = (st & 1) * 32 + (swz % 64) / 2; }
__host__ __device__ __forceinline__ int perm32(int rho) { const int n = rho >> 4, i = rho & 15; return 8 * (i >> 2) + 4 * n + (i & 3); }
struct Unit { int pm, pn, aux; };

template <class Epi, class Sched, bool ALIGN_EPI, bool F8 = false, int WSC = 127>
__device__ __forceinline__ void gemm_phase(LAS unsigned char* lds, const int K, const Sched& S, const Epi& E) {
    const int tid = tid_x(), wid = __builtin_amdgcn_readfirstlane(tid >> 6), lane = tid & 63, wr = wid >> 2, wc = wid & 3, fr = lane & 15, fq = lane >> 4;
    const int nt = K / BK;
    int Rr[2], Cc[2]; unsigned voffB[2];
#pragma unroll
    for (int i = 0; i < 2; ++i) { int R, C; stage_rc(tid * 16 + i * 8192, R, C); Rr[i] = R; Cc[i] = C; const int Rb = Epi::PERM ? ((R & ~31) + perm32(R & 31)) : R; voffB[i] = (unsigned)(Rb * K + C) * 2u; }
    const size_t kstep = (size_t)(BK * 2);
    const size_t hstep = (size_t)HALF * K * 2;
    const unsigned ldsw = (unsigned)wid * 1024u;
    const int aoff = lds_byte(wr * 64 + fr, fq * 8), boff = lds_byte(wc * 32 + fr, fq * 8);
#define PG8_SA(b, h) (((b) * 2 + (h)) * HTB)
#define PG8_SB(b, h) ((4 + (b) * 2 + (h)) * HTB)
#define PG8_STAGE(bufoff, gbase, voff) do { _Pragma("unroll") for (int _i = 0; _i < 2; ++_i) \
        __builtin_amdgcn_global_load_lds((const unsigned*)((const char*)(gbase) + (voff)[_i]), (LAS unsigned*)(lds + (bufoff) + ldsw + _i * 8192), 16, 0, 0); } while (0)
#define PG8_LD8(off_) __builtin_shufflevector(*(const LAS v4i*)(lds + (off_)), *(const LAS v4i*)(lds + (off_) + 1024), 0, 1, 2, 3, 4, 5, 6, 7)
#define PG8_LDA(dst, b, h) do { if constexpr (F8) { _Pragma("unroll") for (int m = 0; m < 4; ++m) dst##8[m] = PG8_LD8(PG8_SA(b, h) + aoff + m * 2048); } \
        else { _Pragma("unroll") for (int m = 0; m < 4; ++m) _Pragma("unroll") for (int k = 0; k < 2; ++k) dst[m][k] = *(const LAS bf16x8*)(lds + PG8_SA(b, h) + aoff + m * 2048 + k * 1024); } } while (0)
#define PG8_LDB(dst, b, h) do { if constexpr (F8) { _Pragma("unroll") for (int n = 0; n < 2; ++n) dst##8[n] = PG8_LD8(PG8_SB(b, h) + boff + n * 2048); } \
        else { _Pragma("unroll") for (int n = 0; n < 2; ++n) _Pragma("unroll") for (int k = 0; k < 2; ++k) dst[n][k] = *(const LAS bf16x8*)(lds + PG8_SB(b, h) + boff + n * 2048 + k * 1024); } } while (0)
#define PG8_MMA(ai, bj, At, Bt) do { __builtin_amdgcn_s_setprio(1); \
        if constexpr (F8) { _Pragma("unroll") for (int m = 0; m < 4; ++m) _Pragma("unroll") for (int n = 0; n < 2; ++n) \
            asm volatile("v_mfma_scale_f32_16x16x128_f8f6f4 %0, %1, %2, %0, %3, %4 op_sel_hi:[0,0,0]" : "+v"(acc[ai][bj][m][n]) : "v"(Bt##8[n]), "v"(At##8[m]), "v"(wsc_), "v"(asc_)); } \
        else { _Pragma("unroll") for (int m = 0; m < 4; ++m) _Pragma("unroll") for (int n = 0; n < 2; ++n) _Pragma("unroll") for (int k = 0; k < 2; ++k) \
            acc[ai][bj][m][n] = __builtin_amdgcn_mfma_f32_16x16x32_bf16(Bt[n][k], At[m][k], acc[ai][bj][m][n], 0, 0, 0); } \
        __builtin_amdgcn_s_setprio(0); } while (0)
#define PG8_WAIT_V(n) asm volatile("s_waitcnt vmcnt(" #n ")" ::: "memory")
#define PG8_WAIT_L(n) asm volatile("s_waitcnt lgkmcnt(" #n ")" ::: "memory")
#define PG8_BAR __builtin_amdgcn_s_barrier()
#define PG8_SCHED __builtin_amdgcn_sched_barrier(0)
    Unit cur, nxt; int ui = 0;
    if (!S.next(0, cur)) return;
    f32x4 acc[2][2][4][2];
#pragma unroll
    for (int a = 0; a < 2; ++a)
#pragma unroll
        for (int b = 0; b < 2; ++b)
#pragma unroll
            for (int m = 0; m < 4; ++m)
#pragma unroll
                for (int n = 0; n < 2; ++n) acc[a][b][m][n] = (f32x4){0.f, 0.f, 0.f, 0.f};
    bf16x8 At[4][2], B0[2][2], B1[2][2]; v8i At8[4], B08[2], B18[2];
    int wsc_ = WSC, asc_ = 127; asm volatile("" : "+v"(wsc_), "+v"(asc_));
    const char* cA; const char* cB; unsigned cA0[2], cA1[2];
    S.addr(cur, Rr, Cc, cA, cB, cA0, cA1);
    LAS unsigned* nslot = (LAS unsigned*)(lds + STAGE_BYTES) + tid * 4;
    PG8_STAGE(PG8_SB(0, 0), cB, voffB); PG8_STAGE(PG8_SB(0, 1), cB + hstep, voffB); PG8_STAGE(PG8_SA(0, 0), cA, cA0); PG8_STAGE(PG8_SA(0, 1), cA, cA1);
    if (wr == 1) PG8_BAR;
    PG8_WAIT_V(2); PG8_BAR;
    PG8_STAGE(PG8_SB(1, 0), cB + kstep, voffB); PG8_STAGE(PG8_SA(1, 0), cA + kstep, cA0); PG8_STAGE(PG8_SB(1, 1), cB + hstep + kstep, voffB);
    PG8_WAIT_V(6); PG8_BAR;
    for (;;) {
        const bool has_next = S.next(ui + 1, nxt);
        const char* nA = cA; const char* nB = cB;
        { unsigned nA0[2] = {cA0[0], cA0[1]}, nA1[2] = {cA1[0], cA1[1]};
          if (has_next) { int R2[2], C2[2]; const int t2 = tid_x();
#pragma unroll
              for (int i = 0; i < 2; ++i) stage_rc(t2 * 16 + i * 8192, R2[i], C2[i]);
              S.addr(nxt, R2, C2, nA, nB, nA0, nA1); }
          nslot[0] = nA0[0]; nslot[1] = nA0[1]; nslot[2] = nA1[0]; nslot[3] = nA1[1]; }
#pragma unroll 1
        for (int t = 0; t < nt; t += 2) {
            const bool last = (t == nt - 2);
            const char* a1 = cA + (size_t)(t + 1) * kstep;
            const char* a2 = last ? nA : cA + (size_t)(t + 2) * kstep; const char* b2 = last ? nB : cB + (size_t)(t + 2) * kstep;
            const char* a3 = a2 + kstep; const char* b3 = b2 + kstep;
            unsigned x0[2], x1[2];
#pragma unroll
            for (int i = 0; i < 2; ++i) { x0[i] = last ? nslot[i] : cA0[i]; x1[i] = last ? nslot[2 + i] : cA1[i]; }
            PG8_LDB(B0, 0, 0); PG8_LDB(B1, 0, 1); PG8_SCHED; PG8_LDA(At, 0, 0); PG8_STAGE(PG8_SA(1, 1), a1, cA1);
            PG8_WAIT_V(8); PG8_WAIT_L(0); PG8_BAR; PG8_MMA(0, 0, At, B0); PG8_MMA(0, 1, At, B1); PG8_BAR; PG8_SCHED;
            PG8_LDA(At, 0, 1); PG8_STAGE(PG8_SB(0, 0), b2, voffB); PG8_STAGE(PG8_SB(0, 1), b2 + hstep, voffB); PG8_STAGE(PG8_SA(0, 0), a2, x0);
            PG8_WAIT_V(8); PG8_WAIT_L(0); PG8_BAR; PG8_MMA(1, 0, At, B0); PG8_MMA(1, 1, At, B1); PG8_BAR; PG8_SCHED;
            PG8_LDB(B0, 1, 0); PG8_LDB(B1, 1, 1); PG8_SCHED; PG8_LDA(At, 1, 0); PG8_STAGE(PG8_SA(0, 1), a2, x1);
            PG8_WAIT_V(8); PG8_WAIT_L(0); PG8_BAR; PG8_MMA(0, 0, At, B0); PG8_MMA(0, 1, At, B1); PG8_BAR; PG8_SCHED;
            PG8_LDA(At, 1, 1); PG8_STAGE(PG8_SB(1, 0), b3, voffB); PG8_STAGE(PG8_SB(1, 1), b3 + hstep, voffB); PG8_STAGE(PG8_SA(1, 0), a3, x0);
            PG8_WAIT_V(8); PG8_WAIT_L(0); PG8_BAR; PG8_MMA(1, 0, At, B0); PG8_MMA(1, 1, At, B1); PG8_BAR; PG8_SCHED;
        }
        if constexpr (ALIGN_EPI) { if (wr == 0) PG8_BAR; }
        if constexpr (F8) asm volatile("s_nop 15\n\ts_nop 15" ::: "memory");
        E(acc, cur, wr, wc, fr, fq);
        if (!has_next) break;
        if (!E.keep(cur)) {
#pragma unroll
            for (int a = 0; a < 2; ++a)
#pragma unroll
                for (int b = 0; b < 2; ++b)
#pragma unroll
                    for (int m = 0; m < 4; ++m)
#pragma unroll
                        for (int n = 0; n < 2; ++n) acc[a][b][m][n] = (f32x4){0.f, 0.f, 0.f, 0.f};
        }
        cur = nxt; cA = nA; cB = nB; cA0[0] = nslot[0]; cA0[1] = nslot[1]; cA1[0] = nslot[2]; cA1[1] = nslot[3]; ++ui;
        if constexpr (ALIGN_EPI) { if (wr == 1) PG8_BAR; }
    }
    PG8_WAIT_V(0);
    if constexpr (!ALIGN_EPI) { if (wr == 0) PG8_BAR; }
    PG8_BAR;
#undef PG8_SA
#undef PG8_SB
#undef PG8_STAGE
#undef PG8_LDA
#undef PG8_LD8
#undef PG8_LDB
#undef PG8_MMA
#undef PG8_WAIT_V
#undef PG8_WAIT_L
#undef PG8_BAR
#undef PG8_SCHED
}

struct DenseOrder {
    const char* A; const char* Bt; int K, nM, nN, nwg, G, c;
    __device__ __forceinline__ void init(const void* A_, const void* Bt_, int M, int N, int K_, int G_, int c_) { A = (const char*)A_; Bt = (const char*)Bt_; K = K_; nM = M / BM; nN = N / BM; nwg = nM * nN; G = G_; c = c_; }
    __device__ __forceinline__ bool next(int i, Unit& u) const {
        const long L = (long)i * G + c; if (L >= nwg) return false;
        int wgid = (int)L; { const int q = nwg / NXCD, r = nwg % NXCD, xcd = wgid % NXCD, off = wgid / NXCD; wgid = (xcd < r ? xcd * (q + 1) : r * (q + 1) + (xcd - r) * q) + off; }
        const int nig = WGM * nN, gid = wgid / nig, fm = gid * WGM, gsz = (nM - fm) < WGM ? (nM - fm) : WGM;
        u.pm = fm + ((wgid % nig) % gsz); u.pn = (wgid % nig) / gsz; u.aux = 0; return true;
    }
    __device__ __forceinline__ void addr(const Unit& u, const int (&R)[2], const int (&C)[2], const char*& a, const char*& b, unsigned (&a0)[2], unsigned (&a1)[2]) const {
        a = A + (size_t)u.pm * ((size_t)BM * K * 2); b = Bt + (size_t)u.pn * ((size_t)BM * K * 2);
#pragma unroll
        for (int i = 0; i < 2; ++i) { a0[i] = (unsigned)(R[i] * K + C[i]) * 2u; a1[i] = a0[i] + (unsigned)(HALF * K * 2); }
    }
};
}

__host__ __device__ __forceinline__ int proj_logical_col(int c) {
    if (c >= 3584) { const int t = (c - 3584) >> 8, l = (c - 3584) & 255; return ((l >> 7) ? 4608 : 3584) + 128 * t + (l & 127); }
    if (c < 2048 || c >= 3072) return c;
    const int tb = c & ~255, l = c & 255, bj = l >> 7, wc = (l >> 5) & 3, i = l & 31;
    return tb + 64 * wc + 32 * bj + i;
}
struct EpiProj {
    static constexpr bool PERM = true;
    unsigned char* ws; bf16* gates; const float* qg; const float* kg;
    __device__ __forceinline__ bool keep(const pg8::Unit&) const { return false; }
    __device__ __forceinline__ void operator()(f32x4 (&acc)[2][2][4][2], const pg8::Unit& u, int wr, int wc, int fr, int fq) const {
        const int pn = u.pn; const int tok0 = u.pm * 256 + wr * 64 + fr;
        if (pn < 8 || pn == 12 || pn == 13) {
            unsigned char* base = ws + ((pn < 8) ? (WS_HQ + (size_t)(pn >> 1) * (32 * MiB)) : WS_VIMG);
#pragma unroll
            for (int ai = 0; ai < 2; ++ai)
#pragma unroll
                for (int m = 0; m < 4; ++m) {
                    const int tok = tok0 + ai * 128 + m * 16; const int b = tok >> 12, s = tok & 4095, chunk = s >> 6, row = s & 63;
#pragma unroll
                    for (int bj = 0; bj < 2; ++bj) { const int h = 2 * (pn & 1) + bj;
                        unsigned char* dst = base + ((size_t)((b * 4 + h) * 64 + chunk) << 14) + off_a(row, 4 * wc + fq);
                        *(v4u*)dst = pack8(acc[ai][bj][m][0], acc[ai][bj][m][1]); }
                }
        } else if (pn < 12) {
            const bool isq = pn < 10; const float* gn = isq ? qg : kg;
            const int j = 4 * (pn & 1) + wc, h = j >> 1, mp = j & 1;
            const f32x4 ga0 = *(const f32x4*)(gn + 8 * fq), ga1 = *(const f32x4*)(gn + 8 * fq + 4), gb0 = *(const f32x4*)(gn + 32 + 8 * fq), gb1 = *(const f32x4*)(gn + 36 + 8 * fq);
            const f32x4* rope = (const f32x4*)(ws + WS_ROPE);
            const float qs = isq ? 0.125f * LOG2E : 1.0f;
#pragma unroll
            for (int ai = 0; ai < 2; ++ai)
#pragma unroll
                for (int m = 0; m < 4; ++m) {
                    const int tok = tok0 + ai * 128 + m * 16; const int b = tok >> 12, s = tok & 4095;
                    f32x4 x10 = acc[ai][0][m][0], x11 = acc[ai][0][m][1], x20 = acc[ai][1][m][0], x21 = acc[ai][1][m][1];
                    float ss = 0.f;
#pragma unroll
                    for (int e = 0; e < 4; ++e) ss += x10[e] * x10[e] + x11[e] * x11[e] + x20[e] * x20[e] + x21[e] * x21[e];
                    ss += swz_xor<16>(ss); { auto rr = __builtin_amdgcn_permlane32_swap(__float_as_uint(ss), __float_as_uint(ss), false, false); ss = __uint_as_float(rr[0]) + __uint_as_float(rr[1]); }
                    const float rstd = qs / sqrtf(ss * (1.0f / 64.0f) + EPS);
                    x10 = x10 * ga0 * rstd; x11 = x11 * ga1 * rstd; x20 = x20 * gb0 * rstd; x21 = x21 * gb1 * rstd;
                    const f32x4* rp = rope + (size_t)s * 16 + 4 * fq;
                    const f32x4 r0 = rp[0], r1 = rp[1], r2 = rp[2], r3 = rp[3];
                    f32x4 o10, o11, o20, o21;
                    o10[0] = x10[0] * r0[0] - x20[0] * r0[1]; o20[0] = x10[0] * r0[1] + x20[0] * r0[0];
                    o10[1] = x10[1] * r0[2] - x20[1] * r0[3]; o20[1] = x10[1] * r0[3] + x20[1] * r0[2];
                    o10[2] = x10[2] * r1[0] - x20[2] * r1[1]; o20[2] = x10[2] * r1[1] + x20[2] * r1[0];
                    o10[3] = x10[3] * r1[2] - x20[3] * r1[3]; o20[3] = x10[3] * r1[3] + x20[3] * r1[2];
                    o11[0] = x11[0] * r2[0] - x21[0] * r2[1]; o21[0] = x11[0] * r2[1] + x21[0] * r2[0];
                    o11[1] = x11[1] * r2[2] - x21[1] * r2[3]; o21[1] = x11[1] * r2[3] + x21[1] * r2[2];
                    o11[2] = x11[2] * r3[0] - x21[2] * r3[1]; o21[2] = x11[2] * r3[1] + x21[2] * r3[0];
                    o11[3] = x11[3] * r3[2] - x21[3] * r3[3]; o21[3] = x11[3] * r3[3] + x21[3] * r3[2];
                    const v4u w1 = pack8(o10, o11), w2 = pack8(o20, o21);
                    if (isq) {
                        bf16* q = (bf16*)(ws + WS_QT) + ((size_t)((b * 4 + h) * 4096 + s) * 128 + 64 * mp + 8 * fq);
                        *(v4u*)q = w1; *(v4u*)(q + 32) = w2;
                    } else {
                        unsigned char* kb = ws + WS_KIMG + ((size_t)((b * 4 + h) * 64 + (s >> 6)) << 14);
                        const unsigned rho = kappa((unsigned)(s & 63));
                        *(v4u*)(kb + off_a(rho, 8 * mp + fq)) = w1; *(v4u*)(kb + off_a(rho, 8 * mp + 4 + fq)) = w2;
                    }
                }
        } else {
            unsigned char* gblk = (unsigned char*)gates + ((size_t)(u.pm * 8 + (pn - 14)) << 17) + (size_t)(((wr * 4) * 4 + wc) * 64 + fr + 16 * fq) * 16;
#pragma unroll
            for (int ai = 0; ai < 2; ++ai)
#pragma unroll
                for (int m = 0; m < 4; ++m) {
                    bf16* dst = (bf16*)(gblk + (size_t)(ai * 2 * 4 + m) * 4 * 1024);
                    f32x4 r0, r1, s0, s1;
#pragma unroll
                    for (int e = 0; e < 4; ++e) {
                        const float ea0 = __expf(-acc[ai][0][m][0][e]), ea1 = __expf(-acc[ai][0][m][1][e]), eb0 = __expf(-acc[ai][1][m][0][e]), eb1 = __expf(-acc[ai][1][m][1][e]);
                        r0[e] = (1.0f + eb0) * rcpf_(1.0f + ea0); r1[e] = (1.0f + eb1) * rcpf_(1.0f + ea1); s0[e] = rcpf_(1.0f + eb0); s1[e] = rcpf_(1.0f + eb1);
                    }
                    *(v4u*)dst = pack8(r0, r1); *(v4u*)(dst + 32768) = pack8(s0, s1);
                }
        }
    }
};

struct BranchOrder {
    pg8::DenseOrder d; const char* A2; const char* B2;
    __device__ __forceinline__ bool next(int i, pg8::Unit& u) const { if (!d.next(i >> 1, u)) return false; u.aux = i & 1; return true; }
    __device__ __forceinline__ void addr(const pg8::Unit& u, const int (&R)[2], const int (&C)[2], const char*& a, const char*& b, unsigned (&a0)[2], unsigned (&a1)[2]) const {
        d.addr(u, R, C, a, b, a0, a1);
        if (u.aux) { a = A2 + (size_t)u.pm * ((size_t)pg8::BM * d.K * 2); b = B2 + (size_t)u.pn * ((size_t)pg8::BM * d.K * 2); }
    }
};
struct EpiBranch {
    static constexpr bool PERM = true;
    const bf16* gates; bf16* mixed;
    __device__ __forceinline__ bool keep(const pg8::Unit& u) const { return u.aux == 0; }
    __device__ __forceinline__ void operator()(f32x4 (&acc)[2][2][4][2], const pg8::Unit& u, int wr, int wc, int fr, int fq) const {
        const int tok0 = u.pm * 256 + wr * 64 + fr, c0 = u.pn * 256 + 32 * wc + 8 * fq;
        const unsigned char* gb = (const unsigned char*)gates + ((size_t)(u.pm * 8 + 2 * u.pn) << 17) + (u.aux ? 65536 : 0) + (size_t)(((wr * 4) * 4 + wc) * 64 + fr + 16 * fq) * 16;
        v4u g[2][4][2];
#pragma unroll
        for (int ai = 0; ai < 2; ++ai)
#pragma unroll
            for (int m = 0; m < 4; ++m)
#pragma unroll
                for (int bj = 0; bj < 2; ++bj) g[ai][m][bj] = *(const v4u*)(gb + ((size_t)bj << 17) + (size_t)(ai * 2 * 4 + m) * 4 * 1024);
#pragma unroll
        for (int ai = 0; ai < 2; ++ai) {
#pragma unroll
            for (int m = 0; m < 4; ++m)
#pragma unroll
                for (int bj = 0; bj < 2; ++bj) {
#pragma unroll
                    for (int e = 0; e < 2; ++e) { acc[ai][bj][m][0][2 * e] *= __uint_as_float(g[ai][m][bj][e] << 16); acc[ai][bj][m][0][2 * e + 1] *= __uint_as_float(g[ai][m][bj][e] & 0xffff0000u);
                                                  acc[ai][bj][m][1][2 * e] *= __uint_as_float(g[ai][m][bj][2 + e] << 16); acc[ai][bj][m][1][2 * e + 1] *= __uint_as_float(g[ai][m][bj][2 + e] & 0xffff0000u); }
                    if (u.aux) *(v4u*)(mixed + (size_t)(tok0 + ai * 128 + m * 16) * DM + c0 + 128 * bj) = pack8(acc[ai][bj][m][0], acc[ai][bj][m][1]);
                }
        }
    }
};
struct EpiOut {
    static constexpr bool PERM = true;
    const float* x; bf16* x1b;
    __device__ __forceinline__ bool keep(const pg8::Unit&) const { return false; }
    __device__ __forceinline__ void operator()(f32x4 (&acc)[2][2][4][2], const pg8::Unit& u, int wr, int wc, int fr, int fq) const {
        const int tok0 = u.pm * 256 + wr * 64 + fr, c0 = u.pn * 256 + 32 * wc + 8 * fq;
#pragma unroll
        for (int ai = 0; ai < 2; ++ai)
#pragma unroll
            for (int mp = 0; mp < 2; ++mp) {
                f32x4 xv[2][2][2];
#pragma unroll
                for (int mm = 0; mm < 2; ++mm) { const size_t ro = (size_t)(tok0 + ai * 128 + (2 * mp + mm) * 16) * DM + c0;
#pragma unroll
                    for (int bj = 0; bj < 2; ++bj)
#pragma unroll
                        for (int n = 0; n < 2; ++n) xv[mm][bj][n] = *(const f32x4*)(x + ro + 128 * bj + 4 * n); }
#pragma unroll
                for (int mm = 0; mm < 2; ++mm) { const size_t ro = (size_t)(tok0 + ai * 128 + (2 * mp + mm) * 16) * DM + c0;
#pragma unroll
                    for (int bj = 0; bj < 2; ++bj) *(v4u*)(x1b + ro + 128 * bj) = pack8(xv[mm][bj][0] + acc[ai][bj][2 * mp + mm][0], xv[mm][bj][1] + acc[ai][bj][2 * mp + mm][1]); }
            }
    }
};
template <int rmul> struct MoeOrderT {
    const LAS int* pref; const LAS int* cnt; const v2u* rowtok; const char* A; const char* Bt; int K; size_t bstride; int rmul_unused; int b_lo, b_hi, ncol, G, c;
    __device__ __forceinline__ bool next(int i, pg8::Unit& u) const {
        const int L = i * G + c; const int t0 = pref[b_lo], total = (pref[b_hi] - t0) * ncol; if (L >= total) return false;
        const int rt = t0 + (L >> 2); int b = b_lo;
#pragma unroll 1
        for (int st = 32; st >= 1; st >>= 1) { const int nb_ = b + st; if (nb_ < b_hi && __builtin_amdgcn_readfirstlane(pref[nb_]) <= rt) b = nb_; }
        u.pm = rt - pref[b]; u.pn = L & 3; u.aux = b; return true;
    }
    __device__ __forceinline__ void addr(const pg8::Unit& u, const int (&R)[2], const int (&C)[2], const char*& a, const char*& b, unsigned (&a0)[2], unsigned (&a1)[2]) const {
        a = A; b = Bt + (size_t)(u.aux & 31) * bstride + (size_t)u.pn * ((size_t)pg8::BM * K * 2);
        if constexpr (rmul == 0) {
            const unsigned base = (unsigned)(pref[u.aux] + u.pm) * 256u;
#pragma unroll
            for (int i = 0; i < 2; ++i) { a0[i] = ((base + (unsigned)R[i]) * (unsigned)K + (unsigned)C[i]) * 2u; a1[i] = a0[i] + (unsigned)(128 * K * 2); }
        } else {
        const int n = cnt[u.aux]; const v2u* rt = rowtok + (size_t)u.aux * RCAP;
#pragma unroll
        for (int i = 0; i < 2; ++i) {
            const int r0 = u.pm * 256 + R[i], r1 = r0 + 128;
            const int t0 = (r0 < n) ? (int)rt[r0].x : 0, t1 = (r1 < n) ? (int)rt[r1].x : 0;
            a0[i] = (unsigned)(t0 * K + C[i]) * 2u; a1[i] = (unsigned)(t1 * K + C[i]) * 2u;
        }
        }
    }
};
struct EpiUp {
    static constexpr bool PERM = true;
    const LAS int* pref; const LAS int* cnt; unsigned char* hid;
    __device__ __forceinline__ bool keep(const pg8::Unit&) const { return false; }
    __device__ __forceinline__ void operator()(f32x4 (&acc)[2][2][4][2], const pg8::Unit& u, int wr, int wc, int fr, int fq) const {
        const int n = cnt[u.aux] - u.pm * 256;
        int frl = fr, fql = fq; asm volatile("" : "+v"(frl), "+v"(fql));
        const int r0 = wr * 64 + frl, c0 = u.pn * 128 + 32 * wc + 8 * fql;
        unsigned char* hb = hid + (size_t)(pref[u.aux] + u.pm) * (256 * DFF) + c0;
#pragma unroll
        for (int ai = 0; ai < 2; ++ai)
#pragma unroll
            for (int m = 0; m < 4; ++m) {
                const int r = r0 + ai * 128 + m * 16;
                f32x4 h0, h1;
#pragma unroll
                for (int e = 0; e < 4; ++e) { const float a0 = acc[ai][0][m][0][e], a1 = acc[ai][0][m][1][e];
                    h0[e] = a0 * rcpf_(1.0f + __expf(-a0)) * acc[ai][1][m][0][e]; h1[e] = a1 * rcpf_(1.0f + __expf(-a1)) * acc[ai][1][m][1][e]; }
                if (r < n) *(v2u*)(hb + (size_t)r * DFF) = (v2u){pk4_fp8(h0[0], h0[1], h0[2], h0[3]), pk4_fp8(h1[0], h1[1], h1[2], h1[3])};
            }
    }
};
struct EpiDown {
    static constexpr bool PERM = true;
    const LAS int* pref; const LAS int* cnt; bf16* y;
    __device__ __forceinline__ bool keep(const pg8::Unit&) const { return false; }
    __device__ __forceinline__ void operator()(f32x4 (&acc)[2][2][4][2], const pg8::Unit& u, int wr, int wc, int fr, int fq) const {
        const int n = cnt[u.aux] - u.pm * 256;
        int frl = fr, fql = fq; asm volatile("" : "+v"(frl), "+v"(fql));
        const int r0 = wr * 64 + frl, c0 = u.pn * 256 + 32 * wc + 8 * fql;
        bf16* yb = y + (size_t)(pref[u.aux] + u.pm) * (256 * DM) + c0;
#pragma unroll
        for (int ai = 0; ai < 2; ++ai)
#pragma unroll
            for (int m = 0; m < 4; ++m) {
                const int r = r0 + ai * 128 + m * 16;
                if (r < n) {
#pragma unroll
                    for (int bj = 0; bj < 2; ++bj) *(v4u*)(yb + (size_t)r * DM + 128 * bj) = pack8(acc[ai][bj][m][0], acc[ai][bj][m][1]);
                }
            }
    }
};

constexpr int NWAVES = 8;
constexpr int RING_OFF = 0, RING_BYTES = 131072;
struct Args { const float* in[20]; float* out; unsigned char* ws; int ph_lo, ph_hi, li, pad; };
constexpr int SCHED_OFF = RING_BYTES + 8192;

template <class F>
__device__ __forceinline__ void transpose_item(const float* W, int N, bf16* WT, int K, LAS float* scr, int kb, int nb, int lane, F srccol) {
    const int k0 = 64 * kb, n0 = 32 * nb; const int sc = srccol(n0);
#pragma unroll 8
    for (int i = 0; i < 32; ++i) { const int kk = 2 * i + (lane >> 5); scr[kk * 33 + (lane & 31)] = W[(size_t)(k0 + kk) * N + sc + (lane & 31)]; }
    asm volatile("s_waitcnt lgkmcnt(0)" ::: "memory");
    const int c = lane & 7;
#pragma unroll
    for (int j = 0; j < 4; ++j) { const int n = (lane >> 3) + 8 * j; const LAS float* s = scr + (8 * c) * 33 + n;
        v4u o; o.x = cvtpk(s[0 * 33], s[1 * 33]); o.y = cvtpk(s[2 * 33], s[3 * 33]); o.z = cvtpk(s[4 * 33], s[5 * 33]); o.w = cvtpk(s[6 * 33], s[7 * 33]);
        *(v4u*)(WT + (size_t)(n0 + n) * K + k0 + 8 * c) = o; }
    asm volatile("s_waitcnt lgkmcnt(0)" ::: "memory");
}

template <class F>
__device__ __forceinline__ void transpose_item8(const float* W, int N, unsigned char* WT, int K, float sc, LAS float* scr, int kb, int nb, int lane, F srccol) {
    const int k0 = 64 * kb, n0 = 32 * nb; const int scol = srccol(n0);
#pragma unroll 8
    for (int i = 0; i < 32; ++i) { const int kk = 2 * i + (lane >> 5); scr[kk * 33 + (lane & 31)] = W[(size_t)(k0 + kk) * N + scol + (lane & 31)] * sc; }
    asm volatile("s_waitcnt lgkmcnt(0)" ::: "memory");
    const int n = lane & 31, hf = lane >> 5; const LAS float* sp = scr + (32 * hf) * 33 + n;
    v4u o0, o1;
    o0.x = pk4_fp8(sp[0 * 33], sp[1 * 33], sp[2 * 33], sp[3 * 33]); o0.y = pk4_fp8(sp[4 * 33], sp[5 * 33], sp[6 * 33], sp[7 * 33]);
    o0.z = pk4_fp8(sp[8 * 33], sp[9 * 33], sp[10 * 33], sp[11 * 33]); o0.w = pk4_fp8(sp[12 * 33], sp[13 * 33], sp[14 * 33], sp[15 * 33]);
    o1.x = pk4_fp8(sp[16 * 33], sp[17 * 33], sp[18 * 33], sp[19 * 33]); o1.y = pk4_fp8(sp[20 * 33], sp[21 * 33], sp[22 * 33], sp[23 * 33]);
    o1.z = pk4_fp8(sp[24 * 33], sp[25 * 33], sp[26 * 33], sp[27 * 33]); o1.w = pk4_fp8(sp[28 * 33], sp[29 * 33], sp[30 * 33], sp[31 * 33]);
    unsigned char* d = WT + (size_t)(n0 + n) * K + k0 + 32 * hf;
    *(v4u*)d = o0; *(v4u*)(d + 16) = o1;
    asm volatile("s_waitcnt lgkmcnt(0)" ::: "memory");
}
__device__ __forceinline__ void p0_prologue(const Args& a, LAS unsigned char* lds, int vcu, int G, int wave, int lane) {
    LAS float* scr = (LAS float*)(lds + wave * 16384);
    unsigned char* ws = a.ws;
    const int gw = vcu * NWAVES + wave, NGW = G * NWAVES;
    constexpr int I_IN = 16 * (NCOLS / 32), I_BR = 8 * 32, I_OUT = 16 * 32;
    constexpr int NITEMS = I_IN + 2 * I_BR + I_OUT;
    for (int it = gw; it < NITEMS; it += NGW) {
        int r = it;
        if (r < I_IN) { transpose_item(a.in[2], NCOLS, (bf16*)(ws + WS_WIN), DM, scr, r / (NCOLS / 32), r % (NCOLS / 32), lane, [](int n) { return proj_logical_col(n); }); continue; } r -= I_IN;
        if (r < I_BR) { transpose_item(a.in[9], DM, (bf16*)(ws + WS_WHG), 512, scr, r / 32, r % 32, lane, [](int n) { return n; }); continue; } r -= I_BR;
        if (r < I_BR) { transpose_item(a.in[10], DM, (bf16*)(ws + WS_WDA), 512, scr, r / 32, r % 32, lane, [](int n) { return n; }); continue; } r -= I_BR;
        transpose_item(a.in[11], DM, (bf16*)(ws + WS_WOUT), DM, scr, r / 32, r % 32, lane, [](int n) { return n; });
    }
    const f32x4 g0 = ((const f32x4*)a.in[1])[lane], g1 = ((const f32x4*)a.in[1])[lane + 64], g2 = ((const f32x4*)a.in[1])[lane + 128], g3 = ((const f32x4*)a.in[1])[lane + 192];
    for (int m = gw; m < NT; m += NGW) {
        const f32x4* xr = (const f32x4*)(a.in[0] + (size_t)m * DM) + lane;
        f32x4 v0 = xr[0], v1 = xr[64], v2 = xr[128], v3 = xr[192];
        float s = 0.f;
#pragma unroll
        for (int e = 0; e < 4; ++e) s += v0[e] * v0[e] + v1[e] * v1[e] + v2[e] * v2[e] + v3[e] * v3[e];
        const float rstd = 1.0f / sqrtf(wave_sum(s) * (1.0f / DM) + EPS);
        v0 = v0 * g0 * rstd; v1 = v1 * g1 * rstd; v2 = v2 * g2 * rstd; v3 = v3 * g3 * rstd;
        v2u* o = (v2u*)((bf16*)(ws + WS_H) + (size_t)m * DM) + lane;
        o[0] = (v2u){cvtpk(v0[0], v0[1]), cvtpk(v0[2], v0[3])}; o[64] = (v2u){cvtpk(v1[0], v1[1]), cvtpk(v1[2], v1[3])};
        o[128] = (v2u){cvtpk(v2[0], v2[1]), cvtpk(v2[2], v2[3])}; o[192] = (v2u){cvtpk(v3[0], v3[1]), cvtpk(v3[2], v3[3])};
    }
    const int gt = (vcu * NWAVES + wave) * 64 + lane, NGT = NGW * 64;
    for (int i = gt; i < 4096 * 32; i += NGT) { const int pos = i >> 5, f = i & 31;
        const float inv = powf(10000.0f, -(float)f / 32.0f); const float ang = (float)pos * inv;
        ((f32x2*)(ws + WS_ROPE))[i] = (f32x2){cosf(ang), sinf(ang)}; }
    if (vcu == 0) {
        float* sm = (float*)(ws + WS_SMALL); const int t = wave * 64 + lane;
        { const float a0 = a.in[3][t], a1 = a.in[3][512 + t], mx = fmaxf(a0, a1), e0 = expf(a0 - mx), e1 = expf(a1 - mx); sm[t] = e0 / (e0 + e1); }
        if (wave == 0) {
            const float* lp = a.in[7];
            const float d01 = wave_sum(lp[lane] * lp[64 + lane]), d23 = wave_sum(lp[128 + lane] * lp[192 + lane]);
            float mq = fabsf(a.in[5][lane]), mk = fabsf(a.in[6][lane]);
            mq = wave_max(mq); mk = wave_max(mk);
            if (lane == 0) { sm[512] = expf(d01) - expf(d23) + 0.2f; sm[513] = 8.0f * mq * mk * LOG2E * 1.001f + 0.01f; }
        }
    }
}

__device__ __forceinline__ void router_phase(const Args& a, LAS unsigned char* lds, int G, int wave, int lane) {
    LAS float* wl = (LAS float*)lds;
    LAS float* gl = (LAS float*)(lds + 77824 + 256);
    LAS float* lg = gl + 1024 + wave * (16 * 48);
    LAS int* lhist = (LAS int*)(gl + 1024 + 8 * 16 * 48);
    LAS int* lbase = lhist + 64;
    LAS int* tbk = lbase + 64;
    LAS int* trk = tbk + 256;
    LAS float* twt = (LAS float*)(trk + 256);
    unsigned char* ws = a.ws; const int tid = tid_x();
    const float* wrg = a.in[13]; const float* wre = a.in[15];
    const bf16* x1b = (const bf16*)(ws + WS_X1B); const float* brg = a.in[14]; const float* bre = a.in[16];
    constexpr int WLS = 38;
    unsigned* gcnt = (unsigned*)(ws + WS_CTL) + CW_GCNT; v2u* rowtok = (v2u*)(ws + WS_ROWTOK);
    const int c16 = lane & 15, g4 = lane >> 4;
    for (int i = tid; i < 1024; i += 512) gl[i] = a.in[12][i];
    for (int batch = blockIdx.x; batch < NT / 128; batch += G) {
        const int t0 = batch * 128 + wave * 16;
        f32x4 acc0 = {0.f, 0.f, 0.f, 0.f}, acc1 = acc0, acc2 = acc0; float ss = 0.f;
        for (int half = 0; half < 2; ++half) {
            __syncthreads();
            if (half == 0 && tid < 64) lhist[tid] = 0;
#pragma unroll 8
            for (int i = tid; i < 512 * 32; i += 512) wl[(i >> 5) * WLS + 4 + (i & 31)] = wre[(size_t)half * 512 * 32 + i];
#pragma unroll
            for (int i = tid; i < 512 * 4; i += 512) wl[(i >> 2) * WLS + (i & 3)] = wrg[(size_t)half * 512 * 4 + i];
            __syncthreads();
            const unsigned char* xr = (const unsigned char*)(x1b + (size_t)(t0 + c16) * DM + 512 * half + 8 * g4);
#pragma unroll 2
            for (int sp = 0; sp < 16; ++sp) {
                const v4u xb = *(const v4u*)(xr + 64 * sp); const LAS float* gp = gl + 512 * half + 32 * sp + 8 * g4;
                const f32x4 ga = *(const LAS f32x4*)gp, gb = *(const LAS f32x4*)(gp + 4);
                float u[8];
#pragma unroll
                for (int e = 0; e < 4; ++e) { u[2 * e] = __uint_as_float(xb[e] << 16); u[2 * e + 1] = __uint_as_float(xb[e] & 0xffff0000u); }
#pragma unroll
                for (int e = 0; e < 8; ++e) ss += u[e] * u[e];
#pragma unroll
                for (int e = 0; e < 4; ++e) { u[e] *= ga[e]; u[4 + e] *= gb[e]; }
                const LAS float* wp = wl + (32 * sp + 8 * g4) * WLS + c16;
#pragma unroll
                for (int i = 0; i < 8; ++i) {
                    acc0 = __builtin_amdgcn_mfma_f32_16x16x4f32(u[i], wp[i * WLS], acc0, 0, 0, 0);
                    acc1 = __builtin_amdgcn_mfma_f32_16x16x4f32(u[i], wp[i * WLS + 16], acc1, 0, 0, 0);
                    acc2 = __builtin_amdgcn_mfma_f32_16x16x4f32(u[i], wp[i * WLS + 32], acc2, 0, 0, 0);
                }
            }
        }
        ss += swz_xor<16>(ss); { auto rr = __builtin_amdgcn_permlane32_swap(__float_as_uint(ss), __float_as_uint(ss), false, false); ss = __uint_as_float(rr[0]) + __uint_as_float(rr[1]); }
        const float rstd = 1.0f / sqrtf(ss * (1.0f / DM) + EPS);
#pragma unroll
        for (int r = 0; r < 4; ++r) { lg[(4 * g4 + r) * 48 + c16] = acc0[r]; lg[(4 * g4 + r) * 48 + 16 + c16] = acc1[r]; lg[(4 * g4 + r) * 48 + 32 + c16] = acc2[r]; }
        asm volatile("s_waitcnt lgkmcnt(0)" ::: "memory");
        if (lane < 16) {
            const LAS float* lt = lg + lane * 48; const int t = t0 + lane, li = wave * 16 + lane;
            float gl4[4]; int gsel = 0;
#pragma unroll
            for (int q = 0; q < 4; ++q) gl4[q] = lt[q] * rstd + brg[q];
            float gmax = gl4[0];
#pragma unroll
            for (int q = 1; q < 4; ++q) if (gl4[q] > gmax) { gmax = gl4[q]; gsel = q; }
            float den = 0.f;
#pragma unroll
            for (int q = 0; q < 4; ++q) den += expf(gl4[q] - gmax);
            const float gw_ = 1.0f / den;
            float el[8];
#pragma unroll
            for (int q = 0; q < 8; ++q) el[q] = lt[4 + 8 * gsel + q] * rstd + bre[gsel * 8 + q];
            int i0 = 0; float v0 = el[0];
#pragma unroll
            for (int q = 1; q < 8; ++q) if (el[q] > v0) { v0 = el[q]; i0 = q; }
            int i1 = -1; float v1 = -3.0e38f;
#pragma unroll
            for (int q = 0; q < 8; ++q) if (q != i0 && el[q] > v1) { v1 = el[q]; i1 = q; }
            const float w1f = 1.0f / (1.0f + expf(v0 - v1)), w0f = 1.0f - w1f;
            const int b0 = gsel * 8 + i0, b1 = 32 + gsel * 8 + i1;
            tbk[2 * li] = b0; tbk[2 * li + 1] = b1;
            trk[2 * li] = atomicAdd((int*)&lhist[b0], 1); trk[2 * li + 1] = atomicAdd((int*)&lhist[b1], 1);
            twt[2 * li] = w0f * gw_; twt[2 * li + 1] = w1f * gw_;
        }
#pragma unroll
        for (int r = 0; r < 16; ++r) {
            const float rs = __uint_as_float(__builtin_amdgcn_readlane(__float_as_uint(rstd), r));
            const v4u* xr = (const v4u*)(x1b + (size_t)(t0 + r) * DM) + lane;
            v2u* o = (v2u*)(ws + WS_XN + (size_t)(t0 + r) * DM) + lane;
#pragma unroll
            for (int j = 0; j < 2; ++j) { const v4u xb = xr[64 * j]; const LAS float* gp = gl + 8 * lane + 512 * j; const f32x4 ga = *(const LAS f32x4*)gp * rs, gb = *(const LAS f32x4*)(gp + 4) * rs;
                o[64 * j] = (v2u){pk4_fp8(__uint_as_float(xb.x << 16) * ga[0], __uint_as_float(xb.x & 0xffff0000u) * ga[1], __uint_as_float(xb.y << 16) * ga[2], __uint_as_float(xb.y & 0xffff0000u) * ga[3]),
                                  pk4_fp8(__uint_as_float(xb.z << 16) * gb[0], __uint_as_float(xb.z & 0xffff0000u) * gb[1], __uint_as_float(xb.w << 16) * gb[2], __uint_as_float(xb.w & 0xffff0000u) * gb[3])}; }
        }
        __syncthreads();
        if (tid < 64) { const int c = lhist[tid]; lbase[tid] = c ? (int)atomicAdd(&gcnt[tid * 16], (unsigned)c) : 0; }
        __syncthreads();
        if (tid < 256) { const int bk = tbk[tid]; const int slot = lbase[bk] + trk[tid]; rowtok[(size_t)bk * RCAP + slot] = (v2u){(unsigned)(batch * 128 + (tid >> 1)), __float_as_uint(twt[tid])};
            ((v2u*)(ws + WS_TOKPOS))[(size_t)batch * 256 + tid] = (v2u){((unsigned)bk << 16) | (unsigned)slot, __float_as_uint(twt[tid])}; }
    }
    __syncthreads();
}

__device__ __forceinline__ void w13_convert(const Args& a, LAS unsigned char* lds, int vcu, int G, int wave, int lane) {
    LAS float* scr = (LAS float*)(lds + wave * 16384);
    const int gw = vcu * NWAVES + wave, NGW = G * NWAVES;
    for (int it = gw; it < NEXP * 512; it += NGW) {
        const int e = it >> 9, q = it & 511, kb = q >> 5, nb = q & 31, n0 = nb * 32, bj = (n0 >> 7) & 1;
        const float* W = (bj ? a.in[18] : a.in[17]) + (size_t)e * DM * DFF;
        transpose_item8(W, DFF, a.ws + WS_W13T + (size_t)e * DM * DM, DM, 32.0f, scr, kb, nb, lane, [](int n) { return 128 * (n >> 8) + (n & 127); });
    }
    for (int it = gw; it < NEXP * 256; it += NGW) {
        const int e = it >> 8, q = it & 255;
        transpose_item8(a.in[19] + (size_t)e * DFF * DM, DM, a.ws + WS_W2T + (size_t)e * DM * DFF, DFF, 16.0f, scr, q / 32, q % 32, lane, [](int n) { return n; });
    }
}
__device__ __forceinline__ void moe_sched_setup(const Args& a, LAS unsigned char* lds) {
    LAS int* pref = (LAS int*)(lds + SCHED_OFF); LAS int* cnt = pref + 80;
    const unsigned* gcnt = (const unsigned*)(a.ws + WS_CTL) + CW_GCNT;
    const int t_ = tid_x();
    if (t_ < 64) {
        const int c = (int)gcnt[t_ * 16]; cnt[t_] = c;
        int v = (c + 255) >> 8;
        volatile LAS int* tmp = (volatile LAS int*)(pref + 160);
#pragma unroll
        for (int o = 1; o < 64; o <<= 1) { tmp[t_] = v; const int up = tmp[t_ >= o ? t_ - o : 0]; if (t_ >= o) v += up; }
        pref[t_ + 1] = v; if (t_ == 0) pref[0] = 0;
    }
    __syncthreads();
}

namespace att {
constexpr int SLOT = 16384;
constexpr int LDS_K = 0, LDS_V = 2 * SLOT, LDS_L = 4 * SLOT, LDS_STG = 4 * SLOT + 4096;
typedef short v4i16_t __attribute__((ext_vector_type(4)));
__device__ __forceinline__ s16x4 vtr(const LAS unsigned char* p) { return __builtin_bit_cast(s16x4, __builtin_amdgcn_ds_read_tr16_b64_v4i16((LAS v4i16_t*)p)); }
#define ATT_WAIT_BAR(N) asm volatile("s_waitcnt vmcnt(" #N ")\n\ts_barrier" ::: "memory")
#define ATT_MFMA(a, b, c) __builtin_amdgcn_mfma_f32_32x32x16_bf16((a), (b), (c), 0, 0, 0)
__device__ __forceinline__ void softmax_tile(f32x16& p0, f32x16& p1, bf16x8 (&pa)[4], float& lsum, int jb, int qrel, int hh, float mshift) {
    if (jb >= 0) {
#pragma unroll
        for (int r = 0; r < 16; ++r) { const int kr = 64 * jb + (r & 7) + 8 * hh + 16 * (r >> 3);
            if (kr > qrel) p0[r] = -INFINITY; if (kr + 32 > qrel) p1[r] = -INFINITY; }
    }
    float s = 0.f;
#pragma unroll
    for (int r = 0; r < 16; ++r) { p0[r] = __builtin_amdgcn_exp2f(p0[r] - mshift); p1[r] = __builtin_amdgcn_exp2f(p1[r] - mshift); s += p0[r] + p1[r]; }
    lsum += s;
    v4u w;
    w.x = cvtpk(p0[0], p0[1]); w.y = cvtpk(p0[2], p0[3]); w.z = cvtpk(p0[4], p0[5]); w.w = cvtpk(p0[6], p0[7]); pa[0] = __builtin_bit_cast(bf16x8, w);
    w.x = cvtpk(p0[8], p0[9]); w.y = cvtpk(p0[10], p0[11]); w.z = cvtpk(p0[12], p0[13]); w.w = cvtpk(p0[14], p0[15]); pa[1] = __builtin_bit_cast(bf16x8, w);
    w.x = cvtpk(p1[0], p1[1]); w.y = cvtpk(p1[2], p1[3]); w.z = cvtpk(p1[4], p1[5]); w.w = cvtpk(p1[6], p1[7]); pa[2] = __builtin_bit_cast(bf16x8, w);
    w.x = cvtpk(p1[8], p1[9]); w.y = cvtpk(p1[10], p1[11]); w.z = cvtpk(p1[12], p1[13]); w.w = cvtpk(p1[14], p1[15]); pa[3] = __builtin_bit_cast(bf16x8, w);
}
struct E16 { float v[16]; };
__device__ __forceinline__ void soft_half(f32x16& p, bf16x8& paA, bf16x8& paB, float& lsum, int jb, int wid, int half) {
    if (jb >= 0) {
        const int ln = (int)lane_id(), hh = ln >> 5, qrel = wid * 32 + (ln & 31);
#pragma unroll
        for (int r = 0; r < 16; ++r) { const int kr = 64 * jb + 32 * half + (r & 7) + 8 * hh + 16 * (r >> 3); if (kr > qrel) p[r] = -INFINITY; }
    }
    float e[16];
#pragma unroll
    for (int r = 0; r < 16; ++r) e[r] = __builtin_amdgcn_exp2f(p[r]);
    const float s0 = (e[0] + e[1]) + (e[2] + e[3]), s1 = (e[4] + e[5]) + (e[6] + e[7]), s2 = (e[8] + e[9]) + (e[10] + e[11]), s3 = (e[12] + e[13]) + (e[14] + e[15]);
    lsum += (s0 + s1) + (s2 + s3);
    v4u w;
    w.x = cvtpk(e[0], e[1]); w.y = cvtpk(e[2], e[3]); w.z = cvtpk(e[4], e[5]); w.w = cvtpk(e[6], e[7]); paA = __builtin_bit_cast(bf16x8, w);
    w.x = cvtpk(e[8], e[9]); w.y = cvtpk(e[10], e[11]); w.z = cvtpk(e[12], e[13]); w.w = cvtpk(e[14], e[15]); paB = __builtin_bit_cast(bf16x8, w);
    asm volatile("" : "+v"(paA), "+v"(paB), "+v"(lsum));
}
__device__ __forceinline__ void exp_half(f32x16& p, E16& e, int jb, int wid, int half) {
    if (jb >= 0) {
        const int ln = (int)lane_id(), hh = ln >> 5, qrel = wid * 32 + (ln & 31);
#pragma unroll
        for (int r = 0; r < 16; ++r) { const int kr = 64 * jb + 32 * half + (r & 7) + 8 * hh + 16 * (r >> 3); if (kr > qrel) p[r] = -INFINITY; }
    }
#pragma unroll
    for (int r = 0; r < 16; ++r) e.v[r] = __builtin_amdgcn_exp2f(p[r]);
    asm volatile("" : "+v"(e.v[0]), "+v"(e.v[1]), "+v"(e.v[2]), "+v"(e.v[3]), "+v"(e.v[4]), "+v"(e.v[5]), "+v"(e.v[6]), "+v"(e.v[7]),
                      "+v"(e.v[8]), "+v"(e.v[9]), "+v"(e.v[10]), "+v"(e.v[11]), "+v"(e.v[12]), "+v"(e.v[13]), "+v"(e.v[14]), "+v"(e.v[15]));
}
__device__ __forceinline__ void pack_half(const E16& e, bf16x8& paA, bf16x8& paB, float& lsum) {
    const float* p = e.v;
    float s0 = (p[0] + p[1]) + (p[2] + p[3]), s1 = (p[4] + p[5]) + (p[6] + p[7]), s2 = (p[8] + p[9]) + (p[10] + p[11]), s3 = (p[12] + p[13]) + (p[14] + p[15]);
    lsum += (s0 + s1) + (s2 + s3);
    v4u w;
    w.x = cvtpk(p[0], p[1]); w.y = cvtpk(p[2], p[3]); w.z = cvtpk(p[4], p[5]); w.w = cvtpk(p[6], p[7]); paA = __builtin_bit_cast(bf16x8, w);
    w.x = cvtpk(p[8], p[9]); w.y = cvtpk(p[10], p[11]); w.z = cvtpk(p[12], p[13]); w.w = cvtpk(p[14], p[15]); paB = __builtin_bit_cast(bf16x8, w);
}
__device__ __forceinline__ void softmax_half(f32x16& p, bf16x8& paA, bf16x8& paB, float& lsum, int jb, int qrel, int hh, float mshift, int half) {
    if (jb >= 0) {
#pragma unroll
        for (int r = 0; r < 16; ++r) { const int kr = 64 * jb + 32 * half + (r & 7) + 8 * hh + 16 * (r >> 3); if (kr > qrel) p[r] = -INFINITY; }
    }
    float s = 0.f;
#pragma unroll
    for (int r = 0; r < 16; ++r) { p[r] = __builtin_amdgcn_exp2f(p[r] - mshift); s += p[r]; }
    lsum += s;
    v4u w;
    w.x = cvtpk(p[0], p[1]); w.y = cvtpk(p[2], p[3]); w.z = cvtpk(p[4], p[5]); w.w = cvtpk(p[6], p[7]); paA = __builtin_bit_cast(bf16x8, w);
    w.x = cvtpk(p[8], p[9]); w.y = cvtpk(p[10], p[11]); w.z = cvtpk(p[12], p[13]); w.w = cvtpk(p[14], p[15]); paB = __builtin_bit_cast(bf16x8, w);
}
__device__ __forceinline__ void attn_unit(int bh, int qb, unsigned char* ws, LAS unsigned char* lds, float mshift, float lam, const float* gain) {
    int tid = tid_x(); asm volatile("" : "+v"(tid));
    const int lane = tid & 63, wid = __builtin_amdgcn_readfirstlane(tid >> 6), r32 = lane & 31, hh = lane >> 5;
    const int NTL = 4 * (qb + 1);
    const unsigned char* kgu = ws + WS_KIMG + ((size_t)bh << 20) + wid * 1024;
    const unsigned char* vgu = ws + WS_VIMG + ((size_t)bh << 20) + wid * 1024;

    {
        const unsigned char* Qg = ws + WS_QT + ((size_t)bh * 4096 + qb * 256 + wid * 32) * 256;
#pragma unroll
        for (int i = 0; i < 8; ++i) { const unsigned row = 8u * (i >> 1) + (((unsigned)lane >> 2) & 7u), ch = 4u * (2u * (i & 1) + ((unsigned)lane >> 5)) + (((unsigned)lane & 3u) ^ ((row >> 2) & 3u));
            __builtin_amdgcn_global_load_lds((const unsigned*)(Qg + row * 256 + ch * 16), (LAS unsigned*)(lds + LDS_STG + wid * 8192 + i * 1024), 16, 0, 0); }
    }
    const LAS unsigned char* Qb = lds + LDS_STG + wid * 8192;
#define ATT_DMA_K(t, slot) do { const unsigned char* tb_ = kgu + ((size_t)(t) << 14); \
        const unsigned lo16 = lane_id() * 16u; __builtin_amdgcn_global_load_lds((const unsigned*)(tb_ + lo16), (LAS unsigned*)(lds + LDS_K + (slot) * SLOT + wid * 1024), 16, 0, 0); \
        __builtin_amdgcn_global_load_lds((const unsigned*)(tb_ + 8192 + lo16), (LAS unsigned*)(lds + LDS_K + (slot) * SLOT + 8192 + wid * 1024), 16, 0, 0); } while (0)
#define ATT_DMA_V(t, slot) do { const unsigned char* tb_ = vgu + ((size_t)(t) << 14); \
        const unsigned lo16 = lane_id() * 16u; __builtin_amdgcn_global_load_lds((const unsigned*)(tb_ + lo16), (LAS unsigned*)(lds + LDS_V + (slot) * SLOT + wid * 1024), 16, 0, 0); \
        __builtin_amdgcn_global_load_lds((const unsigned*)(tb_ + 8192 + lo16), (LAS unsigned*)(lds + LDS_V + (slot) * SLOT + 8192 + wid * 1024), 16, 0, 0); } while (0)
    ATT_DMA_K(0, 0); ATT_DMA_V(0, 0);
    f32x16 o1[4], o2[4];
#pragma unroll
    for (int c = 0; c < 4; ++c)
#pragma unroll
        for (int r = 0; r < 16; ++r) { o1[c][r] = 0.f; o2[c][r] = 0.f; }
    float l1 = 0.f, l2 = 0.f;
    const unsigned krb = 2048u * ((unsigned)r32 >> 3) + 64u * ((unsigned)r32 & 7u), krs = ((unsigned)r32 >> 2) & 3u;
    const unsigned kr0 = krb + 16u * (hh ^ krs);
    const unsigned tq = ((unsigned)lane & 15u) >> 2, tp = (unsigned)lane & 3u, tblk = ((unsigned)lane >> 4) & 1u;
    const unsigned tvb = 2048u * hh + 64u * tq + 8u * (tp & 1u), tvx = (2u * tblk + (tp >> 1)) ^ (2u * hh);
    const unsigned tv0 = tvb + 16u * tvx;
    const int NPH = 2 * NTL;
#define ATT_BOUNDARY(ph_) do { const int ph__ = (ph_); \
        if (ph__ + 1 < NPH) asm volatile("s_waitcnt vmcnt(2) lgkmcnt(0)\n\ts_barrier" ::: "memory"); else asm volatile("s_waitcnt vmcnt(0) lgkmcnt(0)\n\ts_barrier" ::: "memory"); \
        const int m__ = ph__ + 2; if (m__ < NPH) { if (m__ & 1) ATT_DMA_V(m__ >> 1, (m__ >> 1) & 1); else ATT_DMA_K(m__ >> 1, (m__ >> 1) & 1); } } while (0)
#define ATT_SB() __builtin_amdgcn_sched_barrier(0)
#define ATT_KADDR(m_, j_) ((((j_) & 1) ? (kr0 ^ 32u) : kr0) + 512u * (2 * (m_) + ((j_) >> 1)))
#define ATT_LDQ(m_) do { _Pragma("unroll") for (int j = 0; j < 4; ++j) qF[j] = *(const LAS bf16x8*)(Qb + ATT_KADDR(m_, j)); } while (0)
#define ATT_LDK(m_, h_) do { _Pragma("unroll") for (int j = 0; j < 4; ++j) kF[j] = *(const LAS bf16x8*)(Kb + ATT_KADDR(m_, j) + 8192 * (h_)); } while (0)
#define ATT_CHAIN() do { _Pragma("unroll") for (int r = 0; r < 16; ++r) p[r] = -mshift; _Pragma("unroll") for (int j = 0; j < 4; ++j) p = ATT_MFMA(kF[j], qF[j], p); } while (0)
#define ATT_X(t_) do { const int jb = (t_) - (NTL - 4); const LAS unsigned char* Kb = lds + LDS_K + ((t_) & 1) * SLOT; bf16x8 qF[4], kF[4]; f32x16 p; \
        ATT_LDQ(0); ATT_LDK(0, 0); ATT_SB(); \
        ATT_CHAIN(); ATT_SB(); ATT_LDK(0, 1); ATT_SB(); soft_half(p, pa1[0], pa1[1], l1, jb, wid, 0); ATT_SB(); \
        ATT_CHAIN(); ATT_SB(); ATT_LDQ(1); ATT_LDK(1, 0); ATT_SB(); soft_half(p, pa1[2], pa1[3], l1, jb, wid, 1); ATT_SB(); \
        ATT_CHAIN(); ATT_SB(); ATT_LDK(1, 1); ATT_SB(); soft_half(p, pa2[0], pa2[1], l2, jb, wid, 0); ATT_SB(); \
        ATT_CHAIN(); ATT_SB(); soft_half(p, pa2[2], pa2[3], l2, jb, wid, 1); ATT_SB(); } while (0)
#define ATT_VLOAD(buf, i) asm volatile("ds_read_b64_tr_b16 %0, %2 offset:%c4\n\tds_read_b64_tr_b16 %1, %3 offset:%c4" : "=&v"(vlo[buf]), "=&v"(vhi[buf]) : "v"(va0), "v"(va1), "i"(4096 * ((i) & 3) + 512 * ((i) >> 2)) : "memory")
#define ATT_Y(t_) do { const unsigned va0 = (unsigned)(uintptr_t)(lds + LDS_V + ((t_) & 1) * SLOT) + tv0, va1 = (unsigned)(uintptr_t)(lds + LDS_V + ((t_) & 1) * SLOT) + (tv0 ^ 16u) + 256u; \
        s16x4 vlo[3], vhi[3]; ATT_VLOAD(0, 0); ATT_VLOAD(1, 1); \
        _Pragma("unroll") for (int i = 0; i < 16; ++i) { if (i + 2 < 16) ATT_VLOAD((i + 2) % 3, i + 2); \
            if (i + 2 < 16) asm volatile("s_waitcnt lgkmcnt(4)" : "+v"(vlo[i % 3]), "+v"(vhi[i % 3]) :: "memory"); \
            else if (i + 1 < 16) asm volatile("s_waitcnt lgkmcnt(2)" : "+v"(vlo[i % 3]), "+v"(vhi[i % 3]) :: "memory"); \
            else asm volatile("s_waitcnt lgkmcnt(0)" : "+v"(vlo[i % 3]), "+v"(vhi[i % 3]) :: "memory"); \
            const bf16x8 vf = __builtin_shufflevector(vlo[i % 3], vhi[i % 3], 0, 1, 2, 3, 4, 5, 6, 7); \
            o1[i >> 2] = ATT_MFMA(pa1[i & 3], vf, o1[i >> 2]); o2[i >> 2] = ATT_MFMA(pa2[i & 3], vf, o2[i >> 2]); } } while (0)
    if (wid < 4) {
        for (int t = 0; t < NTL; ++t) {
            const bool on = (t - (NTL - 4)) <= (wid >> 1);
            bf16x8 pa1[4], pa2[4];
            ATT_BOUNDARY(2 * t);
            if (on) { __builtin_amdgcn_s_setprio(3); ATT_X(t); __builtin_amdgcn_s_setprio(0); }
            ATT_BOUNDARY(2 * t + 1);
            if (on) ATT_Y(t);
        }
        ATT_BOUNDARY(NPH);
    } else {
        ATT_BOUNDARY(0);
        for (int t = 0; t < NTL; ++t) {
            const bool on = (t - (NTL - 4)) <= (wid >> 1);
            bf16x8 pa1[4], pa2[4];
            ATT_BOUNDARY(2 * t + 1);
            if (on) { __builtin_amdgcn_s_setprio(3); ATT_X(t); __builtin_amdgcn_s_setprio(0); }
            ATT_BOUNDARY(2 * t + 2);
            if (on) ATT_Y(t);
        }
    }
#undef ATT_BOUNDARY
#undef ATT_X
#undef ATT_Y
#undef ATT_KADDR
#undef ATT_LDQ
#undef ATT_LDK
#undef ATT_CHAIN
#undef ATT_VLOAD
#undef ATT_SB
    { auto rr = __builtin_amdgcn_permlane32_swap(__float_as_uint(l1), __float_as_uint(l1), false, false); l1 = __uint_as_float(rr[0]) + __uint_as_float(rr[1]); }
    { auto rr = __builtin_amdgcn_permlane32_swap(__float_as_uint(l2), __float_as_uint(l2), false, false); l2 = __uint_as_float(rr[0]) + __uint_as_float(rr[1]); }
    int lane_e = (int)lane_id(); asm volatile("" : "+v"(lane_e));
    const int hh_e = lane_e >> 5, r32_e = lane_e & 31;
    LAS float* lw = (LAS float*)(lds + LDS_L) + wid * 64;
    if (hh_e == 0) { lw[r32_e] = 1.0f / l1; lw[32 + r32_e] = lam / l2; }
    asm volatile("s_waitcnt lgkmcnt(0)" ::: "memory");
    float ssq[16];
#pragma unroll
    for (int r = 0; r < 16; ++r) { const int qr = (r & 3) + 8 * (r >> 2) + 4 * hh_e; const float i1 = lw[qr], i2 = lw[32 + qr]; float s = 0.f;
#pragma unroll
        for (int c = 0; c < 4; ++c) { const float o = o1[c][r] * i1 - o2[c][r] * i2; o1[c][r] = o; s += o * o; }
        ssq[r] = s; }
#pragma unroll
    for (int r = 0; r < 16; ++r) { float s = ssq[r]; s += swz_xor<1>(s); s += swz_xor<2>(s); s += swz_xor<4>(s); s += swz_xor<8>(s); s += swz_xor<16>(s); ssq[r] = 0.8f / sqrtf(s * (1.0f / 128.0f) + EPS); }
    LAS bf16* stg = (LAS bf16*)(lds + LDS_STG) + wid * 4096;
    float gn[4];
#pragma unroll
    for (int c = 0; c < 4; ++c) gn[c] = gain[32 * c + r32_e];
#pragma unroll
    for (int r = 0; r < 16; ++r) { const int qr = (r & 3) + 8 * (r >> 2) + 4 * hh_e;
#pragma unroll
        for (int c = 0; c < 4; ++c) stg[qr * 128 + 32 * c + r32_e] = (bf16)f2bf(o1[c][r] * ssq[r] * gn[c]); }
    asm volatile("s_waitcnt lgkmcnt(0)" ::: "memory");
    bf16* og = (bf16*)(ws + WS_ODA) + ((size_t)(bh >> 2) * 4096 + qb * 256 + wid * 32) * 512 + 128 * (bh & 3);
#pragma unroll
    for (int i = 0; i < 8; ++i) { const int row = i * 4 + (lane_e >> 4), chk = lane_e & 15; *(v4u*)(og + (size_t)row * 512 + chk * 8) = *(const LAS v4u*)(stg + row * 128 + chk * 8); }
    asm volatile("s_waitcnt vmcnt(0) lgkmcnt(0)\n\ts_barrier" ::: "memory");
#undef ATT_DMA_K
#undef ATT_DMA_V
}
__device__ __forceinline__ void attn_phase(unsigned char* ws, LAS unsigned char* lds, int vcu, int G, const float* gain) {
    const float* sm = (const float*)(ws + WS_SMALL);
    const float lam = __uint_as_float(__builtin_amdgcn_readfirstlane(__float_as_uint(sm[512]))), mshift = __uint_as_float(__builtin_amdgcn_readfirstlane(__float_as_uint(sm[513])));
    for (int p = vcu; p < 256; p += G) {
        const int bh = p >> 3, s = p & 7;
        for (int uu = 0; uu < 2; ++uu) attn_unit(bh, uu ? s : 15 - s, ws, lds, mshift, lam, gain);
    }
}
}

namespace hg {
constexpr int L_HQ = 0, L_HF = 16384, L_HI = 32768, L_HOG = 49152, L_QD = 65536, L_ST = 81920, L_O = 114688, L_PS = 147456;
#define HG_MFMA(a, b, c) __builtin_amdgcn_mfma_f32_32x32x16_bf16((a), (b), (c), 0, 0, 0)
__device__ __forceinline__ void dma16k(const unsigned char* g, LAS unsigned char* l, int wid, int lane) {
    __builtin_amdgcn_global_load_lds((const unsigned*)(g + wid * 1024 + lane * 16), (LAS unsigned*)(l + wid * 1024), 16, 0, 0);
    __builtin_amdgcn_global_load_lds((const unsigned*)(g + 8192 + wid * 1024 + lane * 16), (LAS unsigned*)(l + 8192 + wid * 1024), 16, 0, 0);
}
__device__ __forceinline__ bf16x8 trfrag(const LAS unsigned char* base, unsigned tv0, unsigned tv1, int c, int ks) {
    const s16x4 lo = att::vtr(base + tv0 + 4096 * ks + 512 * c), hi = att::vtr(base + tv1 + 4096 * ks + 512 * c);
    return __builtin_shufflevector(lo, hi, 0, 1, 2, 3, 4, 5, 6, 7);
}
__device__ __forceinline__ void tr3_asm(bf16x8& f0, bf16x8& f1, bf16x8& f2, unsigned a00, unsigned a01, unsigned a10, unsigned a11, unsigned a20, unsigned a21) {
    s16x4 l0, h0, l1, h1, l2, h2;
    asm volatile("ds_read_b64_tr_b16 %0, %6\n\tds_read_b64_tr_b16 %1, %7\n\tds_read_b64_tr_b16 %2, %8\n\tds_read_b64_tr_b16 %3, %9\n\tds_read_b64_tr_b16 %4, %10\n\tds_read_b64_tr_b16 %5, %11\n\ts_waitcnt lgkmcnt(0)"
                 : "=&v"(l0), "=&v"(h0), "=&v"(l1), "=&v"(h1), "=&v"(l2), "=&v"(h2) : "v"(a00), "v"(a01), "v"(a10), "v"(a11), "v"(a20), "v"(a21) : "memory");
    f0 = __builtin_shufflevector(l0, h0, 0, 1, 2, 3, 4, 5, 6, 7); f1 = __builtin_shufflevector(l1, h1, 0, 1, 2, 3, 4, 5, 6, 7); f2 = __builtin_shufflevector(l2, h2, 0, 1, 2, 3, 4, 5, 6, 7);
}
__device__ __forceinline__ void tr2_asm(bf16x8& f0, bf16x8& f1, unsigned a00, unsigned a01, unsigned a10, unsigned a11) {
    s16x4 l0, h0, l1, h1;
    asm volatile("ds_read_b64_tr_b16 %0, %4\n\tds_read_b64_tr_b16 %1, %5\n\tds_read_b64_tr_b16 %2, %6\n\tds_read_b64_tr_b16 %3, %7\n\ts_waitcnt lgkmcnt(0)"
                 : "=&v"(l0), "=&v"(h0), "=&v"(l1), "=&v"(h1) : "v"(a00), "v"(a01), "v"(a10), "v"(a11) : "memory");
    f0 = __builtin_shufflevector(l0, h0, 0, 1, 2, 3, 4, 5, 6, 7); f1 = __builtin_shufflevector(l1, h1, 0, 1, 2, 3, 4, 5, 6, 7);
}
__device__ __forceinline__ bf16x8 rowfrag(const LAS unsigned char* base, unsigned kr0, unsigned kr1, int rblk, int s) {
    return *(const LAS bf16x8*)(base + 8192 * rblk + ((s & 1) ? kr1 : kr0) + 512 * (s >> 1));
}
__device__ __forceinline__ bf16x8 pack_lo(const f32x16& p) { v4u w; w.x = cvtpk(p[0], p[1]); w.y = cvtpk(p[2], p[3]); w.z = cvtpk(p[4], p[5]); w.w = cvtpk(p[6], p[7]); return __builtin_bit_cast(bf16x8, w); }
__device__ __forceinline__ bf16x8 pack_hi(const f32x16& p) { v4u w; w.x = cvtpk(p[8], p[9]); w.y = cvtpk(p[10], p[11]); w.z = cvtpk(p[12], p[13]); w.w = cvtpk(p[14], p[15]); return __builtin_bit_cast(bf16x8, w); }

__device__ __forceinline__ void b1_group(int bh, int s8, unsigned char* ws, LAS unsigned char* lds) {
    int tid = tid_x(); asm volatile("" : "+v"(tid));
    const int lane = tid & 63, wid = __builtin_amdgcn_readfirstlane(tid >> 6), r32 = lane & 31, hh = lane >> 5;
    const int k2 = lane;
    const float lb0 = ((const float*)(ws + WS_SMALL))[128 * (bh & 3) + 2 * k2], lb1 = ((const float*)(ws + WS_SMALL))[128 * (bh & 3) + 2 * k2 + 1];
    LAS float* ps = (LAS float*)(lds + L_PS);
    const unsigned tq = ((unsigned)lane & 15u) >> 2, tp = (unsigned)lane & 3u, tblk = ((unsigned)lane >> 4) & 1u;
    const unsigned tvb = 2048u * hh + 64u * tq + 8u * (tp & 1u), tvx = (2u * tblk + (tp >> 1)) ^ (2u * hh);
    const unsigned tv0 = tvb + 16u * tvx, tv1 = tvb + 256u + 16u * (tvx ^ 1u);
    const int kb = wid >> 1, vb0 = 2 * (wid & 1);
    { const int item = bh * 64 + s8; dma16k(ws + WS_HF + ((size_t)item << 14), lds, wid, lane); dma16k(ws + WS_HI + ((size_t)item << 14), lds + 16384, wid, lane); }
    for (int j = 0; j < 8; ++j) {
        const int item = bh * 64 + s8 + 8 * j; LAS unsigned char* B = lds + (j & 1) * 32768;
        if (j + 1 < 8) { LAS unsigned char* Bn = lds + ((j + 1) & 1) * 32768; dma16k(ws + WS_HF + ((size_t)(item + 8) << 14), Bn, wid, lane); dma16k(ws + WS_HI + ((size_t)(item + 8) << 14), Bn + 16384, wid, lane);
            asm volatile("s_waitcnt vmcnt(4)\n\ts_barrier" ::: "memory"); }
        else asm volatile("s_waitcnt vmcnt(0)\n\ts_barrier" ::: "memory");
        float f0[8], f1[8], c0[8], c1[8]; float r0 = 0.f, r1 = 0.f;
#pragma unroll
        for (int i = 0; i < 8; ++i) { const unsigned w = *(const LAS unsigned*)(B + img_off_a(8 * wid + i, 2 * k2));
            const float h0 = __uint_as_float(w << 16), h1 = __uint_as_float(w & 0xffff0000u);
            f0[i] = lb0 + (1.0f - lb0) * rcpf_(1.0f + __expf(-h0)); f1[i] = lb1 + (1.0f - lb1) * rcpf_(1.0f + __expf(-h1));
            r0 += __logf(f0[i]); r1 += __logf(f1[i]); c0[i] = r0; c1[i] = r1; }
        *(LAS f32x2*)(ps + wid * 128 + 2 * k2) = (f32x2){r0, r1};
        asm volatile("s_waitcnt lgkmcnt(0)\n\ts_barrier" ::: "memory");
        float base0 = 0.f, base1 = 0.f, tot0 = 0.f, tot1 = 0.f;
#pragma unroll
        for (int w = 0; w < 8; ++w) { const f32x2 p = *(const LAS f32x2*)(ps + w * 128 + 2 * k2); if (w < wid) { base0 += p[0]; base1 += p[1]; } tot0 += p[0]; tot1 += p[1]; }
#pragma unroll
        for (int i = 0; i < 8; ++i) { const float b0 = base0 + c0[i], b1 = base1 + c1[i];
            *(LAS unsigned*)(B + img_off_a(8 * wid + i, 2 * k2)) = cvtpk((1.0f - f0[i]) * __expf(tot0 - b0), (1.0f - f1[i]) * __expf(tot1 - b1)); }
        if (wid == 0) *(f32x2*)((float*)(ws + WS_DECAY) + (size_t)item * 128 + 2 * k2) = (f32x2){__expf(tot0), __expf(tot1)};
        asm volatile("s_waitcnt lgkmcnt(0)\n\ts_barrier" ::: "memory");
        f32x16 a0, a1;
#pragma unroll
        for (int r = 0; r < 16; ++r) { a0[r] = 0.f; a1[r] = 0.f; }
        const unsigned bA = (unsigned)(uintptr_t)B, bI = bA + 16384u;
#pragma unroll
        for (int ks = 0; ks < 4; ++ks) { bf16x8 A, B0, B1;
            tr3_asm(A, B0, B1, bA + tv0 + 4096 * ks + 512 * kb, bA + tv1 + 4096 * ks + 512 * kb, bI + tv0 + 4096 * ks + 512 * vb0, bI + tv1 + 4096 * ks + 512 * vb0, bI + tv0 + 4096 * ks + 512 * (vb0 + 1), bI + tv1 + 4096 * ks + 512 * (vb0 + 1));
            a0 = HG_MFMA(A, B0, a0); a1 = HG_MFMA(A, B1, a1); }
        unsigned char* dst = ws + WS_DST + ((size_t)item << 15);
#pragma unroll
        for (int g = 0; g < 4; ++g) { const unsigned k0 = 32u * kb + 8u * g + 4u * hh;
            *(v2u*)(dst + off_a(32u * vb0 + r32, k0 >> 3) + (k0 & 7u) * 2u) = (v2u){cvtpk(a0[4 * g], a0[4 * g + 1]), cvtpk(a0[4 * g + 2], a0[4 * g + 3])};
            *(v2u*)(dst + off_a(32u * (vb0 + 1) + r32, k0 >> 3) + (k0 & 7u) * 2u) = (v2u){cvtpk(a1[4 * g], a1[4 * g + 1]), cvtpk(a1[4 * g + 2], a1[4 * g + 3])}; }
        asm volatile("s_waitcnt lgkmcnt(0)\n\ts_barrier" ::: "memory");
    }
}

__device__ __forceinline__ void scan_slice(unsigned char* ws, int bh, int e) {
    const unsigned pos = 8u * (unsigned)e;
    const unsigned row = 8u * (pos >> 11) + ((pos >> 6) & 7u), ch = 4u * ((pos >> 9) & 3u) + (((pos >> 4) & 3u) ^ ((row >> 2) & 3u)), k0 = 8u * ch + 4u * ((pos >> 3) & 1u);
    unsigned char* img = ws + WS_DST + ((size_t)bh << 21) + pos; const float* dec = (const float*)(ws + WS_DECAY) + (size_t)bh * 64 * 128 + k0;
    float S0 = 0.f, S1 = 0.f, S2 = 0.f, S3 = 0.f;
    for (int c0 = 0; c0 < 64; c0 += 8) {
        v2u d[8]; f32x4 dc[8];
#pragma unroll
        for (int j = 0; j < 8; ++j) { d[j] = *(const v2u*)(img + ((size_t)(c0 + j) << 15)); dc[j] = *(const f32x4*)(dec + (c0 + j) * 128); }
#pragma unroll
        for (int j = 0; j < 8; ++j) {
            *(v2u*)(img + ((size_t)(c0 + j) << 15)) = (v2u){cvtpk(S0, S1), cvtpk(S2, S3)};
            S0 = dc[j][0] * S0 + __uint_as_float(d[j].x << 16); S1 = dc[j][1] * S1 + __uint_as_float(d[j].x & 0xffff0000u);
            S2 = dc[j][2] * S2 + __uint_as_float(d[j].y << 16); S3 = dc[j][3] * S3 + __uint_as_float(d[j].y & 0xffff0000u);
        }
    }
}
__device__ __forceinline__ void group_barrier(unsigned* w, unsigned target) {
    asm volatile("s_waitcnt vmcnt(0)" ::: "memory");
    __syncthreads();
    if (tid_x() == 0) {
        __builtin_amdgcn_fence(__ATOMIC_RELEASE, "agent");
        asm volatile("s_waitcnt vmcnt(0)" ::: "memory");
        __hip_atomic_fetch_add(w, 1u, __ATOMIC_RELAXED, __HIP_MEMORY_SCOPE_AGENT);
        unsigned sp = 0;
        while (__hip_atomic_load(w, __ATOMIC_RELAXED, __HIP_MEMORY_SCOPE_AGENT) < target) { __builtin_amdgcn_s_sleep(2); if (++sp > (1u << 22)) break; }
        __builtin_amdgcn_fence(__ATOMIC_ACQUIRE, "agent");
        asm volatile("s_waitcnt vmcnt(0)" ::: "memory");
    }
    __syncthreads();
}

__device__ __forceinline__ void b3_group(int bh, int s8, unsigned char* ws, LAS unsigned char* lds, const float* gain) {
    constexpr int B_HQ = 0, B_HF = 16384, B_QD = 32768, B_HI = 49152, B_ST = 81920, B_O = 0;
    int tid = tid_x(); asm volatile("" : "+v"(tid));
    const int lane = tid & 63, wid = __builtin_amdgcn_readfirstlane(tid >> 6), r32 = lane & 31, hh = lane >> 5;
    const int k2 = lane;
    const float lb0 = ((const float*)(ws + WS_SMALL))[128 * (bh & 3) + 2 * k2], lb1 = ((const float*)(ws + WS_SMALL))[128 * (bh & 3) + 2 * k2 + 1];
    LAS float* ps = (LAS float*)(lds + L_PS);
    const unsigned krb = 2048u * ((unsigned)r32 >> 3) + 64u * ((unsigned)r32 & 7u), krs = ((unsigned)r32 >> 2) & 3u;
    const unsigned kr0 = krb + 16u * (hh ^ krs), kr1 = krb + 16u * ((2u + hh) ^ krs);
    const unsigned tq = ((unsigned)lane & 15u) >> 2, tp = (unsigned)lane & 3u, tblk = ((unsigned)lane >> 4) & 1u;
    const unsigned tvb = 2048u * hh + 64u * tq + 8u * (tp & 1u), tvx = (2u * tblk + (tp >> 1)) ^ (2u * hh);
    const unsigned tv0 = tvb + 16u * tvx, tv1 = tvb + 256u + 16u * (tvx ^ 1u);
    const int tb = wid >> 2, vb = wid & 3;
    const int erow = tid >> 3, seg = tid & 7;
    const f32x4 n0 = ((const f32x4*)(gain + 16 * seg))[0], n1 = ((const f32x4*)(gain + 16 * seg))[1], n2 = ((const f32x4*)(gain + 16 * seg))[2], n3 = ((const f32x4*)(gain + 16 * seg))[3];
    { const int item = bh * 64 + s8;
      dma16k(ws + WS_HI + ((size_t)item << 14), lds + B_HI, wid, lane);
      dma16k(ws + WS_DST + ((size_t)item << 15), lds + B_ST, wid, lane); dma16k(ws + WS_DST + ((size_t)item << 15) + 16384, lds + B_ST + 16384, wid, lane); }
    for (int j = 0; j < 8; ++j) {
        const int item = bh * 64 + s8 + 8 * j, bb = j & 1;
        dma16k(ws + WS_HQ + ((size_t)item << 14), lds + B_HQ, wid, lane);
        dma16k(ws + WS_HF + ((size_t)item << 14), lds + B_HF, wid, lane);
        if (j + 1 < 8) { const int nb = bb ^ 1;
            dma16k(ws + WS_HI + ((size_t)(item + 8) << 14), lds + B_HI + nb * 16384, wid, lane);
            dma16k(ws + WS_DST + ((size_t)(item + 8) << 15), lds + B_ST + nb * 32768, wid, lane); dma16k(ws + WS_DST + ((size_t)(item + 8) << 15) + 16384, lds + B_ST + nb * 32768 + 16384, wid, lane); }
        const unsigned char* hogp = ws + WS_HOG + ((size_t)item << 14);
        const v4u g0 = *(const v4u*)(hogp + off_a((unsigned)erow, 2u * seg)), g1 = *(const v4u*)(hogp + off_a((unsigned)erow, 2u * seg + 1u));
        if (j + 1 < 8) asm volatile("s_waitcnt vmcnt(8)\n\ts_barrier" ::: "memory"); else asm volatile("s_waitcnt vmcnt(2)\n\ts_barrier" ::: "memory");
        {
            float f0[8], f1[8], c0[8], c1[8]; float r0 = 0.f, r1 = 0.f;
#pragma unroll
            for (int i = 0; i < 8; ++i) { const unsigned w = *(const LAS unsigned*)(lds + B_HF + img_off_a(8 * wid + i, 2 * k2));
                const float h0 = __uint_as_float(w << 16), h1 = __uint_as_float(w & 0xffff0000u);
                f0[i] = lb0 + (1.0f - lb0) * rcpf_(1.0f + __expf(-h0)); f1[i] = lb1 + (1.0f - lb1) * rcpf_(1.0f + __expf(-h1));
                r0 += __logf(f0[i]); r1 += __logf(f1[i]); c0[i] = r0; c1[i] = r1; }
            *(LAS f32x2*)(ps + wid * 128 + 2 * k2) = (f32x2){r0, r1};
            asm volatile("s_waitcnt lgkmcnt(0)\n\ts_barrier" ::: "memory");
            float base0 = 0.f, base1 = 0.f, ref0 = 0.f, ref1 = 0.f;
#pragma unroll
            for (int w = 0; w < 7; ++w) { const f32x2 p = *(const LAS f32x2*)(ps + w * 128 + 2 * k2); if (w < wid) { base0 += p[0]; base1 += p[1]; } if (w < 4) { ref0 += p[0]; ref1 += p[1]; } }
#pragma unroll
            for (int i = 0; i < 8; ++i) { const unsigned row = 8u * wid + i; const float b0 = base0 + c0[i], b1 = base1 + c1[i];
                const unsigned qw = *(const LAS unsigned*)(lds + B_HQ + img_off_a(row, 2 * k2));
                const float q0 = __uint_as_float(qw << 16), q1 = __uint_as_float(qw & 0xffff0000u);
                *(LAS unsigned*)(lds + B_HQ + img_off_a(row, 2 * k2)) = cvtpk(q0 * __expf(b0 - ref0), q1 * __expf(b1 - ref1));
                *(LAS unsigned*)(lds + B_QD + img_off_a(row, 2 * k2)) = cvtpk(q0 * __expf(b0), q1 * __expf(b1));
                *(LAS unsigned*)(lds + B_HF + img_off_a(kappa(row), 2 * k2)) = cvtpk((1.0f - f0[i]) * __expf(ref0 - b0), (1.0f - f1[i]) * __expf(ref1 - b1)); }
        }
        asm volatile("s_waitcnt lgkmcnt(0)\n\ts_barrier" ::: "memory");
        f32x16 o;
#pragma unroll
        for (int r = 0; r < 16; ++r) o[r] = 0.f;
        const int tcol = 32 * tb + r32;
        const unsigned bI = (unsigned)(uintptr_t)(lds + B_HI + bb * 16384);
        {
            f32x16 p;
#pragma unroll
            for (int r = 0; r < 16; ++r) p[r] = 0.f;
#pragma unroll
            for (int sI = 0; sI < 8; ++sI) p = HG_MFMA(rowfrag(lds + B_HF, kr0, kr1, 0, sI), rowfrag(lds + B_HQ, kr0, kr1, tb, sI), p);
#pragma unroll
            for (int r = 0; r < 16; ++r) { const int srel = (r & 7) + 8 * hh + 16 * (r >> 3); if (srel > tcol) p[r] = 0.f; }
            bf16x8 v0, v1; tr2_asm(v0, v1, bI + tv0 + 512 * vb, bI + tv1 + 512 * vb, bI + tv0 + 4096 + 512 * vb, bI + tv1 + 4096 + 512 * vb);
            o = HG_MFMA(pack_lo(p), v0, o); o = HG_MFMA(pack_hi(p), v1, o);
        }
        if (tb == 1) {
            f32x16 p;
#pragma unroll
            for (int r = 0; r < 16; ++r) p[r] = 0.f;
#pragma unroll
            for (int sI = 0; sI < 8; ++sI) p = HG_MFMA(rowfrag(lds + B_HF, kr0, kr1, 1, sI), rowfrag(lds + B_HQ, kr0, kr1, 1, sI), p);
#pragma unroll
            for (int r = 0; r < 16; ++r) { const int srel = 32 + (r & 7) + 8 * hh + 16 * (r >> 3); if (srel > tcol) p[r] = 0.f; }
            bf16x8 v0, v1; tr2_asm(v0, v1, bI + tv0 + 8192 + 512 * vb, bI + tv1 + 8192 + 512 * vb, bI + tv0 + 12288 + 512 * vb, bI + tv1 + 12288 + 512 * vb);
            o = HG_MFMA(pack_lo(p), v0, o); o = HG_MFMA(pack_hi(p), v1, o);
        }
#pragma unroll
        for (int sI = 0; sI < 8; ++sI) o = HG_MFMA(rowfrag(lds + B_QD, kr0, kr1, tb, sI), rowfrag(lds + B_ST + bb * 32768, kr0, kr1, vb, sI), o);
        asm volatile("s_waitcnt lgkmcnt(0)\n\ts_barrier" ::: "memory");
        LAS float* O = (LAS float*)(lds + B_O);
#pragma unroll
        for (int r = 0; r < 16; ++r) O[(32 * tb + (r & 3) + 8 * (r >> 2) + 4 * hh) * 128 + 32 * vb + r32] = o[r];
        asm volatile("s_waitcnt lgkmcnt(0)\n\ts_barrier" ::: "memory");
        {
            const LAS f32x4* op = (const LAS f32x4*)(O + erow * 128 + 16 * seg);
            f32x4 v0 = op[0], v1 = op[1], v2 = op[2], v3 = op[3];
            float sq = 0.f;
#pragma unroll
            for (int e = 0; e < 4; ++e) sq += v0[e] * v0[e] + v1[e] * v1[e] + v2[e] * v2[e] + v3[e] * v3[e];
            sq += swz_xor<1>(sq); sq += swz_xor<2>(sq); sq += swz_xor<4>(sq);
            const float rstd = __builtin_amdgcn_rsqf(sq * (1.0f / 128.0f) + EPS);
            float y[16];
#pragma unroll
            for (int e = 0; e < 4; ++e) { y[e] = v0[e] * n0[e]; y[4 + e] = v1[e] * n1[e]; y[8 + e] = v2[e] * n2[e]; y[12 + e] = v3[e] * n3[e]; }
#pragma unroll
            for (int e = 0; e < 4; ++e) { const float a = __uint_as_float(g0[e] << 16), b = __uint_as_float(g0[e] & 0xffff0000u), c = __uint_as_float(g1[e] << 16), d = __uint_as_float(g1[e] & 0xffff0000u);
                y[2 * e] *= rstd * a * rcpf_(1.0f + __expf(-a)); y[2 * e + 1] *= rstd * b * rcpf_(1.0f + __expf(-b)); y[8 + 2 * e] *= rstd * c * rcpf_(1.0f + __expf(-c)); y[9 + 2 * e] *= rstd * d * rcpf_(1.0f + __expf(-d)); }
            const int c = item & 63;
            bf16* dst = (bf16*)(ws + WS_OHG) + ((size_t)(bh >> 2) * 4096 + 64 * c + erow) * 512 + 128 * (bh & 3) + 16 * seg;
            v4u w0, w1;
            w0.x = cvtpk(y[0], y[1]); w0.y = cvtpk(y[2], y[3]); w0.z = cvtpk(y[4], y[5]); w0.w = cvtpk(y[6], y[7]);
            w1.x = cvtpk(y[8], y[9]); w1.y = cvtpk(y[10], y[11]); w1.z = cvtpk(y[12], y[13]); w1.w = cvtpk(y[14], y[15]);
            *(v4u*)dst = w0; *(v4u*)(dst + 8) = w1;
        }
        asm volatile("s_waitcnt lgkmcnt(0)\n\ts_barrier" ::: "memory");
    }
}
}

__global__ void __launch_bounds__(NWAVES * 64, 2) mega(Args args) {
    LAS unsigned char* lds = (LAS unsigned char*)lds_raw;
    volatile LAS unsigned* MISC = (volatile LAS unsigned*)(lds + MISC_OFF);
    { const int t0_ = threadIdx.x; if ((t0_ & 63) == 0) *(volatile LAS int*)(lds + MISC_OFF + 256 + 4 * ((unsigned)__builtin_amdgcn_s_getreg((5 << 11) | 4) & 63u)) = t0_ >> 6; if (t0_ < 64) MISC[t0_] = 0u; }
    __syncthreads();
    const int wave = wave_idx();
    const int G = gridDim.x; const int bx = blockIdx.x; const int vcu = (G % 8 == 0) ? (bx % 8) * (G / 8) + bx / 8 : bx;
    unsigned char* ws = args.ws;
    const int lo = args.ph_lo, hi = args.ph_hi;
    XcdBarrier bar; bar.bar = (unsigned*)(ws + WS_CTL) + CW_BAR + args.li * XCD_BAR_WORDS; bar.x = 0; bar.st = nullptr;
    if (hi - lo > 1) bar = xcd_barrier_post((unsigned*)(ws + WS_CTL) + CW_BAR + args.li * XCD_BAR_WORDS, MISC + 8);
#define IN(k) (lo <= (k) && (k) < hi)
#define BOTH(k) (IN(k) && IN((k) + 1))
    if (IN(0)) { p0_prologue(args, lds, vcu, G, wave, (int)lane_id()); if (BOTH(0)) xcd_barrier(bar); }
    if (IN(1)) {
        pg8::DenseOrder S; S.init(ws + WS_H, ws + WS_WIN, NT, NCOLS, DM, G, bx);
        EpiProj E{ws, (bf16*)args.out, args.in[5], args.in[6]};
        pg8::gemm_phase<EpiProj, pg8::DenseOrder, true>(lds + RING_OFF, DM, S, E);
        if (BOTH(1)) xcd_barrier(bar);
    }
    if (IN(2)) {
        const int bh = vcu >> 3, s8 = vcu & 7; unsigned* gw = (unsigned*)(ws + WS_CTL) + CW_GRP + bh * 64;
        if (G != 256) { if (tid_x() == 0) __hip_atomic_store((unsigned*)(ws + WS_CTL) + CW_BAR + XB_TMO, 0x7f0u, __ATOMIC_RELAXED, __HIP_MEMORY_SCOPE_AGENT); }
        if (bh & 1) att::attn_phase(ws, lds, vcu, G, args.in[8]);
        w13_convert(args, lds, vcu, G, wave, (int)lane_id()); __syncthreads();
        hg::b1_group(bh, s8, ws, lds);
        hg::group_barrier(gw, 8u);
        hg::scan_slice(ws, bh, s8 * 512 + tid_x());
        hg::group_barrier(gw, 16u);
        hg::b3_group(bh, s8, ws, lds, args.in[4]);
        if (!(bh & 1)) att::attn_phase(ws, lds, vcu, G, args.in[8]);
        if (BOTH(2)) xcd_barrier(bar);
    }
    if (IN(5)) {
        BranchOrder S; S.d.init(ws + WS_OHG, ws + WS_WHG, NT, DM, 512, G, bx); S.A2 = (const char*)(ws + WS_ODA); S.B2 = (const char*)(ws + WS_WDA);
        EpiBranch E{(const bf16*)args.out, (bf16*)(ws + WS_MIXED)};
        pg8::gemm_phase<EpiBranch, BranchOrder, true>(lds + RING_OFF, 512, S, E);
        if (BOTH(5)) xcd_barrier(bar);
    }
    if (IN(6)) {
        pg8::DenseOrder S; S.init(ws + WS_MIXED, ws + WS_WOUT, NT, DM, DM, G, bx);
        EpiOut E{args.in[0], (bf16*)(ws + WS_X1B)};
        pg8::gemm_phase<EpiOut, pg8::DenseOrder, true>(lds + RING_OFF, DM, S, E);
        if (BOTH(6)) xcd_barrier(bar);
    }
    if (IN(7)) { router_phase(args, lds, G, wave, (int)lane_id()); if (BOTH(7)) xcd_barrier(bar); }
    if (IN(8)) {
        moe_sched_setup(args, lds);
        const LAS int* pref = (const LAS int*)(lds + SCHED_OFF); const LAS int* cnt = pref + 80;
        MoeOrderT<1> S{pref, cnt, (const v2u*)(ws + WS_ROWTOK), (const char*)(ws + WS_XN), (const char*)(ws + WS_W13T), DM / 2, (size_t)DM * DM, 1, 0, 64, 4, G, bx};
        EpiUp E{pref, cnt, ws + WS_HID};
        pg8::gemm_phase<EpiUp, MoeOrderT<1>, true, true, 122>(lds + RING_OFF, DM / 2, S, E);
        if (BOTH(8)) xcd_barrier(bar);
    }
    if (IN(9)) {
        moe_sched_setup(args, lds);
        const LAS int* pref = (const LAS int*)(lds + SCHED_OFF); const LAS int* cnt = pref + 80;
        MoeOrderT<0> S{pref, cnt, (const v2u*)(ws + WS_ROWTOK), (const char*)(ws + WS_HID), (const char*)(ws + WS_W2T), DFF / 2, (size_t)DM * DFF, 0, 0, 64, 4, G, bx};
        EpiDown E{pref, cnt, (bf16*)(ws + WS_YS)};
        pg8::gemm_phase<EpiDown, MoeOrderT<0>, true, true, 123>(lds + RING_OFF, DFF / 2, S, E);
        if (BOTH(9)) xcd_barrier(bar);
    }
    if (IN(10)) {
        moe_sched_setup(args, lds);
        const LAS int* pref = (const LAS int*)(lds + SCHED_OFF);
        float* out = args.out; const bf16* y = (const bf16*)(ws + WS_YS); const v2u* tp = (const v2u*)(ws + WS_TOKPOS); const bf16* x1b = (const bf16*)(ws + WS_X1B);
        for (int i = bx * 512 + tid_x(); i < NT * (DM / 8); i += G * 512) {
            const int t = i >> 7, c = (i & 127) * 8;
            const v2u p0 = tp[2 * (size_t)t], p1 = tp[2 * (size_t)t + 1];
            const size_t r0 = (size_t)(pref[p0.x >> 16] * 256 + (int)(p0.x & 0xffffu)), r1 = (size_t)(pref[p1.x >> 16] * 256 + (int)(p1.x & 0xffffu));
            const float w0 = __uint_as_float(p0.y), w1 = __uint_as_float(p1.y);
            f32x4* op = (f32x4*)(out + (size_t)t * DM + c);
            const v4u y0 = *(const v4u*)(y + r0 * DM + c), y1 = *(const v4u*)(y + r1 * DM + c), xb = *(const v4u*)(x1b + (size_t)t * DM + c);
            f32x4 a0, a1;
            a0[0] = __uint_as_float(xb.x << 16) + w0 * __uint_as_float(y0.x << 16) + w1 * __uint_as_float(y1.x << 16); a0[1] = __uint_as_float(xb.x & 0xffff0000u) + w0 * __uint_as_float(y0.x & 0xffff0000u) + w1 * __uint_as_float(y1.x & 0xffff0000u);
            a0[2] = __uint_as_float(xb.y << 16) + w0 * __uint_as_float(y0.y << 16) + w1 * __uint_as_float(y1.y << 16); a0[3] = __uint_as_float(xb.y & 0xffff0000u) + w0 * __uint_as_float(y0.y & 0xffff0000u) + w1 * __uint_as_float(y1.y & 0xffff0000u);
            a1[0] = __uint_as_float(xb.z << 16) + w0 * __uint_as_float(y0.z << 16) + w1 * __uint_as_float(y1.z << 16); a1[1] = __uint_as_float(xb.z & 0xffff0000u) + w0 * __uint_as_float(y0.z & 0xffff0000u) + w1 * __uint_as_float(y1.z & 0xffff0000u);
            a1[2] = __uint_as_float(xb.w << 16) + w0 * __uint_as_float(y0.w << 16) + w1 * __uint_as_float(y1.w << 16); a1[3] = __uint_as_float(xb.w & 0xffff0000u) + w0 * __uint_as_float(y0.w & 0xffff0000u) + w1 * __uint_as_float(y1.w & 0xffff0000u);
            op[0] = a0; op[1] = a1;
        }
    }
#undef IN
#undef BOTH
}

extern "C" void kernel_launch(void* const* d_in, const int* in_sizes, int n_in, void* d_out, int out_size, void* d_ws, size_t ws_size, hipStream_t stream) {
    static int grid = 0;
    if (grid == 0) {
        if (n_in != 20 || out_size != NT * DM || ws_size < WS_END) { fprintf(stderr, "kernel_launch: unexpected shapes (n_in %d out %d ws %zu)\n", n_in, out_size, ws_size); grid = -1; return; }
        int dev = 0, cus = 0, per_cu = 0;
        if (hipGetDevice(&dev) != hipSuccess || hipDeviceGetAttribute(&cus, hipDeviceAttributeMultiprocessorCount, dev) != hipSuccess) { grid = -1; return; }
        if (hipFuncSetAttribute((const void*)mega, hipFuncAttributeMaxDynamicSharedMemorySize, LDS_BYTES) != hipSuccess) { fprintf(stderr, "kernel_launch: hipFuncSetAttribute failed\n"); grid = -1; return; }
        if (hipOccupancyMaxActiveBlocksPerMultiprocessor(&per_cu, (const void*)mega, NWAVES * 64, LDS_BYTES) != hipSuccess || per_cu < 1) fprintf(stderr, "kernel_launch: occupancy query says %d\n", per_cu);
        (void)hipGetLastError();
        grid = cus;
    }
    if (grid < 0) return;
    (void)hipMemsetAsync((char*)d_ws + WS_CTL, 0, CTL_ZERO_BYTES, stream);
    Args a{};
    for (int i = 0; i < 20; ++i) a.in[i] = (const float*)d_in[i];
    a.out = (float*)d_out; a.ws = (unsigned char*)d_ws;
    unsigned char* ws = (unsigned char*)d_ws;
    a.ph_lo = 0; a.ph_hi = 11; a.li = 0; hipLaunchKernelGGL(mega, dim3(grid), dim3(NWAVES * 64), LDS_BYTES, stream, a);
}
```

```cpp
#include <hip/hip_runtime.h>
#include <cstdio>
#include <cstdint>

#define GAS __attribute__((address_space(1)))
#define LAS __attribute__((address_space(3)))
typedef unsigned short bf16;
typedef unsigned v4u __attribute__((ext_vector_type(4)));
typedef unsigned v2u __attribute__((ext_vector_type(2)));
typedef float f32x4 __attribute__((ext_vector_type(4)));
typedef float f32x2 __attribute__((ext_vector_type(2)));
typedef float f32x16 __attribute__((ext_vector_type(16)));
typedef short bf16x8 __attribute__((ext_vector_type(8)));
typedef short s16x4 __attribute__((ext_vector_type(4)));
typedef __bf16 bf16x2_t __attribute__((ext_vector_type(2)));

constexpr int NB = 8, SEQ = 4096, DM = 1024, NT = NB * SEQ;
constexpr int NCOLS = 5632;
constexpr int NEXP = 32, DFF = 512;
constexpr float EPS = 1e-6f;
constexpr float LOG2E = 1.4426950408889634f;
constexpr int RCAP = NT;

constexpr size_t MiB = 1u << 20;
constexpr size_t WS_CTL = 0, CTL_ZERO_BYTES = 1 * MiB;
constexpr size_t WS_SMALL = 1 * MiB;
constexpr size_t WS_ROPE = 2 * MiB;
constexpr size_t WS_WHG = 3 * MiB, WS_WDA = 4 * MiB, WS_WOUT = 5 * MiB;
constexpr size_t WS_WIN = 7 * MiB;
constexpr size_t WS_W2T = 18 * MiB;
constexpr size_t WS_H = 50 * MiB;
constexpr size_t WS_W13T = WS_H;
constexpr size_t WS_HQ = 114 * MiB, WS_HF = 146 * MiB, WS_HI = 178 * MiB, WS_HOG = 210 * MiB;
constexpr size_t WS_MIXED = 114 * MiB;
constexpr size_t WS_XN = 178 * MiB;
constexpr size_t WS_Y = 114 * MiB;
constexpr size_t WS_YS = 50 * MiB;
constexpr size_t WS_TOKPOS = 322 * MiB;
constexpr size_t WS_QT = 242 * MiB, WS_KIMG = 274 * MiB, WS_VIMG = 306 * MiB;
constexpr size_t WS_HID = 242 * MiB;
constexpr size_t WS_ROWTOK = 306 * MiB;
constexpr size_t WS_WT = 314 * MiB;
constexpr size_t WS_DST = 338 * MiB;
constexpr size_t WS_X1B = 338 * MiB;
constexpr size_t WS_DECAY = 402 * MiB;
constexpr size_t WS_OHG = 403 * MiB, WS_ODA = 435 * MiB;
constexpr size_t WS_END = 467 * MiB;
constexpr int CW_BAR = 4096;
constexpr int CW_GCNT = 16384;
constexpr int CW_GRP = 20480;

__device__ __forceinline__ unsigned f2bf(float f) { unsigned u = __float_as_uint(f); return (u + 0x7fffu + ((u >> 16) & 1u)) >> 16; }
__device__ __forceinline__ float bf2f(unsigned short b) { return __uint_as_float((unsigned)b << 16); }
__device__ __forceinline__ unsigned cvtpk(float lo, float hi) { f32x2 v = {lo, hi}; bf16x2_t b = __builtin_convertvector(v, bf16x2_t); return __builtin_bit_cast(unsigned, b); }
__device__ __forceinline__ v4u pack8(const f32x4 a, const f32x4 b) { v4u w; w.x = cvtpk(a[0], a[1]); w.y = cvtpk(a[2], a[3]); w.z = cvtpk(b[0], b[1]); w.w = cvtpk(b[2], b[3]); return w; }
__host__ __device__ __forceinline__ unsigned off_b(unsigned row, unsigned ch) { return 256u * row + 16u * (ch ^ (((row & 3u) << 2) | ((row >> 2) & 3u))); }
__host__ __device__ __forceinline__ unsigned img_off(unsigned row, unsigned col) { return off_b(row, col >> 3) + (col & 7u) * 2u; }
__host__ __device__ __forceinline__ unsigned off_a(unsigned row, unsigned ch) { return 2048u * (row >> 3) + 512u * (ch >> 2) + 64u * (row & 7u) + 16u * ((ch & 3u) ^ ((row >> 2) & 3u)); }
__host__ __device__ __forceinline__ unsigned img_off_a(unsigned row, unsigned col) { return off_a(row, col >> 3) + (col & 7u) * 2u; }
__host__ __device__ __forceinline__ unsigned kappa(unsigned r) { return (r & ~12u) | ((r & 4u) << 1) | ((r & 8u) >> 1); }
template <int M> __device__ __forceinline__ float swz_xor(float v) { return __int_as_float(__builtin_amdgcn_ds_swizzle(__float_as_int(v), (M << 10) | 0x1f)); }
__device__ __forceinline__ float wave_sum(float v) {
    v += swz_xor<1>(v); v += swz_xor<2>(v); v += swz_xor<4>(v); v += swz_xor<8>(v); v += swz_xor<16>(v);
    { auto rr = __builtin_amdgcn_permlane32_swap(__float_as_uint(v), __float_as_uint(v), false, false); v = __uint_as_float(rr[0]) + __uint_as_float(rr[1]); }
    return v;
}
__device__ __forceinline__ float wave_max(float v) {
    v = fmaxf(v, swz_xor<1>(v)); v = fmaxf(v, swz_xor<2>(v)); v = fmaxf(v, swz_xor<4>(v)); v = fmaxf(v, swz_xor<8>(v)); v = fmaxf(v, swz_xor<16>(v));
    { auto rr = __builtin_amdgcn_permlane32_swap(__float_as_uint(v), __float_as_uint(v), false, false); v = fmaxf(__uint_as_float(rr[0]), __uint_as_float(rr[1])); }
    return v;
}
extern __shared__ __attribute__((aligned(16))) unsigned char lds_raw[];
constexpr int LDS_BYTES = 159744;
constexpr int MISC_OFF = LDS_BYTES - 512;
__device__ __forceinline__ int wave_idx() { const unsigned k = (unsigned)__builtin_amdgcn_s_getreg((5 << 11) | 4) & 63u;
    return __builtin_amdgcn_readfirstlane(*(volatile LAS int*)((LAS unsigned char*)lds_raw + MISC_OFF + 256 + 4 * k)); }
__device__ __forceinline__ unsigned lane_id() { unsigned l; asm volatile("v_mbcnt_lo_u32_b32 %0, -1, 0\n\tv_mbcnt_hi_u32_b32 %0, -1, %0" : "=v"(l)); return l; }
__device__ __forceinline__ int tid_x() { return wave_idx() * 64 + (int)lane_id(); }
typedef int v8i __attribute__((ext_vector_type(8)));
typedef int v4i __attribute__((ext_vector_type(4)));
__device__ __forceinline__ unsigned pk4_fp8(float a, float b, float c, float d) { int p = __builtin_amdgcn_cvt_pk_fp8_f32(a, b, 0, false); p = __builtin_amdgcn_cvt_pk_fp8_f32(c, d, p, true); return (unsigned)p; }
__device__ __forceinline__ float rcpf_(float x) { return __builtin_amdgcn_rcpf(x); }
__device__ __forceinline__ float sigmoidf_(float x) { return rcpf_(1.0f + __expf(-x)); }

#define XB_TMO      128
#define XB_XCNT(j)  (256  + 64 * (j))
#define XB_XSUB(j)  (1280 + 64 * (j))
#define XB_XGEN(j)  (2304 + 64 * (j))
#define XB_TOP      3328
#define XB_TOPGEN   3392
#define XCD_BAR_WORDS 3456
#define XB_SPIN_CAP (1u << 18)
__device__ __forceinline__ unsigned xb_ld(unsigned* p)              { return __hip_atomic_load(p, __ATOMIC_RELAXED, __HIP_MEMORY_SCOPE_AGENT); }
__device__ __forceinline__ unsigned xb_add(unsigned* p, unsigned v) { return __hip_atomic_fetch_add(p, v, __ATOMIC_RELAXED, __HIP_MEMORY_SCOPE_AGENT); }
__device__ __forceinline__ unsigned xb_xcc_id() { return (unsigned)__builtin_amdgcn_s_getreg((3 << 11) | 20) & 0xFu; }
#define XB_SPIN(cond, bar) do { unsigned _sp = 0; while (cond) { __builtin_amdgcn_s_sleep(1); \
    if ((++_sp & 255u) == 0u) { if (xb_ld(&(bar)[XB_TMO])) break; if (_sp > XB_SPIN_CAP) { atomicAdd(&(bar)[XB_TMO], 1u); break; } } } } while (0)
struct XcdBarrier { unsigned* bar; unsigned x; volatile LAS unsigned* st; };
__device__ __forceinline__ XcdBarrier xcd_barrier_post(unsigned* bar, volatile LAS unsigned* st) {
    XcdBarrier b; b.bar = bar; b.x = xb_xcc_id(); b.st = st;
    if (tid_x() == 0) (void)xb_add(&bar[XB_XCNT(b.x)], 1u);
    return b;
}
__device__ __forceinline__ void xcd_barrier_complete(unsigned* bar, unsigned x, unsigned& nloc, unsigned& nx) {
    const unsigned G = gridDim.x * gridDim.y * gridDim.z;
    unsigned sum, cnt, mine, sp = 0u;
    for (;;) {
        sum = 0u; cnt = 0u; mine = 0u;
#pragma unroll
        for (unsigned j = 0; j < 16; ++j) { const unsigned c = xb_ld(&bar[XB_XCNT(j)]); sum += c; cnt += (c > 0u) ? 1u : 0u; mine = (j == x) ? c : mine; }
        if (sum == G) break;
        __builtin_amdgcn_s_sleep(1);
        if ((++sp & 255u) == 0u) { if (xb_ld(&bar[XB_TMO])) break; if (sp > XB_SPIN_CAP) { atomicAdd(&bar[XB_TMO], 1u); break; } }
    }
    nloc = mine > 0u ? mine : 1u; nx = cnt > 0u ? cnt : 1u;
}
__device__ __forceinline__ void xcd_barrier(const XcdBarrier& b) {
    asm volatile("s_waitcnt vmcnt(0)" ::: "memory");
    __syncthreads();
    if (tid_x() == 0) {
        unsigned* bar = b.bar;
        __builtin_amdgcn_s_waitcnt(0);
        unsigned nloc = b.st[0], nx = b.st[1];
        if (nloc == 0u) { xcd_barrier_complete(bar, b.x, nloc, nx); b.st[0] = nloc; b.st[1] = nx; }
        const unsigned old = xb_add(&bar[XB_XSUB(b.x)], 1u);
        const unsigned gen = old / nloc;
        if (old + 1u == (gen + 1u) * nloc) {
            __builtin_amdgcn_fence(__ATOMIC_RELEASE, "agent");
            asm volatile("s_waitcnt vmcnt(0)" ::: "memory");
            const unsigned og = xb_add(&bar[XB_TOP], 1u);
            const unsigned tg = og / nx;
            if (og + 1u == (tg + 1u) * nx) xb_add(&bar[XB_TOPGEN], 1u);
            else XB_SPIN(xb_ld(&bar[XB_TOPGEN]) == tg, bar);
            __builtin_amdgcn_fence(__ATOMIC_ACQUIRE, "agent");
            xb_add(&bar[XB_XGEN(b.x)], 1u);
            asm volatile("s_waitcnt vmcnt(0)" ::: "memory");
        } else {
            XB_SPIN(xb_ld(&bar[XB_XGEN(b.x)]) == gen, bar);
            __builtin_amdgcn_fence(__ATOMIC_ACQUIRE, "agent");
            asm volatile("s_waitcnt vmcnt(0)" ::: "memory");
        }
    }
    __syncthreads();
}

namespace pg8 {
constexpr int BM = 256, BK = 64, HALF = 128, HTB = HALF * BK * 2, STAGE_BYTES = 8 * HTB, NXCD = 8, WGM = 8;
__host__ __device__ __forceinline__ int lds_byte(int r, int c) { const int st = (r >> 4) * 2 + (c >> 5), rr = r & 15, cc = c & 31, ob = rr * 64 + cc * 2; return st * 1024 + (ob ^ (((ob >> 9) & 1) << 5)); }
__host__ __device__ __forceinline__ void stage_rc(int b, int& R, int& C) { const int st = b / 1024, sb = b % 1024, swz = sb ^ (((sb >> 9) & 1) << 5); R = (st >> 1) * 16 + swz / 64; C = (st & 1) * 32 + (swz % 64) / 2; }
__host__ __device__ __forceinline__ int perm32(int rho) { const int n = rho >> 4, i = rho & 15; return 8 * (i >> 2) + 4 * n + (i & 3); }
struct Unit { int pm, pn, aux; };

template <class Epi, class Sched, bool ALIGN_EPI, bool F8 = false, int WSC = 127>
__device__ __forceinline__ void gemm_phase(LAS unsigned char* lds, const int K, const Sched& S, const Epi& E) {
    const int tid = tid_x(), wid = __builtin_amdgcn_readfirstlane(tid >> 6), lane = tid & 63, wr = wid >> 2, wc = wid & 3, fr = lane & 15, fq = lane >> 4;
    const int nt = K / BK;
    int Rr[2], Cc[2]; unsigned voffB[2];
#pragma unroll
    for (int i = 0; i < 2; ++i) { int R, C; stage_rc(tid * 16 + i * 8192, R, C); Rr[i] = R; Cc[i] = C; const int Rb = Epi::PERM ? ((R & ~31) + perm32(R & 31)) : R; voffB[i] = (unsigned)(Rb * K + C) * 2u; }
    const size_t kstep = (size_t)(BK * 2);
    const size_t hstep = (size_t)HALF * K * 2;
    const unsigned ldsw = (unsigned)wid * 1024u;
    const int aoff = lds_byte(wr * 64 + fr, fq * 8), boff = lds_byte(wc * 32 + fr, fq * 8);
#define PG8_SA(b, h) (((b) * 2 + (h)) * HTB)
#define PG8_SB(b, h) ((4 + (b) * 2 + (h)) * HTB)
#define PG8_STAGE(bufoff, gbase, voff) do { _Pragma("unroll") for (int _i = 0; _i < 2; ++_i) \
        __builtin_amdgcn_global_load_lds((const unsigned*)((const char*)(gbase) + (voff)[_i]), (LAS unsigned*)(lds + (bufoff) + ldsw + _i * 8192), 16, 0, 0); } while (0)
#define PG8_LD8(off_) __builtin_shufflevector(*(const LAS v4i*)(lds + (off_)), *(const LAS v4i*)(lds + (off_) + 1024), 0, 1, 2, 3, 4, 5, 6, 7)
#define PG8_LDA(dst, b, h) do { if constexpr (F8) { _Pragma("unroll") for (int m = 0; m < 4; ++m) dst##8[m] = PG8_LD8(PG8_SA(b, h) + aoff + m * 2048); } \
        else { _Pragma("unroll") for (int m = 0; m < 4; ++m) _Pragma("unroll") for (int k = 0; k < 2; ++k) dst[m][k] = *(const LAS bf16x8*)(lds + PG8_SA(b, h) + aoff + m * 2048 + k * 1024); } } while (0)
#define PG8_LDB(dst, b, h) do { if constexpr (F8) { _Pragma("unroll") for (int n = 0; n < 2; ++n) dst##8[n] = PG8_LD8(PG8_SB(b, h) + boff + n * 2048); } \
        else { _Pragma("unroll") for (int n = 0; n < 2; ++n) _Pragma("unroll") for (int k = 0; k < 2; ++k) dst[n][k] = *(const LAS bf16x8*)(lds + PG8_SB(b, h) + boff + n * 2048 + k * 1024); } } while (0)
#define PG8_MMA(ai, bj, At, Bt) do { __builtin_amdgcn_s_setprio(1); \
        if constexpr (F8) { _Pragma("unroll") for (int m = 0; m < 4; ++m) _Pragma("unroll") for (int n = 0; n < 2; ++n) \
            asm volatile("v_mfma_scale_f32_16x16x128_f8f6f4 %0, %1, %2, %0, %3, %4 op_sel_hi:[0,0,0]" : "+v"(acc[ai][bj][m][n]) : "v"(Bt##8[n]), "v"(At##8[m]), "v"(wsc_), "v"(asc_)); } \
        else { _Pragma("unroll") for (int m = 0; m < 4; ++m) _Pragma("unroll") for (int n = 0; n < 2; ++n) _Pragma("unroll") for (int k = 0; k < 2; ++k) \
            acc[ai][bj][m][n] = __builtin_amdgcn_mfma_f32_16x16x32_bf16(Bt[n][k], At[m][k], acc[ai][bj][m][n], 0, 0, 0); } \
        __builtin_amdgcn_s_setprio(0); } while (0)
#define PG8_WAIT_V(n) asm volatile("s_waitcnt vmcnt(" #n ")" ::: "memory")
#define PG8_WAIT_L(n) asm volatile("s_waitcnt lgkmcnt(" #n ")" ::: "memory")
#define PG8_BAR __builtin_amdgcn_s_barrier()
#define PG8_SCHED __builtin_amdgcn_sched_barrier(0)
    Unit cur, nxt; int ui = 0;
    if (!S.next(0, cur)) return;
    f32x4 acc[2][2][4][2];
#pragma unroll
    for (int a = 0; a < 2; ++a)
#pragma unroll
        for (int b = 0; b < 2; ++b)
#pragma unroll
            for (int m = 0; m < 4; ++m)
#pragma unroll
                for (int n = 0; n < 2; ++n) acc[a][b][m][n] = (f32x4){0.f, 0.f, 0.f, 0.f};
    bf16x8 At[4][2], B0[2][2], B1[2][2]; v8i At8[4], B08[2], B18[2];
    int wsc_ = WSC, asc_ = 127; asm volatile("" : "+v"(wsc_), "+v"(asc_));
    const char* cA; const char* cB; unsigned cA0[2], cA1[2];
    S.addr(cur, Rr, Cc, cA, cB, cA0, cA1);
    LAS unsigned* nslot = (LAS unsigned*)(lds + STAGE_BYTES) + tid * 4;
    PG8_STAGE(PG8_SB(0, 0), cB, voffB); PG8_STAGE(PG8_SB(0, 1), cB + hstep, voffB); PG8_STAGE(PG8_SA(0, 0), cA, cA0); PG8_STAGE(PG8_SA(0, 1), cA, cA1);
    if (wr == 1) PG8_BAR;
    PG8_WAIT_V(2); PG8_BAR;
    PG8_STAGE(PG8_SB(1, 0), cB + kstep, voffB); PG8_STAGE(PG8_SA(1, 0), cA + kstep, cA0); PG8_STAGE(PG8_SB(1, 1), cB + hstep + kstep, voffB);
    PG8_WAIT_V(6); PG8_BAR;
    for (;;) {
        const bool has_next = S.next(ui + 1, nxt);
        const char* nA = cA; const char* nB = cB;
        { unsigned nA0[2] = {cA0[0], cA0[1]}, nA1[2] = {cA1[0], cA1[1]};
          if (has_next) { int R2[2], C2[2]; const int t2 = tid_x();
#pragma unroll
              for (int i = 0; i < 2; ++i) stage_rc(t2 * 16 + i * 8192, R2[i], C2[i]);
              S.addr(nxt, R2, C2, nA, nB, nA0, nA1); }
          nslot[0] = nA0[0]; nslot[1] = nA0[1]; nslot[2] = nA1[0]; nslot[3] = nA1[1]; }
#pragma unroll 1
        for (int t = 0; t < nt; t += 2) {
            const bool last = (t == nt - 2);
            const char* a1 = cA + (size_t)(t + 1) * kstep;
            const char* a2 = last ? nA : cA + (size_t)(t + 2) * kstep; const char* b2 = last ? nB : cB + (size_t)(t + 2) * kstep;
            const char* a3 = a2 + kstep; const char* b3 = b2 + kstep;
            unsigned x0[2], x1[2];
#pragma unroll
            for (int i = 0; i < 2; ++i) { x0[i] = last ? nslot[i] : cA0[i]; x1[i] = last ? nslot[2 + i] : cA1[i]; }
            PG8_LDB(B0, 0, 0); PG8_LDB(B1, 0, 1); PG8_SCHED; PG8_LDA(At, 0, 0); PG8_STAGE(PG8_SA(1, 1), a1, cA1);
            PG8_WAIT_V(8); PG8_WAIT_L(0); PG8_BAR; PG8_MMA(0, 0, At, B0); PG8_MMA(0, 1, At, B1); PG8_BAR; PG8_SCHED;
            PG8_LDA(At, 0, 1); PG8_STAGE(PG8_SB(0, 0), b2, voffB); PG8_STAGE(PG8_SB(0, 1), b2 + hstep, voffB); PG8_STAGE(PG8_SA(0, 0), a2, x0);
            PG8_WAIT_V(8); PG8_WAIT_L(0); PG8_BAR; PG8_MMA(1, 0, At, B0); PG8_MMA(1, 1, At, B1); PG8_BAR; PG8_SCHED;
            PG8_LDB(B0, 1, 0); PG8_LDB(B1, 1, 1); PG8_SCHED; PG8_LDA(At, 1, 0); PG8_STAGE(PG8_SA(0, 1), a2, x1);
            PG8_WAIT_V(8); PG8_WAIT_L(0); PG8_BAR; PG8_MMA(0, 0, At, B0); PG8_MMA(0, 1, At, B1); PG8_BAR; PG8_SCHED;
            PG8_LDA(At, 1, 1); PG8_STAGE(PG8_SB(1, 0), b3, voffB); PG8_STAGE(PG8_SB(1, 1), b3 + hstep, voffB); PG8_STAGE(PG8_SA(1, 0), a3, x0);
            PG8_WAIT_V(8); PG8_WAIT_L(0); PG8_BAR; PG8_MMA(1, 0, At, B0); PG8_MMA(1, 1, At, B1); PG8_BAR; PG8_SCHED;
        }
        if constexpr (ALIGN_EPI) { if (wr == 0) PG8_BAR; }
        if constexpr (F8) asm volatile("s_nop 15\n\ts_nop 15" ::: "memory");
        E(acc, cur, wr, wc, fr, fq);
        if (!has_next) break;
        if (!E.keep(cur)) {
#pragma unroll
            for (int a = 0; a < 2; ++a)
#pragma unroll
                for (int b = 0; b < 2; ++b)
#pragma unroll
                    for (int m = 0; m < 4; ++m)
#pragma unroll
                        for (int n = 0; n < 2; ++n) acc[a][b][m][n] = (f32x4){0.f, 0.f, 0.f, 0.f};
        }
        cur = nxt; cA = nA; cB = nB; cA0[0] = nslot[0]; cA0[1] = nslot[1]; cA1[0] = nslot[2]; cA1[1] = nslot[3]; ++ui;
        if constexpr (ALIGN_EPI) { if (wr == 1) PG8_BAR; }
    }
    PG8_WAIT_V(0);
    if constexpr (!ALIGN_EPI) { if (wr == 0) PG8_BAR; }
    PG8_BAR;
#undef PG8_SA
#undef PG8_SB
#undef PG8_STAGE
#undef PG8_LDA
#undef PG8_LD8
#undef PG8_LDB
#undef PG8_MMA
#undef PG8_WAIT_V
#undef PG8_WAIT_L
#undef PG8_BAR
#undef PG8_SCHED
}

struct DenseOrder {
    const char* A; const char* Bt; int K, nM, nN, nwg, G, c;
    __device__ __forceinline__ void init(const void* A_, const void* Bt_, int M, int N, int K_, int G_, int c_) { A = (const char*)A_; Bt = (const char*)Bt_; K = K_; nM = M / BM; nN = N / BM; nwg = nM * nN; G = G_; c = c_; }
    __device__ __forceinline__ bool next(int i, Unit& u) const {
        const long L = (long)i * G + c; if (L >= nwg) return false;
        int wgid = (int)L; { const int q = nwg / NXCD, r = nwg % NXCD, xcd = wgid % NXCD, off = wgid / NXCD; wgid = (xcd < r ? xcd * (q + 1) : r * (q + 1) + (xcd - r) * q) + off; }
        const int nig = WGM * nN, gid = wgid / nig, fm = gid * WGM, gsz = (nM - fm) < WGM ? (nM - fm) : WGM;
        u.pm = fm + ((wgid % nig) % gsz); u.pn = (wgid % nig) / gsz; u.aux = 0; return true;
    }
    __device__ __forceinline__ void addr(const Unit& u, const int (&R)[2], const int (&C)[2], const char*& a, const char*& b, unsigned (&a0)[2], unsigned (&a1)[2]) const {
        a = A + (size_t)u.pm * ((size_t)BM * K * 2); b = Bt + (size_t)u.pn * ((size_t)BM * K * 2);
#pragma unroll
        for (int i = 0; i < 2; ++i) { a0[i] = (unsigned)(R[i] * K + C[i]) * 2u; a1[i] = a0[i] + (unsigned)(HALF * K * 2); }
    }
};
}

__host__ __device__ __forceinline__ int proj_logical_col(int c) {
    if (c >= 3584) { const int t = (c - 3584) >> 8, l = (c - 3584) & 255; return ((l >> 7) ? 4608 : 3584) + 128 * t + (l & 127); }
    if (c < 2048 || c >= 3072) return c;
    const int tb = c & ~255, l = c & 255, bj = l >> 7, wc = (l >> 5) & 3, i = l & 31;
    return tb + 64 * wc + 32 * bj + i;
}
struct EpiProj {
    static constexpr bool PERM = true;
    unsigned char* ws; bf16* gates; const float* qg; const float* kg;
    __device__ __forceinline__ bool keep(const pg8::Unit&) const { return false; }
    __device__ __forceinline__ void operator()(f32x4 (&acc)[2][2][4][2], const pg8::Unit& u, int wr, int wc, int fr, int fq) const {
        const int pn = u.pn; const int tok0 = u.pm * 256 + wr * 64 + fr;
        if (pn < 8 || pn == 12 || pn == 13) {
            unsigned char* base = ws + ((pn < 8) ? (WS_HQ + (size_t)(pn >> 1) * (32 * MiB)) : WS_VIMG);
#pragma unroll
            for (int ai = 0; ai < 2; ++ai)
#pragma unroll
                for (int m = 0; m < 4; ++m) {
                    const int tok = tok0 + ai * 128 + m * 16; const int b = tok >> 12, s = tok & 4095, chunk = s >> 6, row = s & 63;
#pragma unroll
                    for (int bj = 0; bj < 2; ++bj) { const int h = 2 * (pn & 1) + bj;
                        unsigned char* dst = base + ((size_t)((b * 4 + h) * 64 + chunk) << 14) + off_a(row, 4 * wc + fq);
                        *(v4u*)dst = pack8(acc[ai][bj][m][0], acc[ai][bj][m][1]); }
                }
        } else if (pn < 12) {
            const bool isq = pn < 10; const float* gn = isq ? qg : kg;
            const int j = 4 * (pn & 1) + wc, h = j >> 1, mp = j & 1;
            const f32x4 ga0 = *(const f32x4*)(gn + 8 * fq), ga1 = *(const f32x4*)(gn + 8 * fq + 4), gb0 = *(const f32x4*)(gn + 32 + 8 * fq), gb1 = *(const f32x4*)(gn + 36 + 8 * fq);
            const f32x4* rope = (const f32x4*)(ws + WS_ROPE);
            const float qs = isq ? 0.125f * LOG2E : 1.0f;
#pragma unroll
            for (int ai = 0; ai < 2; ++ai)
#pragma unroll
                for (int m = 0; m < 4; ++m) {
                    const int tok = tok0 + ai * 128 + m * 16; const int b = tok >> 12, s = tok & 4095;
                    f32x4 x10 = acc[ai][0][m][0], x11 = acc[ai][0][m][1], x20 = acc[ai][1][m][0], x21 = acc[ai][1][m][1];
                    float ss = 0.f;
#pragma unroll
                    for (int e = 0; e < 4; ++e) ss += x10[e] * x10[e] + x11[e] * x11[e] + x20[e] * x20[e] + x21[e] * x21[e];
                    ss += swz_xor<16>(ss); { auto rr = __builtin_amdgcn_permlane32_swap(__float_as_uint(ss), __float_as_uint(ss), false, false); ss = __uint_as_float(rr[0]) + __uint_as_float(rr[1]); }
                    const float rstd = qs / sqrtf(ss * (1.0f / 64.0f) + EPS);
                    x10 = x10 * ga0 * rstd; x11 = x11 * ga1 * rstd; x20 = x20 * gb0 * rstd; x21 = x21 * gb1 * rstd;
                    const f32x4* rp = rope + (size_t)s * 16 + 4 * fq;
                    const f32x4 r0 = rp[0], r1 = rp[1], r2 = rp[2], r3 = rp[3];
                    f32x4 o10, o11, o20, o21;
                    o10[0] = x10[0] * r0[0] - x20[0] * r0[1]; o20[0] = x10[0] * r0[1] + x20[0] * r0[0];
                    o10[1] = x10[1] * r0[2] - x20[1] * r0[3]; o20[1] = x10[1] * r0[3] + x20[1] * r0[2];
                    o10[2] = x10[2] * r1[0] - x20[2] * r1[1]; o20[2] = x10[2] * r1[1] + x20[2] * r1[0];
                    o10[3] = x10[3] * r1[2] - x20[3] * r1[3]; o20[3] = x10[3] * r1[3] + x20[3] * r1[2];
                    o11[0] = x11[0] * r2[0] - x21[0] * r2[1]; o21[0] = x11[0] * r2[1] + x21[0] * r2[0];
                    o11[1] = x11[1] * r2[2] - x21[1] * r2[3]; o21[1] = x11[1] * r2[3] + x21[1] * r2[2];
                    o11[2] = x11[2] * r3[0] - x21[2] * r3[1]; o21[2] = x11[2] * r3[1] + x21[2] * r3[0];
                    o11[3] = x11[3] * r3[2] - x21[3] * r3[3]; o21[3] = x11[3] * r3[3] + x21[3] * r3[2];
                    const v4u w1 = pack8(o10, o11), w2 = pack8(o20, o21);
                    if (isq) {
                        bf16* q = (bf16*)(ws + WS_QT) + ((size_t)((b * 4 + h) * 4096 + s) * 128 + 64 * mp + 8 * fq);
                        *(v4u*)q = w1; *(v4u*)(q + 32) = w2;
                    } else {
                        unsigned char* kb = ws + WS_KIMG + ((size_t)((b * 4 + h) * 64 + (s >> 6)) << 14);
                        const unsigned rho = kappa((unsigned)(s & 63));
                        *(v4u*)(kb + off_a(rho, 8 * mp + fq)) = w1; *(v4u*)(kb + off_a(rho, 8 * mp + 4 + fq)) = w2;
                    }
                }
        } else {
            unsigned char* gblk = (unsigned char*)gates + ((size_t)(u.pm * 8 + (pn - 14)) << 17) + (size_t)(((wr * 4) * 4 + wc) * 64 + fr + 16 * fq) * 16;
#pragma unroll
            for (int ai = 0; ai < 2; ++ai)
#pragma unroll
                for (int m = 0; m < 4; ++m) {
                    bf16* dst = (bf16*)(gblk + (size_t)(ai * 2 * 4 + m) * 4 * 1024);
                    f32x4 r0, r1, s0, s1;
#pragma unroll
                    for (int e = 0; e < 4; ++e) {
                        const float ea0 = __expf(-acc[ai][0][m][0][e]), ea1 = __expf(-acc[ai][0][m][1][e]), eb0 = __expf(-acc[ai][1][m][0][e]), eb1 = __expf(-acc[ai][1][m][1][e]);
                        r0[e] = (1.0f + eb0) * rcpf_(1.0f + ea0); r1[e] = (1.0f + eb1) * rcpf_(1.0f + ea1); s0[e] = rcpf_(1.0f + eb0); s1[e] = rcpf_(1.0f + eb1);
                    }
                    *(v4u*)dst = pack8(r0, r1); *(v4u*)(dst + 32768) = pack8(s0, s1);
                }
        }
    }
};

struct BranchOrder {
    pg8::DenseOrder d; const char* A2; const char* B2;
    __device__ __forceinline__ bool next(int i, pg8::Unit& u) const { if (!d.next(i >> 1, u)) return false; u.aux = i & 1; return true; }
    __device__ __forceinline__ void addr(const pg8::Unit& u, const int (&R)[2], const int (&C)[2], const char*& a, const char*& b, unsigned (&a0)[2], unsigned (&a1)[2]) const {
        d.addr(u, R, C, a, b, a0, a1);
        if (u.aux) { a = A2 + (size_t)u.pm * ((size_t)pg8::BM * d.K * 2); b = B2 + (size_t)u.pn * ((size_t)pg8::BM * d.K * 2); }
    }
};
struct EpiBranch {
    static constexpr bool PERM = true;
    const bf16* gates; bf16* mixed;
    __device__ __forceinline__ bool keep(const pg8::Unit& u) const { return u.aux == 0; }
    __device__ __forceinline__ void operator()(f32x4 (&acc)[2][2][4][2], const pg8::Unit& u, int wr, int wc, int fr, int fq) const {
        const int tok0 = u.pm * 256 + wr * 64 + fr, c0 = u.pn * 256 + 32 * wc + 8 * fq;
        const unsigned char* gb = (const unsigned char*)gates + ((size_t)(u.pm * 8 + 2 * u.pn) << 17) + (u.aux ? 65536 : 0) + (size_t)(((wr * 4) * 4 + wc) * 64 + fr + 16 * fq) * 16;
        v4u g[2][4][2];
#pragma unroll
        for (int ai = 0; ai < 2; ++ai)
#pragma unroll
            for (int m = 0; m < 4; ++m)
#pragma unroll
                for (int bj = 0; bj < 2; ++bj) g[ai][m][bj] = *(const v4u*)(gb + ((size_t)bj << 17) + (size_t)(ai * 2 * 4 + m) * 4 * 1024);
#pragma unroll
        for (int ai = 0; ai < 2; ++ai) {
#pragma unroll
            for (int m = 0; m < 4; ++m)
#pragma unroll
                for (int bj = 0; bj < 2; ++bj) {
#pragma unroll
                    for (int e = 0; e < 2; ++e) { acc[ai][bj][m][0][2 * e] *= __uint_as_float(g[ai][m][bj][e] << 16); acc[ai][bj][m][0][2 * e + 1] *= __uint_as_float(g[ai][m][bj][e] & 0xffff0000u);
                                                  acc[ai][bj][m][1][2 * e] *= __uint_as_float(g[ai][m][bj][2 + e] << 16); acc[ai][bj][m][1][2 * e + 1] *= __uint_as_float(g[ai][m][bj][2 + e] & 0xffff0000u); }
                    if (u.aux) *(v4u*)(mixed + (size_t)(tok0 + ai * 128 + m * 16) * DM + c0 + 128 * bj) = pack8(acc[ai][bj][m][0], acc[ai][bj][m][1]);
                }
        }
    }
};
struct EpiOut {
    static constexpr bool PERM = true;
    const float* x; bf16* x1b;
    __device__ __forceinline__ bool keep(const pg8::Unit&) const { return false; }
    __device__ __forceinline__ void operator()(f32x4 (&acc)[2][2][4][2], const pg8::Unit& u, int wr, int wc, int fr, int fq) const {
        const int tok0 = u.pm * 256 + wr * 64 + fr, c0 = u.pn * 256 + 32 * wc + 8 * fq;
#pragma unroll
        for (int ai = 0; ai < 2; ++ai)
#pragma unroll
            for (int mp = 0; mp < 2; ++mp) {
                f32x4 xv[2][2][2];
#pragma unroll
                for (int mm = 0; mm < 2; ++mm) { const size_t ro = (size_t)(tok0 + ai * 128 + (2 * mp + mm) * 16) * DM + c0;
#pragma unroll
                    for (int bj = 0; bj < 2; ++bj)
#pragma unroll
                        for (int n = 0; n < 2; ++n) xv[mm][bj][n] = *(const f32x4*)(x + ro + 128 * bj + 4 * n); }
#pragma unroll
                for (int mm = 0; mm < 2; ++mm) { const size_t ro = (size_t)(tok0 + ai * 128 + (2 * mp + mm) * 16) * DM + c0;
#pragma unroll
                    for (int bj = 0; bj < 2; ++bj) *(v4u*)(x1b + ro + 128 * bj) = pack8(xv[mm][bj][0] + acc[ai][bj][2 * mp + mm][0], xv[mm][bj][1] + acc[ai][bj][2 * mp + mm][1]); }
            }
    }
};
template <int rmul> struct MoeOrderT {
    const LAS int* pref; const LAS int* cnt; const v2u* rowtok; const char* A; const char* Bt; int K; size_t bstride; int rmul_unused; int b_lo, b_hi, ncol, G, c;
    __device__ __forceinline__ bool next(int i, pg8::Unit& u) const {
        const int L = i * G + c; const int t0 = pref[b_lo], total = (pref[b_hi] - t0) * ncol; if (L >= total) return false;
        const int rt = t0 + (L >> 2); int b = b_lo;
#pragma unroll 1
        for (int st = 32; st >= 1; st >>= 1) { const int nb_ = b + st; if (nb_ < b_hi && __builtin_amdgcn_readfirstlane(pref[nb_]) <= rt) b = nb_; }
        u.pm = rt - pref[b]; u.pn = L & 3; u.aux = b; return true;
    }
    __device__ __forceinline__ void addr(const pg8::Unit& u, const int (&R)[2], const int (&C)[2], const char*& a, const char*& b, unsigned (&a0)[2], unsigned (&a1)[2]) const {
        a = A; b = Bt + (size_t)(u.aux & 31) * bstride + (size_t)u.pn * ((size_t)pg8::BM * K * 2);
        if constexpr (rmul == 0) {
            const unsigned base = (unsigned)(pref[u.aux] + u.pm) * 256u;
#pragma unroll
            for (int i = 0; i < 2; ++i) { a0[i] = ((base + (unsigned)R[i]) * (unsigned)K + (unsigned)C[i]) * 2u; a1[i] = a0[i] + (unsigned)(128 * K * 2); }
        } else {
        const int n = cnt[u.aux]; const v2u* rt = rowtok + (size_t)u.aux * RCAP;
#pragma unroll
        for (int i = 0; i < 2; ++i) {
            const int r0 = u.pm * 256 + R[i], r1 = r0 + 128;
            const int t0 = (r0 < n) ? (int)rt[r0].x : 0, t1 = (r1 < n) ? (int)rt[r1].x : 0;
            a0[i] = (unsigned)(t0 * K + C[i]) * 2u; a1[i] = (unsigned)(t1 * K + C[i]) * 2u;
        }
        }
    }
};
struct EpiUp {
    static constexpr bool PERM = true;
    const LAS int* pref; const LAS int* cnt; unsigned char* hid;
    __device__ __forceinline__ bool keep(const pg8::Unit&) const { return false; }
    __device__ __forceinline__ void operator()(f32x4 (&acc)[2][2][4][2], const pg8::Unit& u, int wr, int wc, int fr, int fq) const {
        const int n = cnt[u.aux] - u.pm * 256;
        int frl = fr, fql = fq; asm volatile("" : "+v"(frl), "+v"(fql));
        const int r0 = wr * 64 + frl, c0 = u.pn * 128 + 32 * wc + 8 * fql;
        unsigned char* hb = hid + (size_t)(pref[u.aux] + u.pm) * (256 * DFF) + c0;
#pragma unroll
        for (int ai = 0; ai < 2; ++ai)
#pragma unroll
            for (int m = 0; m < 4; ++m) {
                const int r = r0 + ai * 128 + m * 16;
                f32x4 h0, h1;
#pragma unroll
                for (int e = 0; e < 4; ++e) { const float a0 = acc[ai][0][m][0][e], a1 = acc[ai][0][m][1][e];
                    h0[e] = a0 * rcpf_(1.0f + __expf(-a0)) * acc[ai][1][m][0][e]; h1[e] = a1 * rcpf_(1.0f + __expf(-a1)) * acc[ai][1][m][1][e]; }
                if (r < n) *(v2u*)(hb + (size_t)r * DFF) = (v2u){pk4_fp8(h0[0], h0[1], h0[2], h0[3]), pk4_fp8(h1[0], h1[1], h1[2], h1[3])};
            }
    }
};
struct EpiDown {
    static constexpr bool PERM = true;
    const LAS int* pref; const LAS int* cnt; bf16* y;
    __device__ __forceinline__ bool keep(const pg8::Unit&) const { return false; }
    __device__ __forceinline__ void operator()(f32x4 (&acc)[2][2][4][2], const pg8::Unit& u, int wr, int wc, int fr, int fq) const {
        const int n = cnt[u.aux] - u.pm * 256;
        int frl = fr, fql = fq; asm volatile("" : "+v"(frl), "+v"(fql));
        const int r0 = wr * 64 + frl, c0 = u.pn * 256 + 32 * wc + 8 * fql;
        bf16* yb = y + (size_t)(pref[u.aux] + u.pm) * (256 * DM) + c0;
#pragma unroll
        for (int ai = 0; ai < 2; ++ai)
#pragma unroll
            for (int m = 0; m < 4; ++m) {
                const int r = r0 + ai * 128 + m * 16;
                if (r < n) {
#pragma unroll
                    for (int bj = 0; bj < 2; ++bj) *(v4u*)(yb + (size_t)r * DM + 128 * bj) = pack8(acc[ai][bj][m][0], acc[ai][bj][m][1]);
                }
            }
    }
};

constexpr int NWAVES = 8;
constexpr int RING_OFF = 0, RING_BYTES = 131072;
struct Args { const float* in[20]; float* out; unsigned char* ws; int ph_lo, ph_hi, li, pad; };
constexpr int SCHED_OFF = RING_BYTES + 8192;

template <class F>
__device__ __forceinline__ void transpose_item(const float* W, int N, bf16* WT, int K, LAS float* scr, int kb, int nb, int lane, F srccol) {
    const int k0 = 64 * kb, n0 = 32 * nb; const int sc = srccol(n0);
#pragma unroll 8
    for (int i = 0; i < 32; ++i) { const int kk = 2 * i + (lane >> 5); scr[kk * 33 + (lane & 31)] = W[(size_t)(k0 + kk) * N + sc + (lane & 31)]; }
    asm volatile("s_waitcnt lgkmcnt(0)" ::: "memory");
    const int c = lane & 7;
#pragma unroll
    for (int j = 0; j < 4; ++j) { const int n = (lane >> 3) + 8 * j; const LAS float* s = scr + (8 * c) * 33 + n;
        v4u o; o.x = cvtpk(s[0 * 33], s[1 * 33]); o.y = cvtpk(s[2 * 33], s[3 * 33]); o.z = cvtpk(s[4 * 33], s[5 * 33]); o.w = cvtpk(s[6 * 33], s[7 * 33]);
        *(v4u*)(WT + (size_t)(n0 + n) * K + k0 + 8 * c) = o; }
    asm volatile("s_waitcnt lgkmcnt(0)" ::: "memory");
}

template <class F>
__device__ __forceinline__ void transpose_item8(const float* W, int N, unsigned char* WT, int K, float sc, LAS float* scr, int kb, int nb, int lane, F srccol) {
    const int k0 = 64 * kb, n0 = 32 * nb; const int scol = srccol(n0);
#pragma unroll 8
    for (int i = 0; i < 32; ++i) { const int kk = 2 * i + (lane >> 5); scr[kk * 33 + (lane & 31)] = W[(size_t)(k0 + kk) * N + scol + (lane & 31)] * sc; }
    asm volatile("s_waitcnt lgkmcnt(0)" ::: "memory");
    const int n = lane & 31, hf = lane >> 5; const LAS float* sp = scr + (32 * hf) * 33 + n;
    v4u o0, o1;
    o0.x = pk4_fp8(sp[0 * 33], sp[1 * 33], sp[2 * 33], sp[3 * 33]); o0.y = pk4_fp8(sp[4 * 33], sp[5 * 33], sp[6 * 33], sp[7 * 33]);
    o0.z = pk4_fp8(sp[8 * 33], sp[9 * 33], sp[10 * 33], sp[11 * 33]); o0.w = pk4_fp8(sp[12 * 33], sp[13 * 33], sp[14 * 33], sp[15 * 33]);
    o1.x = pk4_fp8(sp[16 * 33], sp[17 * 33], sp[18 * 33], sp[19 * 33]); o1.y = pk4_fp8(sp[20 * 33], sp[21 * 33], sp[22 * 33], sp[23 * 33]);
    o1.z = pk4_fp8(sp[24 * 33], sp[25 * 33], sp[26 * 33], sp[27 * 33]); o1.w = pk4_fp8(sp[28 * 33], sp[29 * 33], sp[30 * 33], sp[31 * 33]);
    unsigned char* d = WT + (size_t)(n0 + n) * K + k0 + 32 * hf;
    *(v4u*)d = o0; *(v4u*)(d + 16) = o1;
    asm volatile("s_waitcnt lgkmcnt(0)" ::: "memory");
}
__device__ __forceinline__ void p0_prologue(const Args& a, LAS unsigned char* lds, int vcu, int G, int wave, int lane) {
    LAS float* scr = (LAS float*)(lds + wave * 16384);
    unsigned char* ws = a.ws;
    const int gw = vcu * NWAVES + wave, NGW = G * NWAVES;
    constexpr int I_IN = 16 * (NCOLS / 32), I_BR = 8 * 32, I_OUT = 16 * 32;
    constexpr int NITEMS = I_IN + 2 * I_BR + I_OUT;
    for (int it = gw; it < NITEMS; it += NGW) {
        int r = it;
        if (r < I_IN) { transpose_item(a.in[2], NCOLS, (bf16*)(ws + WS_WIN), DM, scr, r / (NCOLS / 32), r % (NCOLS / 32), lane, [](int n) { return proj_logical_col(n); }); continue; } r -= I_IN;
        if (r < I_BR) { transpose_item(a.in[9], DM, (bf16*)(ws + WS_WHG), 512, scr, r / 32, r % 32, lane, [](int n) { return n; }); continue; } r -= I_BR;
        if (r < I_BR) { transpose_item(a.in[10], DM, (bf16*)(ws + WS_WDA), 512, scr, r / 32, r % 32, lane, [](int n) { return n; }); continue; } r -= I_BR;
        transpose_item(a.in[11], DM, (bf16*)(ws + WS_WOUT), DM, scr, r / 32, r % 32, lane, [](int n) { return n; });
    }
    const f32x4 g0 = ((const f32x4*)a.in[1])[lane], g1 = ((const f32x4*)a.in[1])[lane + 64], g2 = ((const f32x4*)a.in[1])[lane + 128], g3 = ((const f32x4*)a.in[1])[lane + 192];
    for (int m = gw; m < NT; m += NGW) {
        const f32x4* xr = (const f32x4*)(a.in[0] + (size_t)m * DM) + lane;
        f32x4 v0 = xr[0], v1 = xr[64], v2 = xr[128], v3 = xr[192];
        float s = 0.f;
#pragma unroll
        for (int e = 0; e < 4; ++e) s += v0[e] * v0[e] + v1[e] * v1[e] + v2[e] * v2[e] + v3[e] * v3[e];
        const float rstd = 1.0f / sqrtf(wave_sum(s) * (1.0f / DM) + EPS);
        v0 = v0 * g0 * rstd; v1 = v1 * g1 * rstd; v2 = v2 * g2 * rstd; v3 = v3 * g3 * rstd;
        v2u* o = (v2u*)((bf16*)(ws + WS_H) + (size_t)m * DM) + lane;
        o[0] = (v2u){cvtpk(v0[0], v0[1]), cvtpk(v0[2], v0[3])}; o[64] = (v2u){cvtpk(v1[0], v1[1]), cvtpk(v1[2], v1[3])};
        o[128] = (v2u){cvtpk(v2[0], v2[1]), cvtpk(v2[2], v2[3])}; o[192] = (v2u){cvtpk(v3[0], v3[1]), cvtpk(v3[2], v3[3])};
    }
    const int gt = (vcu * NWAVES + wave) * 64 + lane, NGT = NGW * 64;
    for (int i = gt; i < 4096 * 32; i += NGT) { const int pos = i >> 5, f = i & 31;
        const float inv = powf(10000.0f, -(float)f / 32.0f); const float ang = (float)pos * inv;
        ((f32x2*)(ws + WS_ROPE))[i] = (f32x2){cosf(ang), sinf(ang)}; }
    if (vcu == 0) {
        float* sm = (float*)(ws + WS_SMALL); const int t = wave * 64 + lane;
        { const float a0 = a.in[3][t], a1 = a.in[3][512 + t], mx = fmaxf(a0, a1), e0 = expf(a0 - mx), e1 = expf(a1 - mx); sm[t] = e0 / (e0 + e1); }
        if (wave == 0) {
            const float* lp = a.in[7];
            const float d01 = wave_sum(lp[lane] * lp[64 + lane]), d23 = wave_sum(lp[128 + lane] * lp[192 + lane]);
            float mq = fabsf(a.in[5][lane]), mk = fabsf(a.in[6][lane]);
            mq = wave_max(mq); mk = wave_max(mk);
            if (lane == 0) { sm[512] = expf(d01) - expf(d23) + 0.2f; sm[513] = 8.0f * mq * mk * LOG2E * 1.001f + 0.01f; }
        }
    }
}

__device__ __forceinline__ void router_phase(const Args& a, LAS unsigned char* lds, int G, int wave, int lane) {
    LAS float* wl = (LAS float*)lds;
    LAS float* gl = (LAS float*)(lds + 77824 + 256);
    LAS float* lg = gl + 1024 + wave * (16 * 48);
    LAS int* lhist = (LAS int*)(gl + 1024 + 8 * 16 * 48);
    LAS int* lbase = lhist + 64;
    LAS int* tbk = lbase + 64;
    LAS int* trk = tbk + 256;
    LAS float* twt = (LAS float*)(trk + 256);
    unsigned char* ws = a.ws; const int tid = tid_x();
    const float* wrg = a.in[13]; const float* wre = a.in[15];
    const bf16* x1b = (const bf16*)(ws + WS_X1B); const float* brg = a.in[14]; const float* bre = a.in[16];
    LAS unsigned char* wt = lds; constexpr int WRS = 1040, WHS = 36 * WRS;
    unsigned* gcnt = (unsigned*)(ws + WS_CTL) + CW_GCNT; v2u* rowtok = (v2u*)(ws + WS_ROWTOK);
    const int c16 = lane & 15, g4 = lane >> 4;
    for (int i = tid; i < 1024; i += 512) gl[i] = a.in[12][i];
    for (int batch = blockIdx.x; batch < NT / 128; batch += G) {
        const int t0 = batch * 128 + wave * 16;
        f32x4 acc0 = {0.f, 0.f, 0.f, 0.f}, acc1 = acc0, acc2 = acc0; float ss = 0.f;
        for (int half = 0; half < 2; ++half) {
            __syncthreads();
            if (half == 0 && tid < 64) lhist[tid] = 0;
#pragma unroll 4
            for (int i = tid; i < 256 * 32; i += 512) { const int n = i & 31, kp = i >> 5, k = 512 * half + 2 * kp;
                const float v0 = wre[(size_t)k * 32 + n] * gl[k], v1 = wre[(size_t)(k + 1) * 32 + n] * gl[k + 1];
                const unsigned hi = cvtpk(v0, v1), lo = cvtpk(v0 - __uint_as_float(hi << 16), v1 - __uint_as_float(hi & 0xffff0000u));
                LAS unsigned char* d = wt + (4 + n) * WRS + 4 * kp; *(LAS unsigned*)d = hi; *(LAS unsigned*)(d + WHS) = lo; }
#pragma unroll
            for (int i = tid; i < 256 * 4; i += 512) { const int n = i & 3, kp = i >> 2, k = 512 * half + 2 * kp;
                const float v0 = wrg[(size_t)k * 4 + n] * gl[k], v1 = wrg[(size_t)(k + 1) * 4 + n] * gl[k + 1];
                const unsigned hi = cvtpk(v0, v1), lo = cvtpk(v0 - __uint_as_float(hi << 16), v1 - __uint_as_float(hi & 0xffff0000u));
                LAS unsigned char* d = wt + n * WRS + 4 * kp; *(LAS unsigned*)d = hi; *(LAS unsigned*)(d + WHS) = lo; }
            __syncthreads();
            const unsigned char* xr = (const unsigned char*)(x1b + (size_t)(t0 + c16) * DM + 512 * half + 8 * g4);
            const LAS unsigned char* wb0 = wt + c16 * WRS + 16 * g4; const LAS unsigned char* wb1 = wb0 + 16 * WRS; const LAS unsigned char* wb2 = wt + (32 + (c16 & 3)) * WRS + 16 * g4;
#pragma unroll 4
            for (int sp = 0; sp < 16; ++sp) {
                const v4u xb = *(const v4u*)(xr + 64 * sp);
#pragma unroll
                for (int e = 0; e < 4; ++e) { const float lo_ = __uint_as_float(xb[e] << 16), hi_ = __uint_as_float(xb[e] & 0xffff0000u); ss += lo_ * lo_ + hi_ * hi_; }
                const bf16x8 av = __builtin_bit_cast(bf16x8, xb);
                acc0 = __builtin_amdgcn_mfma_f32_16x16x32_bf16(av, *(const LAS bf16x8*)(wb0 + 64 * sp), acc0, 0, 0, 0);
                acc1 = __builtin_amdgcn_mfma_f32_16x16x32_bf16(av, *(const LAS bf16x8*)(wb1 + 64 * sp), acc1, 0, 0, 0);
                acc2 = __builtin_amdgcn_mfma_f32_16x16x32_bf16(av, *(const LAS bf16x8*)(wb2 + 64 * sp), acc2, 0, 0, 0);
                acc0 = __builtin_amdgcn_mfma_f32_16x16x32_bf16(av, *(const LAS bf16x8*)(wb0 + WHS + 64 * sp), acc0, 0, 0, 0);
                acc1 = __builtin_amdgcn_mfma_f32_16x16x32_bf16(av, *(const LAS bf16x8*)(wb1 + WHS + 64 * sp), acc1, 0, 0, 0);
                acc2 = __builtin_amdgcn_mfma_f32_16x16x32_bf16(av, *(const LAS bf16x8*)(wb2 + WHS + 64 * sp), acc2, 0, 0, 0);
            }
        }
        ss += swz_xor<16>(ss); { auto rr = __builtin_amdgcn_permlane32_swap(__float_as_uint(ss), __float_as_uint(ss), false, false); ss = __uint_as_float(rr[0]) + __uint_as_float(rr[1]); }
        const float rstd = 1.0f / sqrtf(ss * (1.0f / DM) + EPS);
#pragma unroll
        for (int r = 0; r < 4; ++r) { lg[(4 * g4 + r) * 48 + c16] = acc0[r]; lg[(4 * g4 + r) * 48 + 16 + c16] = acc1[r]; lg[(4 * g4 + r) * 48 + 32 + c16] = acc2[r]; }
        asm volatile("s_waitcnt lgkmcnt(0)" ::: "memory");
        if (lane < 16) {
            const LAS float* lt = lg + lane * 48; const int t = t0 + lane, li = wave * 16 + lane;
            float gl4[4]; int gsel = 0;
#pragma unroll
            for (int q = 0; q < 4; ++q) gl4[q] = lt[q] * rstd + brg[q];
            float gmax = gl4[0];
#pragma unroll
            for (int q = 1; q < 4; ++q) if (gl4[q] > gmax) { gmax = gl4[q]; gsel = q; }
            float den = 0.f;
#pragma unroll
            for (int q = 0; q < 4; ++q) den += expf(gl4[q] - gmax);
            const float gw_ = 1.0f / den;
            float el[8];
#pragma unroll
            for (int q = 0; q < 8; ++q) el[q] = lt[4 + 8 * gsel + q] * rstd + bre[gsel * 8 + q];
            int i0 = 0; float v0 = el[0];
#pragma unroll
            for (int q = 1; q < 8; ++q) if (el[q] > v0) { v0 = el[q]; i0 = q; }
            int i1 = -1; float v1 = -3.0e38f;
#pragma unroll
            for (int q = 0; q < 8; ++q) if (q != i0 && el[q] > v1) { v1 = el[q]; i1 = q; }
            const float w1f = 1.0f / (1.0f + expf(v0 - v1)), w0f = 1.0f - w1f;
            const int b0 = gsel * 8 + i0, b1 = 32 + gsel * 8 + i1;
            tbk[2 * li] = b0; tbk[2 * li + 1] = b1;
            trk[2 * li] = atomicAdd((int*)&lhist[b0], 1); trk[2 * li + 1] = atomicAdd((int*)&lhist[b1], 1);
            twt[2 * li] = w0f * gw_; twt[2 * li + 1] = w1f * gw_;
        }
#pragma unroll
        for (int r = 0; r < 16; ++r) {
            const float rs = __uint_as_float(__builtin_amdgcn_readlane(__float_as_uint(rstd), r));
            const v4u* xr = (const v4u*)(x1b + (size_t)(t0 + r) * DM) + lane;
            v2u* o = (v2u*)(ws + WS_XN + (size_t)(t0 + r) * DM) + lane;
#pragma unroll
            for (int j = 0; j < 2; ++j) { const v4u xb = xr[64 * j]; const LAS float* gp = gl + 8 * lane + 512 * j; const f32x4 ga = *(const LAS f32x4*)gp * rs, gb = *(const LAS f32x4*)(gp + 4) * rs;
                o[64 * j] = (v2u){pk4_fp8(__uint_as_float(xb.x << 16) * ga[0], __uint_as_float(xb.x & 0xffff0000u) * ga[1], __uint_as_float(xb.y << 16) * ga[2], __uint_as_float(xb.y & 0xffff0000u) * ga[3]),
                                  pk4_fp8(__uint_as_float(xb.z << 16) * gb[0], __uint_as_float(xb.z & 0xffff0000u) * gb[1], __uint_as_float(xb.w << 16) * gb[2], __uint_as_float(xb.w & 0xffff0000u) * gb[3])}; }
        }
        __syncthreads();
        if (tid < 64) { const int c = lhist[tid]; lbase[tid] = c ? (int)atomicAdd(&gcnt[tid * 16], (unsigned)c) : 0; }
        __syncthreads();
        if (tid < 256) { const int bk = tbk[tid]; const int slot = lbase[bk] + trk[tid]; rowtok[(size_t)bk * RCAP + slot] = (v2u){(unsigned)(batch * 128 + (tid >> 1)), __float_as_uint(twt[tid])};
            ((v2u*)(ws + WS_TOKPOS))[(size_t)batch * 256 + tid] = (v2u){((unsigned)bk << 16) | (unsigned)slot, __float_as_uint(twt[tid])}; }
    }
    __syncthreads();
}

__device__ __forceinline__ void w13_convert(const Args& a, LAS unsigned char* lds, int vcu, int G, int wave, int lane) {
    LAS float* scr = (LAS float*)(lds + wave * 16384);
    const int gw = vcu * NWAVES + wave, NGW = G * NWAVES;
    for (int it = gw; it < NEXP * 512; it += NGW) {
        const int e = it >> 9, q = it & 511, kb = q >> 5, nb = q & 31, n0 = nb * 32, bj = (n0 >> 7) & 1;
        const float* W = (bj ? a.in[18] : a.in[17]) + (size_t)e * DM * DFF;
        transpose_item8(W, DFF, a.ws + WS_W13T + (size_t)e * DM * DM, DM, 32.0f, scr, kb, nb, lane, [](int n) { return 128 * (n >> 8) + (n & 127); });
    }
    for (int it = gw; it < NEXP * 256; it += NGW) {
        const int e = it >> 8, q = it & 255;
        transpose_item8(a.in[19] + (size_t)e * DFF * DM, DM, a.ws + WS_W2T + (size_t)e * DM * DFF, DFF, 16.0f, scr, q / 32, q % 32, lane, [](int n) { return n; });
    }
}
__device__ __forceinline__ void moe_sched_setup(const Args& a, LAS unsigned char* lds) {
    LAS int* pref = (LAS int*)(lds + SCHED_OFF); LAS int* cnt = pref + 80;
    const unsigned* gcnt = (const unsigned*)(a.ws + WS_CTL) + CW_GCNT;
    const int t_ = tid_x();
    if (t_ < 64) {
        const int c = (int)gcnt[t_ * 16]; cnt[t_] = c;
        int v = (c + 255) >> 8;
        volatile LAS int* tmp = (volatile LAS int*)(pref + 160);
#pragma unroll
        for (int o = 1; o < 64; o <<= 1) { tmp[t_] = v; const int up = tmp[t_ >= o ? t_ - o : 0]; if (t_ >= o) v += up; }
        pref[t_ + 1] = v; if (t_ == 0) pref[0] = 0;
    }
    __syncthreads();
}

namespace att {
constexpr int SLOT = 16384;
constexpr int LDS_K = 0, LDS_V = 2 * SLOT, LDS_L = 4 * SLOT, LDS_STG = 4 * SLOT + 4096;
typedef short v4i16_t __attribute__((ext_vector_type(4)));
__device__ __forceinline__ s16x4 vtr(const LAS unsigned char* p) { return __builtin_bit_cast(s16x4, __builtin_amdgcn_ds_read_tr16_b64_v4i16((LAS v4i16_t*)p)); }
#define ATT_WAIT_BAR(N) asm volatile("s_waitcnt vmcnt(" #N ")\n\ts_barrier" ::: "memory")
#define ATT_MFMA(a, b, c) __builtin_amdgcn_mfma_f32_32x32x16_bf16((a), (b), (c), 0, 0, 0)
__device__ __forceinline__ void softmax_tile(f32x16& p0, f32x16& p1, bf16x8 (&pa)[4], float& lsum, int jb, int qrel, int hh, float mshift) {
    if (jb >= 0) {
#pragma unroll
        for (int r = 0; r < 16; ++r) { const int kr = 64 * jb + (r & 7) + 8 * hh + 16 * (r >> 3);
            if (kr > qrel) p0[r] = -INFINITY; if (kr + 32 > qrel) p1[r] = -INFINITY; }
    }
    float s = 0.f;
#pragma unroll
    for (int r = 0; r < 16; ++r) { p0[r] = __builtin_amdgcn_exp2f(p0[r] - mshift); p1[r] = __builtin_amdgcn_exp2f(p1[r] - mshift); s += p0[r] + p1[r]; }
    lsum += s;
    v4u w;
    w.x = cvtpk(p0[0], p0[1]); w.y = cvtpk(p0[2], p0[3]); w.z = cvtpk(p0[4], p0[5]); w.w = cvtpk(p0[6], p0[7]); pa[0] = __builtin_bit_cast(bf16x8, w);
    w.x = cvtpk(p0[8], p0[9]); w.y = cvtpk(p0[10], p0[11]); w.z = cvtpk(p0[12], p0[13]); w.w = cvtpk(p0[14], p0[15]); pa[1] = __builtin_bit_cast(bf16x8, w);
    w.x = cvtpk(p1[0], p1[1]); w.y = cvtpk(p1[2], p1[3]); w.z = cvtpk(p1[4], p1[5]); w.w = cvtpk(p1[6], p1[7]); pa[2] = __builtin_bit_cast(bf16x8, w);
    w.x = cvtpk(p1[8], p1[9]); w.y = cvtpk(p1[10], p1[11]); w.z = cvtpk(p1[12], p1[13]); w.w = cvtpk(p1[14], p1[15]); pa[3] = __builtin_bit_cast(bf16x8, w);
}
struct E16 { float v[16]; };
__device__ __forceinline__ void soft_half(f32x16& p, bf16x8& paA, bf16x8& paB, float& lsum, int jb, int wid, int half) {
    if (jb >= 0) {
        const int ln = (int)lane_id(), hh = ln >> 5, qrel = wid * 32 + (ln & 31);
#pragma unroll
        for (int r = 0; r < 16; ++r) { const int kr = 64 * jb + 32 * half + (r & 7) + 8 * hh + 16 * (r >> 3); if (kr > qrel) p[r] = -INFINITY; }
    }
    float e[16];
#pragma unroll
    for (int r = 0; r < 16; ++r) e[r] = __builtin_amdgcn_exp2f(p[r]);
    const float s0 = (e[0] + e[1]) + (e[2] + e[3]), s1 = (e[4] + e[5]) + (e[6] + e[7]), s2 = (e[8] + e[9]) + (e[10] + e[11]), s3 = (e[12] + e[13]) + (e[14] + e[15]);
    lsum += (s0 + s1) + (s2 + s3);
    v4u w;
    w.x = cvtpk(e[0], e[1]); w.y = cvtpk(e[2], e[3]); w.z = cvtpk(e[4], e[5]); w.w = cvtpk(e[6], e[7]); paA = __builtin_bit_cast(bf16x8, w);
    w.x = cvtpk(e[8], e[9]); w.y = cvtpk(e[10], e[11]); w.z = cvtpk(e[12], e[13]); w.w = cvtpk(e[14], e[15]); paB = __builtin_bit_cast(bf16x8, w);
    asm volatile("" : "+v"(paA), "+v"(paB), "+v"(lsum));
}
__device__ __forceinline__ void exp_half(f32x16& p, E16& e, int jb, int wid, int half) {
    if (jb >= 0) {
        const int ln = (int)lane_id(), hh = ln >> 5, qrel = wid * 32 + (ln & 31);
#pragma unroll
        for (int r = 0; r < 16; ++r) { const int kr = 64 * jb + 32 * half + (r & 7) + 8 * hh + 16 * (r >> 3); if (kr > qrel) p[r] = -INFINITY; }
    }
#pragma unroll
    for (int r = 0; r < 16; ++r) e.v[r] = __builtin_amdgcn_exp2f(p[r]);
    asm volatile("" : "+v"(e.v[0]), "+v"(e.v[1]), "+v"(e.v[2]), "+v"(e.v[3]), "+v"(e.v[4]), "+v"(e.v[5]), "+v"(e.v[6]), "+v"(e.v[7]),
                      "+v"(e.v[8]), "+v"(e.v[9]), "+v"(e.v[10]), "+v"(e.v[11]), "+v"(e.v[12]), "+v"(e.v[13]), "+v"(e.v[14]), "+v"(e.v[15]));
}
__device__ __forceinline__ void pack_half(const E16& e, bf16x8& paA, bf16x8& paB, float& lsum) {
    const float* p = e.v;
    float s0 = (p[0] + p[1]) + (p[2] + p[3]), s1 = (p[4] + p[5]) + (p[6] + p[7]), s2 = (p[8] + p[9]) + (p[10] + p[11]), s3 = (p[12] + p[13]) + (p[14] + p[15]);
    lsum += (s0 + s1) + (s2 + s3);
    v4u w;
    w.x = cvtpk(p[0], p[1]); w.y = cvtpk(p[2], p[3]); w.z = cvtpk(p[4], p[5]); w.w = cvtpk(p[6], p[7]); paA = __builtin_bit_cast(bf16x8, w);
    w.x = cvtpk(p[8], p[9]); w.y = cvtpk(p[10], p[11]); w.z = cvtpk(p[12], p[13]); w.w = cvtpk(p[14], p[15]); paB = __builtin_bit_cast(bf16x8, w);
}
__device__ __forceinline__ void softmax_half(f32x16& p, bf16x8& paA, bf16x8& paB, float& lsum, int jb, int qrel, int hh, float mshift, int half) {
    if (jb >= 0) {
#pragma unroll
        for (int r = 0; r < 16; ++r) { const int kr = 64 * jb + 32 * half + (r & 7) + 8 * hh + 16 * (r >> 3); if (kr > qrel) p[r] = -INFINITY; }
    }
    float s = 0.f;
#pragma unroll
    for (int r = 0; r < 16; ++r) { p[r] = __builtin_amdgcn_exp2f(p[r] - mshift); s += p[r]; }
    lsum += s;
    v4u w;
    w.x = cvtpk(p[0], p[1]); w.y = cvtpk(p[2], p[3]); w.z = cvtpk(p[4], p[5]); w.w = cvtpk(p[6], p[7]); paA = __builtin_bit_cast(bf16x8, w);
    w.x = cvtpk(p[8], p[9]); w.y = cvtpk(p[10], p[11]); w.z = cvtpk(p[12], p[13]); w.w = cvtpk(p[14], p[15]); paB = __builtin_bit_cast(bf16x8, w);
}
__device__ __forceinline__ void attn_unit(int bh, int qb, unsigned char* ws, LAS unsigned char* lds, float mshift, float lam, const float* gain) {
    int tid = tid_x(); asm volatile("" : "+v"(tid));
    const int lane = tid & 63, wid = __builtin_amdgcn_readfirstlane(tid >> 6), r32 = lane & 31, hh = lane >> 5;
    const int NTL = 4 * (qb + 1);
    const unsigned char* kgu = ws + WS_KIMG + ((size_t)bh << 20) + wid * 1024;
    const unsigned char* vgu = ws + WS_VIMG + ((size_t)bh << 20) + wid * 1024;

    {
        const unsigned char* Qg = ws + WS_QT + ((size_t)bh * 4096 + qb * 256 + wid * 32) * 256;
#pragma unroll
        for (int i = 0; i < 8; ++i) { const unsigned row = 8u * (i >> 1) + (((unsigned)lane >> 2) & 7u), ch = 4u * (2u * (i & 1) + ((unsigned)lane >> 5)) + (((unsigned)lane & 3u) ^ ((row >> 2) & 3u));
            __builtin_amdgcn_global_load_lds((const unsigned*)(Qg + row * 256 + ch * 16), (LAS unsigned*)(lds + LDS_STG + wid * 8192 + i * 1024), 16, 0, 0); }
    }
    const LAS unsigned char* Qb = lds + LDS_STG + wid * 8192;
#define ATT_DMA_K(t, slot) do { const unsigned char* tb_ = kgu + ((size_t)(t) << 14); \
        const unsigned lo16 = lane_id() * 16u; __builtin_amdgcn_global_load_lds((const unsigned*)(tb_ + lo16), (LAS unsigned*)(lds + LDS_K + (slot) * SLOT + wid * 1024), 16, 0, 0); \
        __builtin_amdgcn_global_load_lds((const unsigned*)(tb_ + 8192 + lo16), (LAS unsigned*)(lds + LDS_K + (slot) * SLOT + 8192 + wid * 1024), 16, 0, 0); } while (0)
#define ATT_DMA_V(t, slot) do { const unsigned char* tb_ = vgu + ((size_t)(t) << 14); \
        const unsigned lo16 = lane_id() * 16u; __builtin_amdgcn_global_load_lds((const unsigned*)(tb_ + lo16), (LAS unsigned*)(lds + LDS_V + (slot) * SLOT + wid * 1024), 16, 0, 0); \
        __builtin_amdgcn_global_load_lds((const unsigned*)(tb_ + 8192 + lo16), (LAS unsigned*)(lds + LDS_V + (slot) * SLOT + 8192 + wid * 1024), 16, 0, 0); } while (0)
    ATT_DMA_K(0, 0); ATT_DMA_V(0, 0);
    f32x16 o1[4], o2[4];
#pragma unroll
    for (int c = 0; c < 4; ++c)
#pragma unroll
        for (int r = 0; r < 16; ++r) { o1[c][r] = 0.f; o2[c][r] = 0.f; }
    float l1 = 0.f, l2 = 0.f;
    const unsigned krb = 2048u * ((unsigned)r32 >> 3) + 64u * ((unsigned)r32 & 7u), krs = ((unsigned)r32 >> 2) & 3u;
    const unsigned kr0 = krb + 16u * (hh ^ krs);
    const unsigned tq = ((unsigned)lane & 15u) >> 2, tp = (unsigned)lane & 3u, tblk = ((unsigned)lane >> 4) & 1u;
    const unsigned tvb = 2048u * hh + 64u * tq + 8u * (tp & 1u), tvx = (2u * tblk + (tp >> 1)) ^ (2u * hh);
    const unsigned tv0 = tvb + 16u * tvx;
    const int NPH = 2 * NTL;
#define ATT_BOUNDARY(ph_) do { const int ph__ = (ph_); \
        if (ph__ + 1 < NPH) asm volatile("s_waitcnt vmcnt(2) lgkmcnt(0)\n\ts_barrier" ::: "memory"); else asm volatile("s_waitcnt vmcnt(0) lgkmcnt(0)\n\ts_barrier" ::: "memory"); \
        const int m__ = ph__ + 2; if (m__ < NPH) { if (m__ & 1) ATT_DMA_V(m__ >> 1, (m__ >> 1) & 1); else ATT_DMA_K(m__ >> 1, (m__ >> 1) & 1); } } while (0)
#define ATT_SB() __builtin_amdgcn_sched_barrier(0)
#define ATT_KADDR(m_, j_) ((((j_) & 1) ? (kr0 ^ 32u) : kr0) + 512u * (2 * (m_) + ((j_) >> 1)))
#define ATT_LDQ(m_) do { _Pragma("unroll") for (int j = 0; j < 4; ++j) qF[j] = *(const LAS bf16x8*)(Qb + ATT_KADDR(m_, j)); } while (0)
#define ATT_LDK(m_, h_) do { _Pragma("unroll") for (int j = 0; j < 4; ++j) kF[j] = *(const LAS bf16x8*)(Kb + ATT_KADDR(m_, j) + 8192 * (h_)); } while (0)
#define ATT_CHAIN() do { _Pragma("unroll") for (int r = 0; r < 16; ++r) p[r] = -mshift; _Pragma("unroll") for (int j = 0; j < 4; ++j) p = ATT_MFMA(kF[j], qF[j], p); } while (0)
#define ATT_X(t_) do { const int jb = (t_) - (NTL - 4); const LAS unsigned char* Kb = lds + LDS_K + ((t_) & 1) * SLOT; bf16x8 qF[4], kF[4]; f32x16 p; \
        ATT_LDQ(0); ATT_LDK(0, 0); ATT_SB(); \
        ATT_CHAIN(); ATT_SB(); ATT_LDK(0, 1); ATT_SB(); soft_half(p, pa1[0], pa1[1], l1, jb, wid, 0); ATT_SB(); \
        ATT_CHAIN(); ATT_SB(); ATT_LDQ(1); ATT_LDK(1, 0); ATT_SB(); soft_half(p, pa1[2], pa1[3], l1, jb, wid, 1); ATT_SB(); \
        ATT_CHAIN(); ATT_SB(); ATT_LDK(1, 1); ATT_SB(); soft_half(p, pa2[0], pa2[1], l2, jb, wid, 0); ATT_SB(); \
        ATT_CHAIN(); ATT_SB(); soft_half(p, pa2[2], pa2[3], l2, jb, wid, 1); ATT_SB(); } while (0)
#define ATT_VLOAD(buf, i) asm volatile("ds_read_b64_tr_b16 %0, %2 offset:%c4\n\tds_read_b64_tr_b16 %1, %3 offset:%c4" : "=&v"(vlo[buf]), "=&v"(vhi[buf]) : "v"(va0), "v"(va1), "i"(4096 * ((i) & 3) + 512 * ((i) >> 2)) : "memory")
#define ATT_Y(t_) do { const unsigned va0 = (unsigned)(uintptr_t)(lds + LDS_V + ((t_) & 1) * SLOT) + tv0, va1 = (unsigned)(uintptr_t)(lds + LDS_V + ((t_) & 1) * SLOT) + (tv0 ^ 16u) + 256u; \
        s16x4 vlo[3], vhi[3]; ATT_VLOAD(0, 0); ATT_VLOAD(1, 1); \
        _Pragma("unroll") for (int i = 0; i < 16; ++i) { if (i + 2 < 16) ATT_VLOAD((i + 2) % 3, i + 2); \
            if (i + 2 < 16) asm volatile("s_waitcnt lgkmcnt(4)" : "+v"(vlo[i % 3]), "+v"(vhi[i % 3]) :: "memory"); \
            else if (i + 1 < 16) asm volatile("s_waitcnt lgkmcnt(2)" : "+v"(vlo[i % 3]), "+v"(vhi[i % 3]) :: "memory"); \
            else asm volatile("s_waitcnt lgkmcnt(0)" : "+v"(vlo[i % 3]), "+v"(vhi[i % 3]) :: "memory"); \
            const bf16x8 vf = __builtin_shufflevector(vlo[i % 3], vhi[i % 3], 0, 1, 2, 3, 4, 5, 6, 7); \
            o1[i >> 2] = ATT_MFMA(pa1[i & 3], vf, o1[i >> 2]); o2[i >> 2] = ATT_MFMA(pa2[i & 3], vf, o2[i >> 2]); } } while (0)
    if (wid < 4) {
        for (int t = 0; t < NTL; ++t) {
            const bool on = (t - (NTL - 4)) <= (wid >> 1);
            bf16x8 pa1[4], pa2[4];
            ATT_BOUNDARY(2 * t);
            if (on) { __builtin_amdgcn_s_setprio(3); ATT_X(t); __builtin_amdgcn_s_setprio(0); }
            ATT_BOUNDARY(2 * t + 1);
            if (on) ATT_Y(t);
        }
        ATT_BOUNDARY(NPH);
    } else {
        ATT_BOUNDARY(0);
        for (int t = 0; t < NTL; ++t) {
            const bool on = (t - (NTL - 4)) <= (wid >> 1);
            bf16x8 pa1[4], pa2[4];
            ATT_BOUNDARY(2 * t + 1);
            if (on) { __builtin_amdgcn_s_setprio(3); ATT_X(t); __builtin_amdgcn_s_setprio(0); }
            ATT_BOUNDARY(2 * t + 2);
            if (on) ATT_Y(t);
        }
    }
#undef ATT_BOUNDARY
#undef ATT_X
#undef ATT_Y
#undef ATT_KADDR
#undef ATT_LDQ
#undef ATT_LDK
#undef ATT_CHAIN
#undef ATT_VLOAD
#undef ATT_SB
    { auto rr = __builtin_amdgcn_permlane32_swap(__float_as_uint(l1), __float_as_uint(l1), false, false); l1 = __uint_as_float(rr[0]) + __uint_as_float(rr[1]); }
    { auto rr = __builtin_amdgcn_permlane32_swap(__float_as_uint(l2), __float_as_uint(l2), false, false); l2 = __uint_as_float(rr[0]) + __uint_as_float(rr[1]); }
    int lane_e = (int)lane_id(); asm volatile("" : "+v"(lane_e));
    const int hh_e = lane_e >> 5, r32_e = lane_e & 31;
    LAS float* lw = (LAS float*)(lds + LDS_L) + wid * 64;
    if (hh_e == 0) { lw[r32_e] = 1.0f / l1; lw[32 + r32_e] = lam / l2; }
    asm volatile("s_waitcnt lgkmcnt(0)" ::: "memory");
    float ssq[16];
#pragma unroll
    for (int r = 0; r < 16; ++r) { const int qr = (r & 3) + 8 * (r >> 2) + 4 * hh_e; const float i1 = lw[qr], i2 = lw[32 + qr]; float s = 0.f;
#pragma unroll
        for (int c = 0; c < 4; ++c) { const float o = o1[c][r] * i1 - o2[c][r] * i2; o1[c][r] = o; s += o * o; }
        ssq[r] = s; }
#pragma unroll
    for (int r = 0; r < 16; ++r) { float s = ssq[r]; s += swz_xor<1>(s); s += swz_xor<2>(s); s += swz_xor<4>(s); s += swz_xor<8>(s); s += swz_xor<16>(s); ssq[r] = 0.8f / sqrtf(s * (1.0f / 128.0f) + EPS); }
    LAS bf16* stg = (LAS bf16*)(lds + LDS_STG) + wid * 4096;
    float gn[4];
#pragma unroll
    for (int c = 0; c < 4; ++c) gn[c] = gain[32 * c + r32_e];
#pragma unroll
    for (int r = 0; r < 16; ++r) { const int qr = (r & 3) + 8 * (r >> 2) + 4 * hh_e;
#pragma unroll
        for (int c = 0; c < 4; ++c) stg[qr * 128 + 32 * c + r32_e] = (bf16)f2bf(o1[c][r] * ssq[r] * gn[c]); }
    asm volatile("s_waitcnt lgkmcnt(0)" ::: "memory");
    bf16* og = (bf16*)(ws + WS_ODA) + ((size_t)(bh >> 2) * 4096 + qb * 256 + wid * 32) * 512 + 128 * (bh & 3);
#pragma unroll
    for (int i = 0; i < 8; ++i) { const int row = i * 4 + (lane_e >> 4), chk = lane_e & 15; *(v4u*)(og + (size_t)row * 512 + chk * 8) = *(const LAS v4u*)(stg + row * 128 + chk * 8); }
    asm volatile("s_waitcnt vmcnt(0) lgkmcnt(0)\n\ts_barrier" ::: "memory");
#undef ATT_DMA_K
#undef ATT_DMA_V
}
__device__ __forceinline__ void attn_phase(unsigned char* ws, LAS unsigned char* lds, int vcu, int G, const float* gain) {
    const float* sm = (const float*)(ws + WS_SMALL);
    const float lam = __uint_as_float(__builtin_amdgcn_readfirstlane(__float_as_uint(sm[512]))), mshift = __uint_as_float(__builtin_amdgcn_readfirstlane(__float_as_uint(sm[513])));
    for (int p = vcu; p < 256; p += G) {
        const int bh = p >> 3, s = p & 7;
        for (int uu = 0; uu < 2; ++uu) attn_unit(bh, uu ? s : 15 - s, ws, lds, mshift, lam, gain);
    }
}
}

namespace hg {
constexpr int L_HQ = 0, L_HF = 16384, L_HI = 32768, L_HOG = 49152, L_QD = 65536, L_ST = 81920, L_O = 114688, L_PS = 147456;
#define HG_MFMA(a, b, c) __builtin_amdgcn_mfma_f32_32x32x16_bf16((a), (b), (c), 0, 0, 0)
__device__ __forceinline__ void dma16k(const unsigned char* g, LAS unsigned char* l, int wid, int lane) {
    __builtin_amdgcn_global_load_lds((const unsigned*)(g + wid * 1024 + lane * 16), (LAS unsigned*)(l + wid * 1024), 16, 0, 0);
    __builtin_amdgcn_global_load_lds((const unsigned*)(g + 8192 + wid * 1024 + lane * 16), (LAS unsigned*)(l + 8192 + wid * 1024), 16, 0, 0);
}
__device__ __forceinline__ bf16x8 trfrag(const LAS unsigned char* base, unsigned tv0, unsigned tv1, int c, int ks) {
    const s16x4 lo = att::vtr(base + tv0 + 4096 * ks + 512 * c), hi = att::vtr(base + tv1 + 4096 * ks + 512 * c);
    return __builtin_shufflevector(lo, hi, 0, 1, 2, 3, 4, 5, 6, 7);
}
__device__ __forceinline__ void tr3_asm(bf16x8& f0, bf16x8& f1, bf16x8& f2, unsigned a00, unsigned a01, unsigned a10, unsigned a11, unsigned a20, unsigned a21) {
    s16x4 l0, h0, l1, h1, l2, h2;
    asm volatile("ds_read_b64_tr_b16 %0, %6\n\tds_read_b64_tr_b16 %1, %7\n\tds_read_b64_tr_b16 %2, %8\n\tds_read_b64_tr_b16 %3, %9\n\tds_read_b64_tr_b16 %4, %10\n\tds_read_b64_tr_b16 %5, %11\n\ts_waitcnt lgkmcnt(0)"
                 : "=&v"(l0), "=&v"(h0), "=&v"(l1), "=&v"(h1), "=&v"(l2), "=&v"(h2) : "v"(a00), "v"(a01), "v"(a10), "v"(a11), "v"(a20), "v"(a21) : "memory");
    f0 = __builtin_shufflevector(l0, h0, 0, 1, 2, 3, 4, 5, 6, 7); f1 = __builtin_shufflevector(l1, h1, 0, 1, 2, 3, 4, 5, 6, 7); f2 = __builtin_shufflevector(l2, h2, 0, 1, 2, 3, 4, 5, 6, 7);
}
__device__ __forceinline__ void tr2_asm(bf16x8& f0, bf16x8& f1, unsigned a00, unsigned a01, unsigned a10, unsigned a11) {
    s16x4 l0, h0, l1, h1;
    asm volatile("ds_read_b64_tr_b16 %0, %4\n\tds_read_b64_tr_b16 %1, %5\n\tds_read_b64_tr_b16 %2, %6\n\tds_read_b64_tr_b16 %3, %7\n\ts_waitcnt lgkmcnt(0)"
                 : "=&v"(l0), "=&v"(h0), "=&v"(l1), "=&v"(h1) : "v"(a00), "v"(a01), "v"(a10), "v"(a11) : "memory");
    f0 = __builtin_shufflevector(l0, h0, 0, 1, 2, 3, 4, 5, 6, 7); f1 = __builtin_shufflevector(l1, h1, 0, 1, 2, 3, 4, 5, 6, 7);
}
__device__ __forceinline__ bf16x8 rowfrag(const LAS unsigned char* base, unsigned kr0, unsigned kr1, int rblk, int s) {
    return *(const LAS bf16x8*)(base + 8192 * rblk + ((s & 1) ? kr1 : kr0) + 512 * (s >> 1));
}
__device__ __forceinline__ bf16x8 pack_lo(const f32x16& p) { v4u w; w.x = cvtpk(p[0], p[1]); w.y = cvtpk(p[2], p[3]); w.z = cvtpk(p[4], p[5]); w.w = cvtpk(p[6], p[7]); return __builtin_bit_cast(bf16x8, w); }
__device__ __forceinline__ bf16x8 pack_hi(const f32x16& p) { v4u w; w.x = cvtpk(p[8], p[9]); w.y = cvtpk(p[10], p[11]); w.z = cvtpk(p[12], p[13]); w.w = cvtpk(p[14], p[15]); return __builtin_bit_cast(bf16x8, w); }

__device__ __forceinline__ void b1_group(int bh, int s8, unsigned char* ws, LAS unsigned char* lds) {
    int tid = tid_x(); asm volatile("" : "+v"(tid));
    const int lane = tid & 63, wid = __builtin_amdgcn_readfirstlane(tid >> 6), r32 = lane & 31, hh = lane >> 5;
    const int k2 = lane;
    const float lb0 = ((const float*)(ws + WS_SMALL))[128 * (bh & 3) + 2 * k2], lb1 = ((const float*)(ws + WS_SMALL))[128 * (bh & 3) + 2 * k2 + 1];
    LAS float* ps = (LAS float*)(lds + L_PS);
    const unsigned tq = ((unsigned)lane & 15u) >> 2, tp = (unsigned)lane & 3u, tblk = ((unsigned)lane >> 4) & 1u;
    const unsigned tvb = 2048u * hh + 64u * tq + 8u * (tp & 1u), tvx = (2u * tblk + (tp >> 1)) ^ (2u * hh);
    const unsigned tv0 = tvb + 16u * tvx, tv1 = tvb + 256u + 16u * (tvx ^ 1u);
    const int kb = wid >> 1, vb0 = 2 * (wid & 1);
    { const int item = bh * 64 + s8; dma16k(ws + WS_HF + ((size_t)item << 14), lds, wid, lane); dma16k(ws + WS_HI + ((size_t)item << 14), lds + 16384, wid, lane); }
    for (int j = 0; j < 8; ++j) {
        const int item = bh * 64 + s8 + 8 * j; LAS unsigned char* B = lds + (j & 1) * 32768;
        if (j + 1 < 8) { LAS unsigned char* Bn = lds + ((j + 1) & 1) * 32768; dma16k(ws + WS_HF + ((size_t)(item + 8) << 14), Bn, wid, lane); dma16k(ws + WS_HI + ((size_t)(item + 8) << 14), Bn + 16384, wid, lane);
            asm volatile("s_waitcnt vmcnt(4)\n\ts_barrier" ::: "memory"); }
        else asm volatile("s_waitcnt vmcnt(0)\n\ts_barrier" ::: "memory");
        float f0[8], f1[8], c0[8], c1[8]; float r0 = 0.f, r1 = 0.f;
#pragma unroll
        for (int i = 0; i < 8; ++i) { const unsigned w = *(const LAS unsigned*)(B + img_off_a(8 * wid + i, 2 * k2));
            const float h0 = __uint_as_float(w << 16), h1 = __uint_as_float(w & 0xffff0000u);
            f0[i] = lb0 + (1.0f - lb0) * rcpf_(1.0f + __expf(-h0)); f1[i] = lb1 + (1.0f - lb1) * rcpf_(1.0f + __expf(-h1));
            r0 += __logf(f0[i]); r1 += __logf(f1[i]); c0[i] = r0; c1[i] = r1; }
        *(LAS f32x2*)(ps + wid * 128 + 2 * k2) = (f32x2){r0, r1};
        asm volatile("s_waitcnt lgkmcnt(0)\n\ts_barrier" ::: "memory");
        float base0 = 0.f, base1 = 0.f, tot0 = 0.f, tot1 = 0.f;
#pragma unroll
        for (int w = 0; w < 8; ++w) { const f32x2 p = *(const LAS f32x2*)(ps + w * 128 + 2 * k2); if (w < wid) { base0 += p[0]; base1 += p[1]; } tot0 += p[0]; tot1 += p[1]; }
#pragma unroll
        for (int i = 0; i < 8; ++i) { const float b0 = base0 + c0[i], b1 = base1 + c1[i];
            *(LAS unsigned*)(B + img_off_a(8 * wid + i, 2 * k2)) = cvtpk((1.0f - f0[i]) * __expf(tot0 - b0), (1.0f - f1[i]) * __expf(tot1 - b1)); }
        if (wid == 0) *(f32x2*)((float*)(ws + WS_DECAY) + (size_t)item * 128 + 2 * k2) = (f32x2){__expf(tot0), __expf(tot1)};
        asm volatile("s_waitcnt lgkmcnt(0)\n\ts_barrier" ::: "memory");
        f32x16 a0, a1;
#pragma unroll
        for (int r = 0; r < 16; ++r) { a0[r] = 0.f; a1[r] = 0.f; }
        const unsigned bA = (unsigned)(uintptr_t)B, bI = bA + 16384u;
#pragma unroll
        for (int ks = 0; ks < 4; ++ks) { bf16x8 A, B0, B1;
            tr3_asm(A, B0, B1, bA + tv0 + 4096 * ks + 512 * kb, bA + tv1 + 4096 * ks + 512 * kb, bI + tv0 + 4096 * ks + 512 * vb0, bI + tv1 + 4096 * ks + 512 * vb0, bI + tv0 + 4096 * ks + 512 * (vb0 + 1), bI + tv1 + 4096 * ks + 512 * (vb0 + 1));
            a0 = HG_MFMA(A, B0, a0); a1 = HG_MFMA(A, B1, a1); }
        unsigned char* dst = ws + WS_DST + ((size_t)item << 15);
#pragma unroll
        for (int g = 0; g < 4; ++g) { const unsigned k0 = 32u * kb + 8u * g + 4u * hh;
            *(v2u*)(dst + off_a(32u * vb0 + r32, k0 >> 3) + (k0 & 7u) * 2u) = (v2u){cvtpk(a0[4 * g], a0[4 * g + 1]), cvtpk(a0[4 * g + 2], a0[4 * g + 3])};
            *(v2u*)(dst + off_a(32u * (vb0 + 1) + r32, k0 >> 3) + (k0 & 7u) * 2u) = (v2u){cvtpk(a1[4 * g], a1[4 * g + 1]), cvtpk(a1[4 * g + 2], a1[4 * g + 3])}; }
        asm volatile("s_waitcnt lgkmcnt(0)\n\ts_barrier" ::: "memory");
    }
}

__device__ __forceinline__ void scan_slice(unsigned char* ws, int bh, int e) {
    const unsigned pos = 8u * (unsigned)e;
    const unsigned row = 8u * (pos >> 11) + ((pos >> 6) & 7u), ch = 4u * ((pos >> 9) & 3u) + (((pos >> 4) & 3u) ^ ((row >> 2) & 3u)), k0 = 8u * ch + 4u * ((pos >> 3) & 1u);
    unsigned char* img = ws + WS_DST + ((size_t)bh << 21) + pos; const float* dec = (const float*)(ws + WS_DECAY) + (size_t)bh * 64 * 128 + k0;
    float S0 = 0.f, S1 = 0.f, S2 = 0.f, S3 = 0.f;
    for (int c0 = 0; c0 < 64; c0 += 8) {
        v2u d[8]; f32x4 dc[8];
#pragma unroll
        for (int j = 0; j < 8; ++j) { d[j] = *(const v2u*)(img + ((size_t)(c0 + j) << 15)); dc[j] = *(const f32x4*)(dec + (c0 + j) * 128); }
#pragma unroll
        for (int j = 0; j < 8; ++j) {
            *(v2u*)(img + ((size_t)(c0 + j) << 15)) = (v2u){cvtpk(S0, S1), cvtpk(S2, S3)};
            S0 = dc[j][0] * S0 + __uint_as_float(d[j].x << 16); S1 = dc[j][1] * S1 + __uint_as_float(d[j].x & 0xffff0000u);
            S2 = dc[j][2] * S2 + __uint_as_float(d[j].y << 16); S3 = dc[j][3] * S3 + __uint_as_float(d[j].y & 0xffff0000u);
        }
    }
}
__device__ __forceinline__ void group_barrier(unsigned* w, unsigned target) {
    asm volatile("s_waitcnt vmcnt(0)" ::: "memory");
    __syncthreads();
    if (tid_x() == 0) {
        __builtin_amdgcn_fence(__ATOMIC_RELEASE, "agent");
        asm volatile("s_waitcnt vmcnt(0)" ::: "memory");
        __hip_atomic_fetch_add(w, 1u, __ATOMIC_RELAXED, __HIP_MEMORY_SCOPE_AGENT);
        unsigned sp = 0;
        while (__hip_atomic_load(w, __ATOMIC_RELAXED, __HIP_MEMORY_SCOPE_AGENT) < target) { __builtin_amdgcn_s_sleep(2); if (++sp > (1u << 22)) break; }
        __builtin_amdgcn_fence(__ATOMIC_ACQUIRE, "agent");
        asm volatile("s_waitcnt vmcnt(0)" ::: "memory");
    }
    __syncthreads();
}

__device__ __forceinline__ void b3_group(int bh, int s8, unsigned char* ws, LAS unsigned char* lds, const float* gain) {
    constexpr int B_HQ = 0, B_HF = 16384, B_QD = 32768, B_HI = 49152, B_ST = 81920, B_O = 0;
    int tid = tid_x(); asm volatile("" : "+v"(tid));
    const int lane = tid & 63, wid = __builtin_amdgcn_readfirstlane(tid >> 6), r32 = lane & 31, hh = lane >> 5;
    const int k2 = lane;
    const float lb0 = ((const float*)(ws + WS_SMALL))[128 * (bh & 3) + 2 * k2], lb1 = ((const float*)(ws + WS_SMALL))[128 * (bh & 3) + 2 * k2 + 1];
    LAS float* ps = (LAS float*)(lds + L_PS);
    const unsigned krb = 2048u * ((unsigned)r32 >> 3) + 64u * ((unsigned)r32 & 7u), krs = ((unsigned)r32 >> 2) & 3u;
    const unsigned kr0 = krb + 16u * (hh ^ krs), kr1 = krb + 16u * ((2u + hh) ^ krs);
    const unsigned tq = ((unsigned)lane & 15u) >> 2, tp = (unsigned)lane & 3u, tblk = ((unsigned)lane >> 4) & 1u;
    const unsigned tvb = 2048u * hh + 64u * tq + 8u * (tp & 1u), tvx = (2u * tblk + (tp >> 1)) ^ (2u * hh);
    const unsigned tv0 = tvb + 16u * tvx, tv1 = tvb + 256u + 16u * (tvx ^ 1u);
    const int tb = wid >> 2, vb = wid & 3;
    const int erow = tid >> 3, seg = tid & 7;
    const f32x4 n0 = ((const f32x4*)(gain + 16 * seg))[0], n1 = ((const f32x4*)(gain + 16 * seg))[1], n2 = ((const f32x4*)(gain + 16 * seg))[2], n3 = ((const f32x4*)(gain + 16 * seg))[3];
    { const int item = bh * 64 + s8;
      dma16k(ws + WS_HI + ((size_t)item << 14), lds + B_HI, wid, lane);
      dma16k(ws + WS_DST + ((size_t)item << 15), lds + B_ST, wid, lane); dma16k(ws + WS_DST + ((size_t)item << 15) + 16384, lds + B_ST + 16384, wid, lane); }
    for (int j = 0; j < 8; ++j) {
        const int item = bh * 64 + s8 + 8 * j, bb = j & 1;
        dma16k(ws + WS_HQ + ((size_t)item << 14), lds + B_HQ, wid, lane);
        dma16k(ws + WS_HF + ((size_t)item << 14), lds + B_HF, wid, lane);
        if (j + 1 < 8) { const int nb = bb ^ 1;
            dma16k(ws + WS_HI + ((size_t)(item + 8) << 14), lds + B_HI + nb * 16384, wid, lane);
            dma16k(ws + WS_DST + ((size_t)(item + 8) << 15), lds + B_ST + nb * 32768, wid, lane); dma16k(ws + WS_DST + ((size_t)(item + 8) << 15) + 16384, lds + B_ST + nb * 32768 + 16384, wid, lane); }
        const unsigned char* hogp = ws + WS_HOG + ((size_t)item << 14);
        const v4u g0 = *(const v4u*)(hogp + off_a((unsigned)erow, 2u * seg)), g1 = *(const v4u*)(hogp + off_a((unsigned)erow, 2u * seg + 1u));
        if (j + 1 < 8) asm volatile("s_waitcnt vmcnt(8)\n\ts_barrier" ::: "memory"); else asm volatile("s_waitcnt vmcnt(2)\n\ts_barrier" ::: "memory");
        {
            float f0[8], f1[8], c0[8], c1[8]; float r0 = 0.f, r1 = 0.f;
#pragma unroll
            for (int i = 0; i < 8; ++i) { const unsigned w = *(const LAS unsigned*)(lds + B_HF + img_off_a(8 * wid + i, 2 * k2));
                const float h0 = __uint_as_float(w << 16), h1 = __uint_as_float(w & 0xffff0000u);
                f0[i] = lb0 + (1.0f - lb0) * rcpf_(1.0f + __expf(-h0)); f1[i] = lb1 + (1.0f - lb1) * rcpf_(1.0f + __expf(-h1));
                r0 += __logf(f0[i]); r1 += __logf(f1[i]); c0[i] = r0; c1[i] = r1; }
            *(LAS f32x2*)(ps + wid * 128 + 2 * k2) = (f32x2){r0, r1};
            asm volatile("s_waitcnt lgkmcnt(0)\n\ts_barrier" ::: "memory");
            float base0 = 0.f, base1 = 0.f, ref0 = 0.f, ref1 = 0.f;
#pragma unroll
            for (int w = 0; w < 7; ++w) { const f32x2 p = *(const LAS f32x2*)(ps + w * 128 + 2 * k2); if (w < wid) { base0 += p[0]; base1 += p[1]; } if (w < 4) { ref0 += p[0]; ref1 += p[1]; } }
#pragma unroll
            for (int i = 0; i < 8; ++i) { const unsigned row = 8u * wid + i; const float b0 = base0 + c0[i], b1 = base1 + c1[i];
                const unsigned qw = *(const LAS unsigned*)(lds + B_HQ + img_off_a(row, 2 * k2));
                const float q0 = __uint_as_float(qw << 16), q1 = __uint_as_float(qw & 0xffff0000u);
                *(LAS unsigned*)(lds + B_HQ + img_off_a(row, 2 * k2)) = cvtpk(q0 * __expf(b0 - ref0), q1 * __expf(b1 - ref1));
                *(LAS unsigned*)(lds + B_QD + img_off_a(row, 2 * k2)) = cvtpk(q0 * __expf(b0), q1 * __expf(b1));
                *(LAS unsigned*)(lds + B_HF + img_off_a(kappa(row), 2 * k2)) = cvtpk((1.0f - f0[i]) * __expf(ref0 - b0), (1.0f - f1[i]) * __expf(ref1 - b1)); }
        }
        asm volatile("s_waitcnt lgkmcnt(0)\n\ts_barrier" ::: "memory");
        f32x16 o;
#pragma unroll
        for (int r = 0; r < 16; ++r) o[r] = 0.f;
        const int tcol = 32 * tb + r32;
        const unsigned bI = (unsigned)(uintptr_t)(lds + B_HI + bb * 16384);
        {
            f32x16 p;
#pragma unroll
            for (int r = 0; r < 16; ++r) p[r] = 0.f;
#pragma unroll
            for (int sI = 0; sI < 8; ++sI) p = HG_MFMA(rowfrag(lds + B_HF, kr0, kr1, 0, sI), rowfrag(lds + B_HQ, kr0, kr1, tb, sI), p);
#pragma unroll
            for (int r = 0; r < 16; ++r) { const int srel = (r & 7) + 8 * hh + 16 * (r >> 3); if (srel > tcol) p[r] = 0.f; }
            bf16x8 v0, v1; tr2_asm(v0, v1, bI + tv0 + 512 * vb, bI + tv1 + 512 * vb, bI + tv0 + 4096 + 512 * vb, bI + tv1 + 4096 + 512 * vb);
            o = HG_MFMA(pack_lo(p), v0, o); o = HG_MFMA(pack_hi(p), v1, o);
        }
        if (tb == 1) {
            f32x16 p;
#pragma unroll
            for (int r = 0; r < 16; ++r) p[r] = 0.f;
#pragma unroll
            for (int sI = 0; sI < 8; ++sI) p = HG_MFMA(rowfrag(lds + B_HF, kr0, kr1, 1, sI), rowfrag(lds + B_HQ, kr0, kr1, 1, sI), p);
#pragma unroll
            for (int r = 0; r < 16; ++r) { const int srel = 32 + (r & 7) + 8 * hh + 16 * (r >> 3); if (srel > tcol) p[r] = 0.f; }
            bf16x8 v0, v1; tr2_asm(v0, v1, bI + tv0 + 8192 + 512 * vb, bI + tv1 + 8192 + 512 * vb, bI + tv0 + 12288 + 512 * vb, bI + tv1 + 12288 + 512 * vb);
            o = HG_MFMA(pack_lo(p), v0, o); o = HG_MFMA(pack_hi(p), v1, o);
        }
#pragma unroll
        for (int sI = 0; sI < 8; ++sI) o = HG_MFMA(rowfrag(lds + B_QD, kr0, kr1, tb, sI), rowfrag(lds + B_ST + bb * 32768, kr0, kr1, vb, sI), o);
        asm volatile("s_waitcnt lgkmcnt(0)\n\ts_barrier" ::: "memory");
        LAS float* O = (LAS float*)(lds + B_O);
#pragma unroll
        for (int r = 0; r < 16; ++r) O[(32 * tb + (r & 3) + 8 * (r >> 2) + 4 * hh) * 128 + 32 * vb + r32] = o[r];
        asm volatile("s_waitcnt lgkmcnt(0)\n\ts_barrier" ::: "memory");
        {
            const LAS f32x4* op = (const LAS f32x4*)(O + erow * 128 + 16 * seg);
            f32x4 v0 = op[0], v1 = op[1], v2 = op[2], v3 = op[3];
            float sq = 0.f;
#pragma unroll
            for (int e = 0; e < 4; ++e) sq += v0[e] * v0[e] + v1[e] * v1[e] + v2[e] * v2[e] + v3[e] * v3[e];
            sq += swz_xor<1>(sq); sq += swz_xor<2>(sq); sq += swz_xor<4>(sq);
            const float rstd = __builtin_amdgcn_rsqf(sq * (1.0f / 128.0f) + EPS);
            float y[16];
#pragma unroll
            for (int e = 0; e < 4; ++e) { y[e] = v0[e] * n0[e]; y[4 + e] = v1[e] * n1[e]; y[8 + e] = v2[e] * n2[e]; y[12 + e] = v3[e] * n3[e]; }
#pragma unroll
            for (int e = 0; e < 4; ++e) { const float a = __uint_as_float(g0[e] << 16), b = __uint_as_float(g0[e] & 0xffff0000u), c = __uint_as_float(g1[e] << 16), d = __uint_as_float(g1[e] & 0xffff0000u);
                y[2 * e] *= rstd * a * rcpf_(1.0f + __expf(-a)); y[2 * e + 1] *= rstd * b * rcpf_(1.0f + __expf(-b)); y[8 + 2 * e] *= rstd * c * rcpf_(1.0f + __expf(-c)); y[9 + 2 * e] *= rstd * d * rcpf_(1.0f + __expf(-d)); }
            const int c = item & 63;
            bf16* dst = (bf16*)(ws + WS_OHG) + ((size_t)(bh >> 2) * 4096 + 64 * c + erow) * 512 + 128 * (bh & 3) + 16 * seg;
            v4u w0, w1;
            w0.x = cvtpk(y[0], y[1]); w0.y = cvtpk(y[2], y[3]); w0.z = cvtpk(y[4], y[5]); w0.w = cvtpk(y[6], y[7]);
            w1.x = cvtpk(y[8], y[9]); w1.y = cvtpk(y[10], y[11]); w1.z = cvtpk(y[12], y[13]); w1.w = cvtpk(y[14], y[15]);
            *(v4u*)dst = w0; *(v4u*)(dst + 8) = w1;
        }
        asm volatile("s_waitcnt lgkmcnt(0)\n\ts_barrier" ::: "memory");
    }
}
}

__global__ void __launch_bounds__(NWAVES * 64, 2) mega(Args args) {
    LAS unsigned char* lds = (LAS unsigned char*)lds_raw;
    volatile LAS unsigned* MISC = (volatile LAS unsigned*)(lds + MISC_OFF);
    { const int t0_ = threadIdx.x; if ((t0_ & 63) == 0) *(volatile LAS int*)(lds + MISC_OFF + 256 + 4 * ((unsigned)__builtin_amdgcn_s_getreg((5 << 11) | 4) & 63u)) = t0_ >> 6; if (t0_ < 64) MISC[t0_] = 0u; }
    __syncthreads();
    const int wave = wave_idx();
    const int G = gridDim.x; const int bx = blockIdx.x; const int vcu = (G % 8 == 0) ? (bx % 8) * (G / 8) + bx / 8 : bx;
    unsigned char* ws = args.ws;
    const int lo = args.ph_lo, hi = args.ph_hi;
    XcdBarrier bar; bar.bar = (unsigned*)(ws + WS_CTL) + CW_BAR + args.li * XCD_BAR_WORDS; bar.x = 0; bar.st = nullptr;
    if (hi - lo > 1) bar = xcd_barrier_post((unsigned*)(ws + WS_CTL) + CW_BAR + args.li * XCD_BAR_WORDS, MISC + 8);
#define IN(k) (lo <= (k) && (k) < hi)
#define BOTH(k) (IN(k) && IN((k) + 1))
    if (IN(0)) { p0_prologue(args, lds, vcu, G, wave, (int)lane_id()); if (BOTH(0)) xcd_barrier(bar); }
    if (IN(1)) {
        pg8::DenseOrder S; S.init(ws + WS_H, ws + WS_WIN, NT, NCOLS, DM, G, bx);
        EpiProj E{ws, (bf16*)args.out, args.in[5], args.in[6]};
        pg8::gemm_phase<EpiProj, pg8::DenseOrder, true>(lds + RING_OFF, DM, S, E);
        if (BOTH(1)) xcd_barrier(bar);
    }
    if (IN(2)) {
        const int bh = vcu >> 3, s8 = vcu & 7; unsigned* gw = (unsigned*)(ws + WS_CTL) + CW_GRP + bh * 64;
        if (G != 256) { if (tid_x() == 0) __hip_atomic_store((unsigned*)(ws + WS_CTL) + CW_BAR + XB_TMO, 0x7f0u, __ATOMIC_RELAXED, __HIP_MEMORY_SCOPE_AGENT); }
        if (bh & 1) att::attn_phase(ws, lds, vcu, G, args.in[8]);
        w13_convert(args, lds, vcu, G, wave, (int)lane_id()); __syncthreads();
        hg::b1_group(bh, s8, ws, lds);
        hg::group_barrier(gw, 8u);
        hg::scan_slice(ws, bh, s8 * 512 + tid_x());
        hg::group_barrier(gw, 16u);
        hg::b3_group(bh, s8, ws, lds, args.in[4]);
        if (!(bh & 1)) att::attn_phase(ws, lds, vcu, G, args.in[8]);
        if (BOTH(2)) xcd_barrier(bar);
    }
    if (IN(5)) {
        BranchOrder S; S.d.init(ws + WS_OHG, ws + WS_WHG, NT, DM, 512, G, bx); S.A2 = (const char*)(ws + WS_ODA); S.B2 = (const char*)(ws + WS_WDA);
        EpiBranch E{(const bf16*)args.out, (bf16*)(ws + WS_MIXED)};
        pg8::gemm_phase<EpiBranch, BranchOrder, true>(lds + RING_OFF, 512, S, E);
        if (BOTH(5)) xcd_barrier(bar);
    }
    if (IN(6)) {
        pg8::DenseOrder S; S.init(ws + WS_MIXED, ws + WS_WOUT, NT, DM, DM, G, bx);
        EpiOut E{args.in[0], (bf16*)(ws + WS_X1B)};
        pg8::gemm_phase<EpiOut, pg8::DenseOrder, true>(lds + RING_OFF, DM, S, E);
        if (BOTH(6)) xcd_barrier(bar);
    }
    if (IN(7)) { router_phase(args, lds, G, wave, (int)lane_id()); if (BOTH(7)) xcd_barrier(bar); }
    if (IN(8)) {
        moe_sched_setup(args, lds);
        const LAS int* pref = (const LAS int*)(lds + SCHED_OFF); const LAS int* cnt = pref + 80;
        MoeOrderT<1> S{pref, cnt, (const v2u*)(ws + WS_ROWTOK), (const char*)(ws + WS_XN), (const char*)(ws + WS_W13T), DM / 2, (size_t)DM * DM, 1, 0, 64, 4, G, bx};
        EpiUp E{pref, cnt, ws + WS_HID};
        pg8::gemm_phase<EpiUp, MoeOrderT<1>, true, true, 122>(lds + RING_OFF, DM / 2, S, E);
        if (BOTH(8)) xcd_barrier(bar);
    }
    if (IN(9)) {
        moe_sched_setup(args, lds);
        const LAS int* pref = (const LAS int*)(lds + SCHED_OFF); const LAS int* cnt = pref + 80;
        MoeOrderT<0> S{pref, cnt, (const v2u*)(ws + WS_ROWTOK), (const char*)(ws + WS_HID), (const char*)(ws + WS_W2T), DFF / 2, (size_t)DM * DFF, 0, 0, 64, 4, G, bx};
        EpiDown E{pref, cnt, (bf16*)(ws + WS_YS)};
        pg8::gemm_phase<EpiDown, MoeOrderT<0>, true, true, 123>(lds + RING_OFF, DFF / 2, S, E);
        if (BOTH(9)) xcd_barrier(bar);
    }
    if (IN(10)) {
        moe_sched_setup(args, lds);
        const LAS int* pref = (const LAS int*)(lds + SCHED_OFF);
        float* out = args.out; const bf16* y = (const bf16*)(ws + WS_YS); const v2u* tp = (const v2u*)(ws + WS_TOKPOS); const bf16* x1b = (const bf16*)(ws + WS_X1B);
        for (int i = bx * 512 + tid_x(); i < NT * (DM / 8); i += G * 512) {
            const int t = i >> 7, c = (i & 127) * 8;
            const v2u p0 = tp[2 * (size_t)t], p1 = tp[2 * (size_t)t + 1];
            const size_t r0 = (size_t)(pref[p0.x >> 16] * 256 + (int)(p0.x & 0xffffu)), r1 = (size_t)(pref[p1.x >> 16] * 256 + (int)(p1.x & 0xffffu));
            const float w0 = __uint_as_float(p0.y), w1 = __uint_as_float(p1.y);
            f32x4* op = (f32x4*)(out + (size_t)t * DM + c);
            const v4u y0 = *(const v4u*)(y + r0 * DM + c), y1 = *(const v4u*)(y + r1 * DM + c), xb = *(const v4u*)(x1b + (size_t)t * DM + c);
            f32x4 a0, a1;
            a0[0] = __uint_as_float(xb.x << 16) + w0 * __uint_as_float(y0.x << 16) + w1 * __uint_as_float(y1.x << 16); a0[1] = __uint_as_float(xb.x & 0xffff0000u) + w0 * __uint_as_float(y0.x & 0xffff0000u) + w1 * __uint_as_float(y1.x & 0xffff0000u);
            a0[2] = __uint_as_float(xb.y << 16) + w0 * __uint_as_float(y0.y << 16) + w1 * __uint_as_float(y1.y << 16); a0[3] = __uint_as_float(xb.y & 0xffff0000u) + w0 * __uint_as_float(y0.y & 0xffff0000u) + w1 * __uint_as_float(y1.y & 0xffff0000u);
            a1[0] = __uint_as_float(xb.z << 16) + w0 * __uint_as_float(y0.z << 16) + w1 * __uint_as_float(y1.z << 16); a1[1] = __uint_as_float(xb.z & 0xffff0000u) + w0 * __uint_as_float(y0.z & 0xffff0000u) + w1 * __uint_as_float(y1.z & 0xffff0000u);
            a1[2] = __uint_as_float(xb.w << 16) + w0 * __uint_as_float(y0.w << 16) + w1 * __uint_as_float(y1.w << 16); a1[3] = __uint_as_float(xb.w & 0xffff0000u) + w0 * __uint_as_float(y0.w & 0xffff0000u) + w1 * __uint_as_float(y1.w & 0xffff0000u);
            op[0] = a0; op[1] = a1;
        }
    }
#undef IN
#undef BOTH
}

extern "C" void kernel_launch(void* const* d_in, const int* in_sizes, int n_in, void* d_out, int out_size, void* d_ws, size_t ws_size, hipStream_t stream) {
    static int grid = 0;
    if (grid == 0) {
        if (n_in != 20 || out_size != NT * DM || ws_size < WS_END) { fprintf(stderr, "kernel_launch: unexpected shapes (n_in %d out %d ws %zu)\n", n_in, out_size, ws_size); grid = -1; return; }
        int dev = 0, cus = 0, per_cu = 0;
        if (hipGetDevice(&dev) != hipSuccess || hipDeviceGetAttribute(&cus, hipDeviceAttributeMultiprocessorCount, dev) != hipSuccess) { grid = -1; return; }
        if (hipFuncSetAttribute((const void*)mega, hipFuncAttributeMaxDynamicSharedMemorySize, LDS_BYTES) != hipSuccess) { fprintf(stderr, "kernel_launch: hipFuncSetAttribute failed\n"); grid = -1; return; }
        if (hipOccupancyMaxActiveBlocksPerMultiprocessor(&per_cu, (const void*)mega, NWAVES * 64, LDS_BYTES) != hipSuccess || per_cu < 1) fprintf(stderr, "kernel_launch: occupancy query says %d\n", per_cu);
        (void)hipGetLastError();
        grid = cus;
    }
    if (grid < 0) return;
    (void)hipMemsetAsync((char*)d_ws + WS_CTL, 0, CTL_ZERO_BYTES, stream);
    Args a{};
    for (int i = 0; i < 20; ++i) a.in[i] = (const float*)d_in[i];
    a.out = (float*)d_out; a.ws = (unsigned char*)d_ws;
    unsigned char* ws = (unsigned char*)d_ws;
    a.ph_lo = 0; a.ph_hi = 11; a.li = 0; hipLaunchKernelGGL(mega, dim3(grid), dim3(NWAVES * 64), LDS_BYTES, stream, a);
}
```

```cpp
#include <hip/hip_runtime.h>
#include <cstdio>
#include <cstdint>

#define GAS __attribute__((address_space(1)))
#define LAS __attribute__((address_space(3)))
typedef unsigned short bf16;
typedef unsigned v4u __attribute__((ext_vector_type(4)));
typedef unsigned v2u __attribute__((ext_vector_type(2)));
typedef float f32x4 __attribute__((ext_vector_type(4)));
typedef float f32x2 __attribute__((ext_vector_type(2)));
typedef float f32x16 __attribute__((ext_vector_type(16)));
typedef short bf16x8 __attribute__((ext_vector_type(8)));
typedef short s16x4 __attribute__((ext_vector_type(4)));
typedef __bf16 bf16x2_t __attribute__((ext_vector_type(2)));

constexpr int NB = 8, SEQ = 4096, DM = 1024, NT = NB * SEQ;
constexpr int NCOLS = 5632;
constexpr int NEXP = 32, DFF = 512;
constexpr float EPS = 1e-6f;
constexpr float LOG2E = 1.4426950408889634f;
constexpr int RCAP = NT;

constexpr size_t MiB = 1u << 20;
constexpr size_t WS_CTL = 0, CTL_ZERO_BYTES = 1 * MiB;
constexpr size_t WS_SMALL = 1 * MiB;
constexpr size_t WS_ROPE = 2 * MiB;
constexpr size_t WS_WHG = 3 * MiB, WS_WDA = 4 * MiB, WS_WOUT = 5 * MiB;
constexpr size_t WS_WIN = 7 * MiB;
constexpr size_t WS_W2T = 18 * MiB;
constexpr size_t WS_H = 50 * MiB;
constexpr size_t WS_W13T = WS_H;
constexpr size_t WS_HQ = 114 * MiB, WS_HF = 146 * MiB, WS_HI = 178 * MiB, WS_HOG = 210 * MiB;
constexpr size_t WS_MIXED = 114 * MiB;
constexpr size_t WS_XN = 178 * MiB;
constexpr size_t WS_Y = 114 * MiB;
constexpr size_t WS_YS = 50 * MiB;
constexpr size_t WS_TOKPOS = 322 * MiB;
constexpr size_t WS_QT = 242 * MiB, WS_KIMG = 274 * MiB, WS_VIMG = 306 * MiB;
constexpr size_t WS_HID = 242 * MiB;
constexpr size_t WS_ROWTOK = 306 * MiB;
constexpr size_t WS_WT = 314 * MiB;
constexpr size_t WS_DST = 338 * MiB;
constexpr size_t WS_X1B = 338 * MiB;
constexpr size_t WS_DECAY = 402 * MiB;
constexpr size_t WS_OHG = 403 * MiB, WS_ODA = 435 * MiB;
constexpr size_t WS_END = 467 * MiB;
constexpr int CW_BAR = 4096;
constexpr int CW_GCNT = 16384;
constexpr int CW_GRP = 20480;

__device__ __forceinline__ unsigned f2bf(float f) { unsigned u = __float_as_uint(f); return (u + 0x7fffu + ((u >> 16) & 1u)) >> 16; }
__device__ __forceinline__ float bf2f(unsigned short b) { return __uint_as_float((unsigned)b << 16); }
__device__ __forceinline__ unsigned cvtpk(float lo, float hi) { f32x2 v = {lo, hi}; bf16x2_t b = __builtin_convertvector(v, bf16x2_t); return __builtin_bit_cast(unsigned, b); }
__device__ __forceinline__ v4u pack8(const f32x4 a, const f32x4 b) { v4u w; w.x = cvtpk(a[0], a[1]); w.y = cvtpk(a[2], a[3]); w.z = cvtpk(b[0], b[1]); w.w = cvtpk(b[2], b[3]); return w; }
__host__ __device__ __forceinline__ unsigned off_b(unsigned row, unsigned ch) { return 256u * row + 16u * (ch ^ (((row & 3u) << 2) | ((row >> 2) & 3u))); }
__host__ __device__ __forceinline__ unsigned img_off(unsigned row, unsigned col) { return off_b(row, col >> 3) + (col & 7u) * 2u; }
__host__ __device__ __forceinline__ unsigned off_a(unsigned row, unsigned ch) { return 2048u * (row >> 3) + 512u * (ch >> 2) + 64u * (row & 7u) + 16u * ((ch & 3u) ^ ((row >> 2) & 3u)); }
__host__ __device__ __forceinline__ unsigned img_off_a(unsigned row, unsigned col) { return off_a(row, col >> 3) + (col & 7u) * 2u; }
__host__ __device__ __forceinline__ unsigned kappa(unsigned r) { return (r & ~12u) | ((r & 4u) << 1) | ((r & 8u) >> 1); }
template <int M> __device__ __forceinline__ float swz_xor(float v) { return __int_as_float(__builtin_amdgcn_ds_swizzle(__float_as_int(v), (M << 10) | 0x1f)); }
__device__ __forceinline__ float wave_sum(float v) {
    v += swz_xor<1>(v); v += swz_xor<2>(v); v += swz_xor<4>(v); v += swz_xor<8>(v); v += swz_xor<16>(v);
    { auto rr = __builtin_amdgcn_permlane32_swap(__float_as_uint(v), __float_as_uint(v), false, false); v = __uint_as_float(rr[0]) + __uint_as_float(rr[1]); }
    return v;
}
__device__ __forceinline__ float wave_max(float v) {
    v = fmaxf(v, swz_xor<1>(v)); v = fmaxf(v, swz_xor<2>(v)); v = fmaxf(v, swz_xor<4>(v)); v = fmaxf(v, swz_xor<8>(v)); v = fmaxf(v, swz_xor<16>(v));
    { auto rr = __builtin_amdgcn_permlane32_swap(__float_as_uint(v), __float_as_uint(v), false, false); v = fmaxf(__uint_as_float(rr[0]), __uint_as_float(rr[1])); }
    return v;
}
extern __shared__ __attribute__((aligned(16))) unsigned char lds_raw[];
constexpr int LDS_BYTES = 159744;
constexpr int MISC_OFF = LDS_BYTES - 512;
__device__ __forceinline__ int wave_idx() { const unsigned k = (unsigned)__builtin_amdgcn_s_getreg((5 << 11) | 4) & 63u;
    return __builtin_amdgcn_readfirstlane(*(volatile LAS int*)((LAS unsigned char*)lds_raw + MISC_OFF + 256 + 4 * k)); }
__device__ __forceinline__ unsigned lane_id() { unsigned l; asm volatile("v_mbcnt_lo_u32_b32 %0, -1, 0\n\tv_mbcnt_hi_u32_b32 %0, -1, %0" : "=v"(l)); return l; }
__device__ __forceinline__ int tid_x() { return wave_idx() * 64 + (int)lane_id(); }
typedef int v8i __attribute__((ext_vector_type(8)));
typedef int v4i __attribute__((ext_vector_type(4)));
__device__ __forceinline__ unsigned pk4_fp8(float a, float b, float c, float d) { int p = __builtin_amdgcn_cvt_pk_fp8_f32(a, b, 0, false); p = __builtin_amdgcn_cvt_pk_fp8_f32(c, d, p, true); return (unsigned)p; }
__device__ __forceinline__ float rcpf_(float x) { return __builtin_amdgcn_rcpf(x); }
__device__ __forceinline__ float sigmoidf_(float x) { return rcpf_(1.0f + __expf(-x)); }

#define XB_TMO      128
#define XB_XCNT(j)  (256  + 64 * (j))
#define XB_XSUB(j)  (1280 + 64 * (j))
#define XB_XGEN(j)  (2304 + 64 * (j))
#define XB_TOP      3328
#define XB_TOPGEN   3392
#define XCD_BAR_WORDS 3456
#define XB_SPIN_CAP (1u << 18)
__device__ __forceinline__ unsigned xb_ld(unsigned* p)              { return __hip_atomic_load(p, __ATOMIC_RELAXED, __HIP_MEMORY_SCOPE_AGENT); }
__device__ __forceinline__ unsigned xb_add(unsigned* p, unsigned v) { return __hip_atomic_fetch_add(p, v, __ATOMIC_RELAXED, __HIP_MEMORY_SCOPE_AGENT); }
__device__ __forceinline__ unsigned xb_xcc_id() { return (unsigned)__builtin_amdgcn_s_getreg((3 << 11) | 20) & 0xFu; }
#define XB_SPIN(cond, bar) do { unsigned _sp = 0; while (cond) { __builtin_amdgcn_s_sleep(1); \
    if ((++_sp & 255u) == 0u) { if (xb_ld(&(bar)[XB_TMO])) break; if (_sp > XB_SPIN_CAP) { atomicAdd(&(bar)[XB_TMO], 1u); break; } } } } while (0)
struct XcdBarrier { unsigned* bar; unsigned x; volatile LAS unsigned* st; };
__device__ __forceinline__ XcdBarrier xcd_barrier_post(unsigned* bar, volatile LAS unsigned* st) {
    XcdBarrier b; b.bar = bar; b.x = xb_xcc_id(); b.st = st;
    if (tid_x() == 0) (void)xb_add(&bar[XB_XCNT(b.x)], 1u);
    return b;
}
__device__ __forceinline__ void xcd_barrier_complete(unsigned* bar, unsigned x, unsigned& nloc, unsigned& nx) {
    const unsigned G = gridDim.x * gridDim.y * gridDim.z;
    unsigned sum, cnt, mine, sp = 0u;
    for (;;) {
        sum = 0u; cnt = 0u; mine = 0u;
#pragma unroll
        for (unsigned j = 0; j < 16; ++j) { const unsigned c = xb_ld(&bar[XB_XCNT(j)]); sum += c; cnt += (c > 0u) ? 1u : 0u; mine = (j == x) ? c : mine; }
        if (sum == G) break;
        __builtin_amdgcn_s_sleep(1);
        if ((++sp & 255u) == 0u) { if (xb_ld(&bar[XB_TMO])) break; if (sp > XB_SPIN_CAP) { atomicAdd(&bar[XB_TMO], 1u); break; } }
    }
    nloc = mine > 0u ? mine : 1u; nx = cnt > 0u ? cnt : 1u;
}
__device__ __forceinline__ void xcd_barrier(const XcdBarrier& b) {
    asm volatile("s_waitcnt vmcnt(0)" ::: "memory");
    __syncthreads();
    if (tid_x() == 0) {
        unsigned* bar = b.bar;
        __builtin_amdgcn_s_waitcnt(0);
        unsigned nloc = b.st[0], nx = b.st[1];
        if (nloc == 0u) { xcd_barrier_complete(bar, b.x, nloc, nx); b.st[0] = nloc; b.st[1] = nx; }
        const unsigned old = xb_add(&bar[XB_XSUB(b.x)], 1u);
        const unsigned gen = old / nloc;
        if (old + 1u == (gen + 1u) * nloc) {
            __builtin_amdgcn_fence(__ATOMIC_RELEASE, "agent");
            asm volatile("s_waitcnt vmcnt(0)" ::: "memory");
            const unsigned og = xb_add(&bar[XB_TOP], 1u);
            const unsigned tg = og / nx;
            if (og + 1u == (tg + 1u) * nx) xb_add(&bar[XB_TOPGEN], 1u);
            else XB_SPIN(xb_ld(&bar[XB_TOPGEN]) == tg, bar);
            __builtin_amdgcn_fence(__ATOMIC_ACQUIRE, "agent");
            xb_add(&bar[XB_XGEN(b.x)], 1u);
            asm volatile("s_waitcnt vmcnt(0)" ::: "memory");
        } else {
            XB_SPIN(xb_ld(&bar[XB_XGEN(b.x)]) == gen, bar);
            __builtin_amdgcn_fence(__ATOMIC_ACQUIRE, "agent");
            asm volatile("s_waitcnt vmcnt(0)" ::: "memory");
        }
    }
    __syncthreads();
}

namespace pg8 {
constexpr int BM = 256, BK = 64, HALF = 128, HTB = HALF * BK * 2, STAGE_BYTES = 8 * HTB, NXCD = 8, WGM = 8;
__host__ __device__ __forceinline__ int lds_byte(int r, int c) { const int st = (r >> 4) * 2 + (c >> 5), rr = r & 15, cc = c & 31, ob = rr * 64 + cc * 2; return st * 1024 + (ob ^ (((ob >> 9) & 1) << 5)); }
__host__ __device__ __forceinline__ void stage_rc(int b, int& R, int& C) { const int st = b / 1024, sb = b % 1024, swz = sb ^ (((sb >> 9) & 1) << 5); R = (st >> 1) * 16 + swz / 64; C = (st & 1) * 32 + (swz % 64) / 2; }
__host__ __device__ __forceinline__ int perm32(int rho) { const int n = rho >> 4, i = rho & 15; return 8 * (i >> 2) + 4 * n + (i & 3); }
struct Unit { int pm, pn, aux; };

template <class Epi, class Sched, bool ALIGN_EPI, bool F8 = false, int WSC = 127>
__device__ __forceinline__ void gemm_phase(LAS unsigned char* lds, const int K, const Sched& S, const Epi& E) {
    const int tid = tid_x(), wid = __builtin_amdgcn_readfirstlane(tid >> 6), lane = tid & 63, wr = wid >> 2, wc = wid & 3, fr = lane & 15, fq = lane >> 4;
    const int nt = K / BK;
    int Rr[2], Cc[2]; unsigned voffB[2];
#pragma unroll
    for (int i = 0; i < 2; ++i) { int R, C; stage_rc(tid * 16 + i * 8192, R, C); Rr[i] = R; Cc[i] = C; const int Rb = Epi::PERM ? ((R & ~31) + perm32(R & 31)) : R; voffB[i] = (unsigned)(Rb * K + C) * 2u; }
    const size_t kstep = (size_t)(BK * 2);
    const size_t hstep = (size_t)HALF * K * 2;
    const unsigned ldsw = (unsigned)wid * 1024u;
    const int aoff = lds_byte(wr * 64 + fr, fq * 8), boff = lds_byte(wc * 32 + fr, fq * 8);
#define PG8_SA(b, h) (((b) * 2 + (h)) * HTB)
#define PG8_SB(b, h) ((4 + (b) * 2 + (h)) * HTB)
#define PG8_STAGE(bufoff, gbase, voff) do { _Pragma("unroll") for (int _i = 0; _i < 2; ++_i) \
        __builtin_amdgcn_global_load_lds((const unsigned*)((const char*)(gbase) + (voff)[_i]), (LAS unsigned*)(lds + (bufoff) + ldsw + _i * 8192), 16, 0, 0); } while (0)
#define PG8_LD8(off_) __builtin_shufflevector(*(const LAS v4i*)(lds + (off_)), *(const LAS v4i*)(lds + (off_) + 1024), 0, 1, 2, 3, 4, 5, 6, 7)
#define PG8_LDA(dst, b, h) do { if constexpr (F8) { _Pragma("unroll") for (int m = 0; m < 4; ++m) dst##8[m] = PG8_LD8(PG8_SA(b, h) + aoff + m * 2048); } \
        else { _Pragma("unroll") for (int m = 0; m < 4; ++m) _Pragma("unroll") for (int k = 0; k < 2; ++k) dst[m][k] = *(const LAS bf16x8*)(lds + PG8_SA(b, h) + aoff + m * 2048 + k * 1024); } } while (0)
#define PG8_LDB(dst, b, h) do { if constexpr (F8) { _Pragma("unroll") for (int n = 0; n < 2; ++n) dst##8[n] = PG8_LD8(PG8_SB(b, h) + boff + n * 2048); } \
        else { _Pragma("unroll") for (int n = 0; n < 2; ++n) _Pragma("unroll") for (int k = 0; k < 2; ++k) dst[n][k] = *(const LAS bf16x8*)(lds + PG8_SB(b, h) + boff + n * 2048 + k * 1024); } } while (0)
#define PG8_MMA(ai, bj, At, Bt) do { __builtin_amdgcn_s_setprio(1); \
        if constexpr (F8) { _Pragma("unroll") for (int m = 0; m < 4; ++m) _Pragma("unroll") for (int n = 0; n < 2; ++n) \
            asm volatile("v_mfma_scale_f32_16x16x128_f8f6f4 %0, %1, %2, %0, %3, %4 op_sel_hi:[0,0,0]" : "+v"(acc[ai][bj][m][n]) : "v"(Bt##8[n]), "v"(At##8[m]), "v"(wsc_), "v"(asc_)); } \
        else { _Pragma("unroll") for (int m = 0; m < 4; ++m) _Pragma("unroll") for (int n = 0; n < 2; ++n) _Pragma("unroll") for (int k = 0; k < 2; ++k) \
            acc[ai][bj][m][n] = __builtin_amdgcn_mfma_f32_16x16x32_bf16(Bt[n][k], At[m][k], acc[ai][bj][m][n], 0, 0, 0); } \
        __builtin_amdgcn_s_setprio(0); } while (0)
#define PG8_WAIT_V(n) asm volatile("s_waitcnt vmcnt(" #n ")" ::: "memory")
#define PG8_WAIT_L(n) asm volatile("s_waitcnt lgkmcnt(" #n ")" ::: "memory")
#define PG8_BAR __builtin_amdgcn_s_barrier()
#define PG8_SCHED __builtin_amdgcn_sched_barrier(0)
    Unit cur, nxt; int ui = 0;
    if (!S.next(0, cur)) return;
    f32x4 acc[2][2][4][2];
#pragma unroll
    for (int a = 0; a < 2; ++a)
#pragma unroll
        for (int b = 0; b < 2; ++b)
#pragma unroll
            for (int m = 0; m < 4; ++m)
#pragma unroll
                for (int n = 0; n < 2; ++n) acc[a][b][m][n] = (f32x4){0.f, 0.f, 0.f, 0.f};
    bf16x8 At[4][2], B0[2][2], B1[2][2]; v8i At8[4], B08[2], B18[2];
    int wsc_ = WSC, asc_ = 127; asm volatile("" : "+v"(wsc_), "+v"(asc_));
    const char* cA; const char* cB; unsigned cA0[2], cA1[2];
    S.addr(cur, Rr, Cc, cA, cB, cA0, cA1);
    LAS unsigned* nslot = (LAS unsigned*)(lds + STAGE_BYTES) + tid * 4;
    PG8_STAGE(PG8_SB(0, 0), cB, voffB); PG8_STAGE(PG8_SB(0, 1), cB + hstep, voffB); PG8_STAGE(PG8_SA(0, 0), cA, cA0); PG8_STAGE(PG8_SA(0, 1), cA, cA1);
    if (wr == 1) PG8_BAR;
    PG8_WAIT_V(2); PG8_BAR;
    PG8_STAGE(PG8_SB(1, 0), cB + kstep, voffB); PG8_STAGE(PG8_SA(1, 0), cA + kstep, cA0); PG8_STAGE(PG8_SB(1, 1), cB + hstep + kstep, voffB);
    PG8_WAIT_V(6); PG8_BAR;
    for (;;) {
        const bool has_next = S.next(ui + 1, nxt);
        const char* nA = cA; const char* nB = cB;
        { unsigned nA0[2] = {cA0[0], cA0[1]}, nA1[2] = {cA1[0], cA1[1]};
          if (has_next) { int R2[2], C2[2]; const int t2 = tid_x();
#pragma unroll
              for (int i = 0; i < 2; ++i) stage_rc(t2 * 16 + i * 8192, R2[i], C2[i]);
              S.addr(nxt, R2, C2, nA, nB, nA0, nA1); }
          nslot[0] = nA0[0]; nslot[1] = nA0[1]; nslot[2] = nA1[0]; nslot[3] = nA1[1]; }
#pragma unroll 1
        for (int t = 0; t < nt; t += 2) {
            const bool last = (t == nt - 2);
            const char* a1 = cA + (size_t)(t + 1) * kstep;
            const char* a2 = last ? nA : cA + (size_t)(t + 2) * kstep; const char* b2 = last ? nB : cB + (size_t)(t + 2) * kstep;
            const char* a3 = a2 + kstep; const char* b3 = b2 + kstep;
            unsigned x0[2], x1[2];
#pragma unroll
            for (int i = 0; i < 2; ++i) { x0[i] = last ? nslot[i] : cA0[i]; x1[i] = last ? nslot[2 + i] : cA1[i]; }
            PG8_LDB(B0, 0, 0); PG8_LDB(B1, 0, 1); PG8_SCHED; PG8_LDA(At, 0, 0); PG8_STAGE(PG8_SA(1, 1), a1, cA1);
            PG8_WAIT_V(8); PG8_WAIT_L(0); PG8_BAR; PG8_MMA(0, 0, At, B0); PG8_MMA(0, 1, At, B1); PG8_BAR; PG8_SCHED;
            PG8_LDA(At, 0, 1); PG8_STAGE(PG8_SB(0, 0), b2, voffB); PG8_STAGE(PG8_SB(0, 1), b2 + hstep, voffB); PG8_STAGE(PG8_SA(0, 0), a2, x0);
            PG8_WAIT_V(8); PG8_WAIT_L(0); PG8_BAR; PG8_MMA(1, 0, At, B0); PG8_MMA(1, 1, At, B1); PG8_BAR; PG8_SCHED;
            PG8_LDB(B0, 1, 0); PG8_LDB(B1, 1, 1); PG8_SCHED; PG8_LDA(At, 1, 0); PG8_STAGE(PG8_SA(0, 1), a2, x1);
            PG8_WAIT_V(8); PG8_WAIT_L(0); PG8_BAR; PG8_MMA(0, 0, At, B0); PG8_MMA(0, 1, At, B1); PG8_BAR; PG8_SCHED;
            PG8_LDA(At, 1, 1); PG8_STAGE(PG8_SB(1, 0), b3, voffB); PG8_STAGE(PG8_SB(1, 1), b3 + hstep, voffB); PG8_STAGE(PG8_SA(1, 0), a3, x0);
            PG8_WAIT_V(8); PG8_WAIT_L(0); PG8_BAR; PG8_MMA(1, 0, At, B0); PG8_MMA(1, 1, At, B1); PG8_BAR; PG8_SCHED;
        }
        if constexpr (ALIGN_EPI) { if (wr == 0) PG8_BAR; }
        if constexpr (F8) asm volatile("s_nop 15\n\ts_nop 15" ::: "memory");
        E(acc, cur, wr, wc, fr, fq);
        if (!has_next) break;
        if (!E.keep(cur)) {
#pragma unroll
            for (int a = 0; a < 2; ++a)
#pragma unroll
                for (int b = 0; b < 2; ++b)
#pragma unroll
                    for (int m = 0; m < 4; ++m)
#pragma unroll
                        for (int n = 0; n < 2; ++n) acc[a][b][m][n] = (f32x4){0.f, 0.f, 0.f, 0.f};
        }
        cur = nxt; cA = nA; cB = nB; cA0[0] = nslot[0]; cA0[1] = nslot[1]; cA1[0] = nslot[2]; cA1[1] = nslot[3]; ++ui;
        if constexpr (ALIGN_EPI) { if (wr == 1) PG8_BAR; }
    }
    PG8_WAIT_V(0);
    if constexpr (!ALIGN_EPI) { if (wr == 0) PG8_BAR; }
    PG8_BAR;
#undef PG8_SA
#undef PG8_SB
#undef PG8_STAGE
#undef PG8_LDA
#undef PG8_LD8
#undef PG8_LDB
#undef PG8_MMA
#undef PG8_WAIT_V
#undef PG8_WAIT_L
#undef PG8_BAR
#undef PG8_SCHED
}

struct DenseOrder {
    const char* A; const char* Bt; int K, nM, nN, nwg, G, c;
    __device__ __forceinline__ void init(const void* A_, const void* Bt_, int M, int N, int K_, int G_, int c_) { A = (const char*)A_; Bt = (const char*)Bt_; K = K_; nM = M / BM; nN = N / BM; nwg = nM * nN; G = G_; c = c_; }
    __device__ __forceinline__ bool next(int i, Unit& u) const {
        const long L = (long)i * G + c; if (L >= nwg) return false;
        int wgid = (int)L; { const int q = nwg / NXCD, r = nwg % NXCD, xcd = wgid % NXCD, off = wgid / NXCD; wgid = (xcd < r ? xcd * (q + 1) : r * (q + 1) + (xcd - r) * q) + off; }
        const int nig = WGM * nN, gid = wgid / nig, fm = gid * WGM, gsz = (nM - fm) < WGM ? (nM - fm) : WGM;
        u.pm = fm + ((wgid % nig) % gsz); u.pn = (wgid % nig) / gsz; u.aux = 0; return true;
    }
    __device__ __forceinline__ void addr(const Unit& u, const int (&R)[2], const int (&C)[2], const char*& a, const char*& b, unsigned (&a0)[2], unsigned (&a1)[2]) const {
        a = A + (size_t)u.pm * ((size_t)BM * K * 2); b = Bt + (size_t)u.pn * ((size_t)BM * K * 2);
#pragma unroll
        for (int i = 0; i < 2; ++i) { a0[i] = (unsigned)(R[i] * K + C[i]) * 2u; a1[i] = a0[i] + (unsigned)(HALF * K * 2); }
    }
};
}

__host__ __device__ __forceinline__ int proj_logical_col(int c) {
    if (c >= 3584) { const int t = (c - 3584) >> 8, l = (c - 3584) & 255; return ((l >> 7) ? 4608 : 3584) + 128 * t + (l & 127); }
    if (c < 2048 || c >= 3072) return c;
    const int tb = c & ~255, l = c & 255, bj = l >> 7, wc = (l >> 5) & 3, i = l & 31;
    return tb + 64 * wc + 32 * bj + i;
}
struct EpiProj {
    static constexpr bool PERM = true;
    unsigned char* ws; bf16* gates; const float* qg; const float* kg;
    __device__ __forceinline__ bool keep(const pg8::Unit&) const { return false; }
    __device__ __forceinline__ void operator()(f32x4 (&acc)[2][2][4][2], const pg8::Unit& u, int wr, int wc, int fr, int fq) const {
        const int pn = u.pn; const int tok0 = u.pm * 256 + wr * 64 + fr;
        if (pn < 8 || pn == 12 || pn == 13) {
            unsigned char* base = ws + ((pn < 8) ? (WS_HQ + (size_t)(pn >> 1) * (32 * MiB)) : WS_VIMG);
#pragma unroll
            for (int ai = 0; ai < 2; ++ai)
#pragma unroll
                for (int m = 0; m < 4; ++m) {
                    const int tok = tok0 + ai * 128 + m * 16; const int b = tok >> 12, s = tok & 4095, chunk = s >> 6, row = s & 63;
#pragma unroll
                    for (int bj = 0; bj < 2; ++bj) { const int h = 2 * (pn & 1) + bj;
                        unsigned char* dst = base + ((size_t)((b * 4 + h) * 64 + chunk) << 14) + off_a(row, 4 * wc + fq);
                        *(v4u*)dst = pack8(acc[ai][bj][m][0], acc[ai][bj][m][1]); }
                }
        } else if (pn < 12) {
            const bool isq = pn < 10; const float* gn = isq ? qg : kg;
            const int j = 4 * (pn & 1) + wc, h = j >> 1, mp = j & 1;
            const f32x4 ga0 = *(const f32x4*)(gn + 8 * fq), ga1 = *(const f32x4*)(gn + 8 * fq + 4), gb0 = *(const f32x4*)(gn + 32 + 8 * fq), gb1 = *(const f32x4*)(gn + 36 + 8 * fq);
            const f32x4* rope = (const f32x4*)(ws + WS_ROPE);
            const float qs = isq ? 0.125f * LOG2E : 1.0f;
#pragma unroll
            for (int ai = 0; ai < 2; ++ai)
#pragma unroll
                for (int m = 0; m < 4; ++m) {
                    const int tok = tok0 + ai * 128 + m * 16; const int b = tok >> 12, s = tok & 4095;
                    f32x4 x10 = acc[ai][0][m][0], x11 = acc[ai][0][m][1], x20 = acc[ai][1][m][0], x21 = acc[ai][1][m][1];
                    float ss = 0.f;
#pragma unroll
                    for (int e = 0; e < 4; ++e) ss += x10[e] * x10[e] + x11[e] * x11[e] + x20[e] * x20[e] + x21[e] * x21[e];
                    ss += swz_xor<16>(ss); { auto rr = __builtin_amdgcn_permlane32_swap(__float_as_uint(ss), __float_as_uint(ss), false, false); ss = __uint_as_float(rr[0]) + __uint_as_float(rr[1]); }
                    const float rstd = qs / sqrtf(ss * (1.0f / 64.0f) + EPS);
                    x10 = x10 * ga0 * rstd; x11 = x11 * ga1 * rstd; x20 = x20 * gb0 * rstd; x21 = x21 * gb1 * rstd;
                    const f32x4* rp = rope + (size_t)s * 16 + 4 * fq;
                    const f32x4 r0 = rp[0], r1 = rp[1], r2 = rp[2], r3 = rp[3];
                    f32x4 o10, o11, o20, o21;
                    o10[0] = x10[0] * r0[0] - x20[0] * r0[1]; o20[0] = x10[0] * r0[1] + x20[0] * r0[0];
                    o10[1] = x10[1] * r0[2] - x20[1] * r0[3]; o20[1] = x10[1] * r0[3] + x20[1] * r0[2];
                    o10[2] = x10[2] * r1[0] - x20[2] * r1[1]; o20[2] = x10[2] * r1[1] + x20[2] * r1[0];
                    o10[3] = x10[3] * r1[2] - x20[3] * r1[3]; o20[3] = x10[3] * r1[3] + x20[3] * r1[2];
                    o11[0] = x11[0] * r2[0] - x21[0] * r2[1]; o21[0] = x11[0] * r2[1] + x21[0] * r2[0];
                    o11[1] = x11[1] * r2[2] - x21[1] * r2[3]; o21[1] = x11[1] * r2[3] + x21[1] * r2[2];
                    o11[2] = x11[2] * r3[0] - x21[2] * r3[1]; o21[2] = x11[2] * r3[1] + x21[2] * r3[0];
                    o11[3] = x11[3] * r3[2] - x21[3] * r3[3]; o21[3] = x11[3] * r3[3] + x21[3] * r3[2];
                    const v4u w1 = pack8(o10, o11), w2 = pack8(o20, o21);
                    if (isq) {
                        bf16* q = (bf16*)(ws + WS_QT) + ((size_t)((b * 4 + h) * 4096 + s) * 128 + 64 * mp + 8 * fq);
                        *(v4u*)q = w1; *(v4u*)(q + 32) = w2;
                    } else {
                        unsigned char* kb = ws + WS_KIMG + ((size_t)((b * 4 + h) * 64 + (s >> 6)) << 14);
                        const unsigned rho = kappa((unsigned)(s & 63));
                        *(v4u*)(kb + off_a(rho, 8 * mp + fq)) = w1; *(v4u*)(kb + off_a(rho, 8 * mp + 4 + fq)) = w2;
                    }
                }
        } else {
            unsigned char* gblk = (unsigned char*)gates + ((size_t)(u.pm * 8 + (pn - 14)) << 17) + (size_t)(((wr * 4) * 4 + wc) * 64 + fr + 16 * fq) * 16;
#pragma unroll
            for (int ai = 0; ai < 2; ++ai)
#pragma unroll
                for (int m = 0; m < 4; ++m) {
                    bf16* dst = (bf16*)(gblk + (size_t)(ai * 2 * 4 + m) * 4 * 1024);
                    f32x4 r0, r1, s0, s1;
#pragma unroll
                    for (int e = 0; e < 4; ++e) {
                        const float ea0 = __expf(-acc[ai][0][m][0][e]), ea1 = __expf(-acc[ai][0][m][1][e]), eb0 = __expf(-acc[ai][1][m][0][e]), eb1 = __expf(-acc[ai][1][m][1][e]);
                        r0[e] = (1.0f + eb0) * rcpf_(1.0f + ea0); r1[e] = (1.0f + eb1) * rcpf_(1.0f + ea1); s0[e] = rcpf_(1.0f + eb0); s1[e] = rcpf_(1.0f + eb1);
                    }
                    *(v4u*)dst = pack8(r0, r1); *(v4u*)(dst + 32768) = pack8(s0, s1);
                }
        }
    }
};

struct BranchOrder {
    pg8::DenseOrder d; const char* A2; const char* B2;
    __device__ __forceinline__ bool next(int i, pg8::Unit& u) const { if (!d.next(i >> 1, u)) return false; u.aux = i & 1; return true; }
    __device__ __forceinline__ void addr(const pg8::Unit& u, const int (&R)[2], const int (&C)[2], const char*& a, const char*& b, unsigned (&a0)[2], unsigned (&a1)[2]) const {
        d.addr(u, R, C, a, b, a0, a1);
        if (u.aux) { a = A2 + (size_t)u.pm * ((size_t)pg8::BM * d.K * 2); b = B2 + (size_t)u.pn * ((size_t)pg8::BM * d.K * 2); }
    }
};
struct EpiBranch {
    static constexpr bool PERM = true;
    const bf16* gates; bf16* mixed;
    __device__ __forceinline__ bool keep(const pg8::Unit& u) const { return u.aux == 0; }
    __device__ __forceinline__ void operator()(f32x4 (&acc)[2][2][4][2], const pg8::Unit& u, int wr, int wc, int fr, int fq) const {
        const int tok0 = u.pm * 256 + wr * 64 + fr, c0 = u.pn * 256 + 32 * wc + 8 * fq;
        const unsigned char* gb = (const unsigned char*)gates + ((size_t)(u.pm * 8 + 2 * u.pn) << 17) + (u.aux ? 65536 : 0) + (size_t)(((wr * 4) * 4 + wc) * 64 + fr + 16 * fq) * 16;
        v4u g[2][4][2];
#pragma unroll
        for (int ai = 0; ai < 2; ++ai)
#pragma unroll
            for (int m = 0; m < 4; ++m)
#pragma unroll
                for (int bj = 0; bj < 2; ++bj) g[ai][m][bj] = *(const v4u*)(gb + ((size_t)bj << 17) + (size_t)(ai * 2 * 4 + m) * 4 * 1024);
#pragma unroll
        for (int ai = 0; ai < 2; ++ai) {
#pragma unroll
            for (int m = 0; m < 4; ++m)
#pragma unroll
                for (int bj = 0; bj < 2; ++bj) {
#pragma unroll
                    for (int e = 0; e < 2; ++e) { acc[ai][bj][m][0][2 * e] *= __uint_as_float(g[ai][m][bj][e] << 16); acc[ai][bj][m][0][2 * e + 1] *= __uint_as_float(g[ai][m][bj][e] & 0xffff0000u);
                                                  acc[ai][bj][m][1][2 * e] *= __uint_as_float(g[ai][m][bj][2 + e] << 16); acc[ai][bj][m][1][2 * e + 1] *= __uint_as_float(g[ai][m][bj][2 + e] & 0xffff0000u); }
                    if (u.aux) *(v4u*)(mixed + (size_t)(tok0 + ai * 128 + m * 16) * DM + c0 + 128 * bj) = pack8(acc[ai][bj][m][0], acc[ai][bj][m][1]);
                }
        }
    }
};
struct EpiOut {
    static constexpr bool PERM = true;
    const float* x; bf16* x1b;
    __device__ __forceinline__ bool keep(const pg8::Unit&) const { return false; }
    __device__ __forceinline__ void operator()(f32x4 (&acc)[2][2][4][2], const pg8::Unit& u, int wr, int wc, int fr, int fq) const {
        const int tok0 = u.pm * 256 + wr * 64 + fr, c0 = u.pn * 256 + 32 * wc + 8 * fq;
#pragma unroll
        for (int ai = 0; ai < 2; ++ai)
#pragma unroll
            for (int mp = 0; mp < 2; ++mp) {
                f32x4 xv[2][2][2];
#pragma unroll
                for (int mm = 0; mm < 2; ++mm) { const size_t ro = (size_t)(tok0 + ai * 128 + (2 * mp + mm) * 16) * DM + c0;
#pragma unroll
                    for (int bj = 0; bj < 2; ++bj)
#pragma unroll
                        for (int n = 0; n < 2; ++n) xv[mm][bj][n] = *(const f32x4*)(x + ro + 128 * bj + 4 * n); }
#pragma unroll
                for (int mm = 0; mm < 2; ++mm) { const size_t ro = (size_t)(tok0 + ai * 128 + (2 * mp + mm) * 16) * DM + c0;
#pragma unroll
                    for (int bj = 0; bj < 2; ++bj) *(v4u*)(x1b + ro + 128 * bj) = pack8(xv[mm][bj][0] + acc[ai][bj][2 * mp + mm][0], xv[mm][bj][1] + acc[ai][bj][2 * mp + mm][1]); }
            }
    }
};
template <int rmul> struct MoeOrderT {
    const LAS int* pref; const LAS int* cnt; const v2u* rowtok; const char* A; const char* Bt; int K; size_t bstride; int rmul_unused; int b_lo, b_hi, ncol, G, c;
    __device__ __forceinline__ bool next(int i, pg8::Unit& u) const {
        const int L = i * G + c; const int t0 = pref[b_lo], total = (pref[b_hi] - t0) * ncol; if (L >= total) return false;
        const int rt = t0 + (L >> 2); int b = b_lo;
#pragma unroll 1
        for (int st = 32; st >= 1; st >>= 1) { const int nb_ = b + st; if (nb_ < b_hi && __builtin_amdgcn_readfirstlane(pref[nb_]) <= rt) b = nb_; }
        u.pm = rt - pref[b]; u.pn = L & 3; u.aux = b; return true;
    }
    __device__ __forceinline__ void addr(const pg8::Unit& u, const int (&R)[2], const int (&C)[2], const char*& a, const char*& b, unsigned (&a0)[2], unsigned (&a1)[2]) const {
        a = A; b = Bt + (size_t)(u.aux & 31) * bstride + (size_t)u.pn * ((size_t)pg8::BM * K * 2);
        if constexpr (rmul == 0) {
            const unsigned base = (unsigned)(pref[u.aux] + u.pm) * 256u;
#pragma unroll
            for (int i = 0; i < 2; ++i) { a0[i] = ((base + (unsigned)R[i]) * (unsigned)K + (unsigned)C[i]) * 2u; a1[i] = a0[i] + (unsigned)(128 * K * 2); }
        } else {
        const int n = cnt[u.aux]; const v2u* rt = rowtok + (size_t)u.aux * RCAP;
#pragma unroll
        for (int i = 0; i < 2; ++i) {
            const int r0 = u.pm * 256 + R[i], r1 = r0 + 128;
            const int t0 = (r0 < n) ? (int)rt[r0].x : 0, t1 = (r1 < n) ? (int)rt[r1].x : 0;
            a0[i] = (unsigned)(t0 * K + C[i]) * 2u; a1[i] = (unsigned)(t1 * K + C[i]) * 2u;
        }
        }
    }
};
struct EpiUp {
    static constexpr bool PERM = true;
    const LAS int* pref; const LAS int* cnt; unsigned char* hid;
    __device__ __forceinline__ bool keep(const pg8::Unit&) const { return false; }
    __device__ __forceinline__ void operator()(f32x4 (&acc)[2][2][4][2], const pg8::Unit& u, int wr, int wc, int fr, int fq) const {
        const int n = cnt[u.aux] - u.pm * 256;
        int frl = fr, fql = fq; asm volatile("" : "+v"(frl), "+v"(fql));
        const int r0 = wr * 64 + frl, c0 = u.pn * 128 + 32 * wc + 8 * fql;
        unsigned char* hb = hid + (size_t)(pref[u.aux] + u.pm) * (256 * DFF) + c0;
#pragma unroll
        for (int ai = 0; ai < 2; ++ai)
#pragma unroll
            for (int m = 0; m < 4; ++m) {
                const int r = r0 + ai * 128 + m * 16;
                f32x4 h0, h1;
#pragma unroll
                for (int e = 0; e < 4; ++e) { const float a0 = acc[ai][0][m][0][e], a1 = acc[ai][0][m][1][e];
                    h0[e] = a0 * rcpf_(1.0f + __expf(-a0)) * acc[ai][1][m][0][e]; h1[e] = a1 * rcpf_(1.0f + __expf(-a1)) * acc[ai][1][m][1][e]; }
                if (r < n) *(v2u*)(hb + (size_t)r * DFF) = (v2u){pk4_fp8(h0[0], h0[1], h0[2], h0[3]), pk4_fp8(h1[0], h1[1], h1[2], h1[3])};
            }
    }
};
struct EpiDown {
    static constexpr bool PERM = true;
    const LAS int* pref; const LAS int* cnt; bf16* y;
    __device__ __forceinline__ bool keep(const pg8::Unit&) const { return false; }
    __device__ __forceinline__ void operator()(f32x4 (&acc)[2][2][4][2], const pg8::Unit& u, int wr, int wc, int fr, int fq) const {
        const int n = cnt[u.aux] - u.pm * 256;
        int frl = fr, fql = fq; asm volatile("" : "+v"(frl), "+v"(fql));
        const int r0 = wr * 64 + frl, c0 = u.pn * 256 + 32 * wc + 8 * fql;
        bf16* yb = y + (size_t)(pref[u.aux] + u.pm) * (256 * DM) + c0;
#pragma unroll
        for (int ai = 0; ai < 2; ++ai)
#pragma unroll
            for (int m = 0; m < 4; ++m) {
                const int r = r0 + ai * 128 + m * 16;
                if (r < n) {
#pragma unroll
                    for (int bj = 0; bj < 2; ++bj) *(v4u*)(yb + (size_t)r * DM + 128 * bj) = pack8(acc[ai][bj][m][0], acc[ai][bj][m][1]);
                }
            }
    }
};

constexpr int NWAVES = 8;
constexpr int RING_OFF = 0, RING_BYTES = 131072;
struct Args { const float* in[20]; float* out; unsigned char* ws; int ph_lo, ph_hi, li, pad; };
constexpr int SCHED_OFF = RING_BYTES + 8192;

template <class F>
__device__ __forceinline__ void transpose_item(const float* W, int N, bf16* WT, int K, LAS float* scr, int kb, int nb, int lane, F srccol) {
    const int k0 = 64 * kb, n0 = 32 * nb; const int sc = srccol(n0);
#pragma unroll 8
    for (int i = 0; i < 32; ++i) { const int kk = 2 * i + (lane >> 5); scr[kk * 33 + (lane & 31)] = W[(size_t)(k0 + kk) * N + sc + (lane & 31)]; }
    asm volatile("s_waitcnt lgkmcnt(0)" ::: "memory");
    const int c = lane & 7;
#pragma unroll
    for (int j = 0; j < 4; ++j) { const int n = (lane >> 3) + 8 * j; const LAS float* s = scr + (8 * c) * 33 + n;
        v4u o; o.x = cvtpk(s[0 * 33], s[1 * 33]); o.y = cvtpk(s[2 * 33], s[3 * 33]); o.z = cvtpk(s[4 * 33], s[5 * 33]); o.w = cvtpk(s[6 * 33], s[7 * 33]);
        *(v4u*)(WT + (size_t)(n0 + n) * K + k0 + 8 * c) = o; }
    asm volatile("s_waitcnt lgkmcnt(0)" ::: "memory");
}

template <class F>
__device__ __forceinline__ void transpose_item8(const float* W, int N, unsigned char* WT, int K, float sc, LAS float* scr, int kb, int nb, int lane, F srccol) {
    const int k0 = 64 * kb, n0 = 32 * nb; const int scol = srccol(n0);
#pragma unroll 8
    for (int i = 0; i < 32; ++i) { const int kk = 2 * i + (lane >> 5); scr[kk * 33 + (lane & 31)] = W[(size_t)(k0 + kk) * N + scol + (lane & 31)] * sc; }
    asm volatile("s_waitcnt lgkmcnt(0)" ::: "memory");
    const int n = lane & 31, hf = lane >> 5; const LAS float* sp = scr + (32 * hf) * 33 + n;
    v4u o0, o1;
    o0.x = pk4_fp8(sp[0 * 33], sp[1 * 33], sp[2 * 33], sp[3 * 33]); o0.y = pk4_fp8(sp[4 * 33], sp[5 * 33], sp[6 * 33], sp[7 * 33]);
    o0.z = pk4_fp8(sp[8 * 33], sp[9 * 33], sp[10 * 33], sp[11 * 33]); o0.w = pk4_fp8(sp[12 * 33], sp[13 * 33], sp[14 * 33], sp[15 * 33]);
    o1.x = pk4_fp8(sp[16 * 33], sp[17 * 33], sp[18 * 33], sp[19 * 33]); o1.y = pk4_fp8(sp[20 * 33], sp[21 * 33], sp[22 * 33], sp[23 * 33]);
    o1.z = pk4_fp8(sp[24 * 33], sp[25 * 33], sp[26 * 33], sp[27 * 33]); o1.w = pk4_fp8(sp[28 * 33], sp[29 * 33], sp[30 * 33], sp[31 * 33]);
    unsigned char* d = WT + (size_t)(n0 + n) * K + k0 + 32 * hf;
    *(v4u*)d = o0; *(v4u*)(d + 16) = o1;
    asm volatile("s_waitcnt lgkmcnt(0)" ::: "memory");
}
__device__ __forceinline__ void p0_prologue(const Args& a, LAS unsigned char* lds, int vcu, int G, int wave, int lane) {
    LAS float* scr = (LAS float*)(lds + wave * 16384);
    unsigned char* ws = a.ws;
    const int gw = vcu * NWAVES + wave, NGW = G * NWAVES;
    constexpr int I_IN = 16 * (NCOLS / 32), I_BR = 8 * 32, I_OUT = 16 * 32;
    constexpr int NITEMS = I_IN + 2 * I_BR + I_OUT;
    for (int it = gw; it < NITEMS; it += NGW) {
        int r = it;
        if (r < I_IN) { transpose_item(a.in[2], NCOLS, (bf16*)(ws + WS_WIN), DM, scr, r / (NCOLS / 32), r % (NCOLS / 32), lane, [](int n) { return proj_logical_col(n); }); continue; } r -= I_IN;
        if (r < I_BR) { transpose_item(a.in[9], DM, (bf16*)(ws + WS_WHG), 512, scr, r / 32, r % 32, lane, [](int n) { return n; }); continue; } r -= I_BR;
        if (r < I_BR) { transpose_item(a.in[10], DM, (bf16*)(ws + WS_WDA), 512, scr, r / 32, r % 32, lane, [](int n) { return n; }); continue; } r -= I_BR;
        transpose_item(a.in[11], DM, (bf16*)(ws + WS_WOUT), DM, scr, r / 32, r % 32, lane, [](int n) { return n; });
    }
    const f32x4 g0 = ((const f32x4*)a.in[1])[lane], g1 = ((const f32x4*)a.in[1])[lane + 64], g2 = ((const f32x4*)a.in[1])[lane + 128], g3 = ((const f32x4*)a.in[1])[lane + 192];
    for (int m = gw; m < NT; m += NGW) {
        const f32x4* xr = (const f32x4*)(a.in[0] + (size_t)m * DM) + lane;
        f32x4 v0 = xr[0], v1 = xr[64], v2 = xr[128], v3 = xr[192];
        float s = 0.f;
#pragma unroll
        for (int e = 0; e < 4; ++e) s += v0[e] * v0[e] + v1[e] * v1[e] + v2[e] * v2[e] + v3[e] * v3[e];
        const float rstd = 1.0f / sqrtf(wave_sum(s) * (1.0f / DM) + EPS);
        v0 = v0 * g0 * rstd; v1 = v1 * g1 * rstd; v2 = v2 * g2 * rstd; v3 = v3 * g3 * rstd;
        v2u* o = (v2u*)((bf16*)(ws + WS_H) + (size_t)m * DM) + lane;
        o[0] = (v2u){cvtpk(v0[0], v0[1]), cvtpk(v0[2], v0[3])}; o[64] = (v2u){cvtpk(v1[0], v1[1]), cvtpk(v1[2], v1[3])};
        o[128] = (v2u){cvtpk(v2[0], v2[1]), cvtpk(v2[2], v2[3])}; o[192] = (v2u){cvtpk(v3[0], v3[1]), cvtpk(v3[2], v3[3])};
    }
    const int gt = (vcu * NWAVES + wave) * 64 + lane, NGT = NGW * 64;
    for (int i = gt; i < 4096 * 32; i += NGT) { const int pos = i >> 5, f = i & 31;
        const float inv = powf(10000.0f, -(float)f / 32.0f); const float ang = (float)pos * inv;
        ((f32x2*)(ws + WS_ROPE))[i] = (f32x2){cosf(ang), sinf(ang)}; }
    if (vcu == 0) {
        float* sm = (float*)(ws + WS_SMALL); const int t = wave * 64 + lane;
        { const float a0 = a.in[3][t], a1 = a.in[3][512 + t], mx = fmaxf(a0, a1), e0 = expf(a0 - mx), e1 = expf(a1 - mx); sm[t] = e0 / (e0 + e1); }
        if (wave == 0) {
            const float* lp = a.in[7];
            const float d01 = wave_sum(lp[lane] * lp[64 + lane]), d23 = wave_sum(lp[128 + lane] * lp[192 + lane]);
            float mq = fabsf(a.in[5][lane]), mk = fabsf(a.in[6][lane]);
            mq = wave_max(mq); mk = wave_max(mk);
            if (lane == 0) { sm[512] = expf(d01) - expf(d23) + 0.2f; sm[513] = 8.0f * mq * mk * LOG2E * 1.001f + 0.01f; }
        }
    }
}

__device__ __forceinline__ void router_phase(const Args& a, LAS unsigned char* lds, int G, int wave, int lane) {
    LAS float* wl = (LAS float*)lds;
    LAS float* gl = (LAS float*)(lds + 77824 + 256);
    LAS float* lg = gl + 1024 + wave * (16 * 48);
    LAS int* lhist = (LAS int*)(gl + 1024 + 8 * 16 * 48);
    LAS int* lbase = lhist + 64;
    LAS int* tbk = lbase + 64;
    LAS int* trk = tbk + 256;
    LAS float* twt = (LAS float*)(trk + 256);
    unsigned char* ws = a.ws; const int tid = tid_x();
    const float* wrg = a.in[13]; const float* wre = a.in[15];
    const bf16* x1b = (const bf16*)(ws + WS_X1B); const float* brg = a.in[14]; const float* bre = a.in[16];
    LAS unsigned char* wt = lds; constexpr int WRS = 1040, WHS = 36 * WRS;
    unsigned* gcnt = (unsigned*)(ws + WS_CTL) + CW_GCNT; v2u* rowtok = (v2u*)(ws + WS_ROWTOK);
    const int c16 = lane & 15, g4 = lane >> 4;
    for (int i = tid; i < 1024; i += 512) gl[i] = a.in[12][i];
    for (int batch = blockIdx.x; batch < NT / 128; batch += G) {
        const int t0 = batch * 128 + wave * 16;
        f32x4 acc0 = {0.f, 0.f, 0.f, 0.f}, acc1 = acc0, acc2 = acc0; float ss = 0.f;
        for (int half = 0; half < 2; ++half) {
            __syncthreads();
            if (half == 0 && tid < 64) lhist[tid] = 0;
#pragma unroll 4
            for (int i = tid; i < 256 * 32; i += 512) { const int n = i & 31, kp = i >> 5, k = 512 * half + 2 * kp;
                const float v0 = wre[(size_t)k * 32 + n] * gl[k], v1 = wre[(size_t)(k + 1) * 32 + n] * gl[k + 1];
                const unsigned hi = cvtpk(v0, v1), lo = cvtpk(v0 - __uint_as_float(hi << 16), v1 - __uint_as_float(hi & 0xffff0000u));
                LAS unsigned char* d = wt + (4 + n) * WRS + 4 * kp; *(LAS unsigned*)d = hi; *(LAS unsigned*)(d + WHS) = lo; }
#pragma unroll
            for (int i = tid; i < 256 * 4; i += 512) { const int n = i & 3, kp = i >> 2, k = 512 * half + 2 * kp;
                const float v0 = wrg[(size_t)k * 4 + n] * gl[k], v1 = wrg[(size_t)(k + 1) * 4 + n] * gl[k + 1];
                const unsigned hi = cvtpk(v0, v1), lo = cvtpk(v0 - __uint_as_float(hi << 16), v1 - __uint_as_float(hi & 0xffff0000u));
                LAS unsigned char* d = wt + n * WRS + 4 * kp; *(LAS unsigned*)d = hi; *(LAS unsigned*)(d + WHS) = lo; }
            __syncthreads();
            const unsigned char* xr = (const unsigned char*)(x1b + (size_t)(t0 + c16) * DM + 512 * half + 8 * g4);
            const LAS unsigned char* wb0 = wt + c16 * WRS + 16 * g4; const LAS unsigned char* wb1 = wb0 + 16 * WRS; const LAS unsigned char* wb2 = wt + (32 + (c16 & 3)) * WRS + 16 * g4;
#pragma unroll 4
            for (int sp = 0; sp < 16; ++sp) {
                const v4u xb = *(const v4u*)(xr + 64 * sp);
#pragma unroll
                for (int e = 0; e < 4; ++e) { const float lo_ = __uint_as_float(xb[e] << 16), hi_ = __uint_as_float(xb[e] & 0xffff0000u); ss += lo_ * lo_ + hi_ * hi_; }
                const bf16x8 av = __builtin_bit_cast(bf16x8, xb);
                acc0 = __builtin_amdgcn_mfma_f32_16x16x32_bf16(av, *(const LAS bf16x8*)(wb0 + 64 * sp), acc0, 0, 0, 0);
                acc1 = __builtin_amdgcn_mfma_f32_16x16x32_bf16(av, *(const LAS bf16x8*)(wb1 + 64 * sp), acc1, 0, 0, 0);
                acc2 = __builtin_amdgcn_mfma_f32_16x16x32_bf16(av, *(const LAS bf16x8*)(wb2 + 64 * sp), acc2, 0, 0, 0);
                acc0 = __builtin_amdgcn_mfma_f32_16x16x32_bf16(av, *(const LAS bf16x8*)(wb0 + WHS + 64 * sp), acc0, 0, 0, 0);
                acc1 = __builtin_amdgcn_mfma_f32_16x16x32_bf16(av, *(const LAS bf16x8*)(wb1 + WHS + 64 * sp), acc1, 0, 0, 0);
                acc2 = __builtin_amdgcn_mfma_f32_16x16x32_bf16(av, *(const LAS bf16x8*)(wb2 + WHS + 64 * sp), acc2, 0, 0, 0);
            }
        }
        ss += swz_xor<16>(ss); { auto rr = __builtin_amdgcn_permlane32_swap(__float_as_uint(ss), __float_as_uint(ss), false, false); ss = __uint_as_float(rr[0]) + __uint_as_float(rr[1]); }
        const float rstd = 1.0f / sqrtf(ss * (1.0f / DM) + EPS);
#pragma unroll
        for (int r = 0; r < 4; ++r) { lg[(4 * g4 + r) * 48 + c16] = acc0[r]; lg[(4 * g4 + r) * 48 + 16 + c16] = acc1[r]; lg[(4 * g4 + r) * 48 + 32 + c16] = acc2[r]; }
        asm volatile("s_waitcnt lgkmcnt(0)" ::: "memory");
        if (lane < 16) {
            const LAS float* lt = lg + lane * 48; const int t = t0 + lane, li = wave * 16 + lane;
            float gl4[4]; int gsel = 0;
#pragma unroll
            for (int q = 0; q < 4; ++q) gl4[q] = lt[q] * rstd + brg[q];
            float gmax = gl4[0];
#pragma unroll
            for (int q = 1; q < 4; ++q) if (gl4[q] > gmax) { gmax = gl4[q]; gsel = q; }
            float den = 0.f;
#pragma unroll
            for (int q = 0; q < 4; ++q) den += expf(gl4[q] - gmax);
            const float gw_ = 1.0f / den;
            float el[8];
#pragma unroll
            for (int q = 0; q < 8; ++q) el[q] = lt[4 + 8 * gsel + q] * rstd + bre[gsel * 8 + q];
            int i0 = 0; float v0 = el[0];
#pragma unroll
            for (int q = 1; q < 8; ++q) if (el[q] > v0) { v0 = el[q]; i0 = q; }
            int i1 = -1; float v1 = -3.0e38f;
#pragma unroll
            for (int q = 0; q < 8; ++q) if (q != i0 && el[q] > v1) { v1 = el[q]; i1 = q; }
            const float w1f = 1.0f / (1.0f + expf(v0 - v1)), w0f = 1.0f - w1f;
            const int b0 = gsel * 8 + i0, b1 = 32 + gsel * 8 + i1;
            tbk[2 * li] = b0; tbk[2 * li + 1] = b1;
            trk[2 * li] = atomicAdd((int*)&lhist[b0], 1); trk[2 * li + 1] = atomicAdd((int*)&lhist[b1], 1);
            twt[2 * li] = w0f * gw_; twt[2 * li + 1] = w1f * gw_;
        }
#pragma unroll
        for (int r = 0; r < 16; ++r) {
            const float rs = __uint_as_float(__builtin_amdgcn_readlane(__float_as_uint(rstd), r));
            const v4u* xr = (const v4u*)(x1b + (size_t)(t0 + r) * DM) + lane;
            v2u* o = (v2u*)(ws + WS_XN + (size_t)(t0 + r) * DM) + lane;
#pragma unroll
            for (int j = 0; j < 2; ++j) { const v4u xb = xr[64 * j]; const LAS float* gp = gl + 8 * lane + 512 * j; const f32x4 ga = *(const LAS f32x4*)gp * rs, gb = *(const LAS f32x4*)(gp + 4) * rs;
                o[64 * j] = (v2u){pk4_fp8(__uint_as_float(xb.x << 16) * ga[0], __uint_as_float(xb.x & 0xffff0000u) * ga[1], __uint_as_float(xb.y << 16) * ga[2], __uint_as_float(xb.y & 0xffff0000u) * ga[3]),
                                  pk4_fp8(__uint_as_float(xb.z << 16) * gb[0], __uint_as_float(xb.z & 0xffff0000u) * gb[1], __uint_as_float(xb.w << 16) * gb[2], __uint_as_float(xb.w & 0xffff0000u) * gb[3])}; }
        }
        __syncthreads();
        if (tid < 64) { const int c = lhist[tid]; lbase[tid] = c ? (int)atomicAdd(&gcnt[tid * 16], (unsigned)c) : 0; }
        __syncthreads();
        if (tid < 256) { const int bk = tbk[tid]; const int slot = lbase[bk] + trk[tid]; rowtok[(size_t)bk * RCAP + slot] = (v2u){(unsigned)(batch * 128 + (tid >> 1)), __float_as_uint(twt[tid])};
            ((v2u*)(ws + WS_TOKPOS))[(size_t)batch * 256 + tid] = (v2u){((unsigned)bk << 16) | (unsigned)slot, __float_as_uint(twt[tid])}; }
    }
    __syncthreads();
}

__device__ __forceinline__ void w13_convert(const Args& a, LAS unsigned char* lds, int vcu, int G, int wave, int lane) {
    LAS float* scr = (LAS float*)(lds + wave * 16384);
    const int gw = vcu * NWAVES + wave, NGW = G * NWAVES;
    for (int it = gw; it < NEXP * 512; it += NGW) {
        const int e = it >> 9, q = it & 511, kb = q >> 5, nb = q & 31, n0 = nb * 32, bj = (n0 >> 7) & 1;
        const float* W = (bj ? a.in[18] : a.in[17]) + (size_t)e * DM * DFF;
        transpose_item8(W, DFF, a.ws + WS_W13T + (size_t)e * DM * DM, DM, 32.0f, scr, kb, nb, lane, [](int n) { return 128 * (n >> 8) + (n & 127); });
    }
    for (int it = gw; it < NEXP * 256; it += NGW) {
        const int e = it >> 8, q = it & 255;
        transpose_item8(a.in[19] + (size_t)e * DFF * DM, DM, a.ws + WS_W2T + (size_t)e * DM * DFF, DFF, 16.0f, scr, q / 32, q % 32, lane, [](int n) { return n; });
    }
}
__device__ __forceinline__ void moe_sched_setup(const Args& a, LAS unsigned char* lds) {
    LAS int* pref = (LAS int*)(lds + SCHED_OFF); LAS int* cnt = pref + 80;
    const unsigned* gcnt = (const unsigned*)(a.ws + WS_CTL) + CW_GCNT;
    const int t_ = tid_x();
    if (t_ < 64) {
        const int c = (int)gcnt[t_ * 16]; cnt[t_] = c;
        int v = (c + 255) >> 8;
        volatile LAS int* tmp = (volatile LAS int*)(pref + 160);
#pragma unroll
        for (int o = 1; o < 64; o <<= 1) { tmp[t_] = v; const int up = tmp[t_ >= o ? t_ - o : 0]; if (t_ >= o) v += up; }
        pref[t_ + 1] = v; if (t_ == 0) pref[0] = 0;
    }
    __syncthreads();
}

namespace att {
constexpr int SLOT = 16384;
constexpr int LDS_K = 0, LDS_V = 2 * SLOT, LDS_L = 4 * SLOT, LDS_STG = 4 * SLOT + 4096;
typedef short v4i16_t __attribute__((ext_vector_type(4)));
__device__ __forceinline__ s16x4 vtr(const LAS unsigned char* p) { return __builtin_bit_cast(s16x4, __builtin_amdgcn_ds_read_tr16_b64_v4i16((LAS v4i16_t*)p)); }
#define ATT_WAIT_BAR(N) asm volatile("s_waitcnt vmcnt(" #N ")\n\ts_barrier" ::: "memory")
#define ATT_MFMA(a, b, c) __builtin_amdgcn_mfma_f32_32x32x16_bf16((a), (b), (c), 0, 0, 0)
__device__ __forceinline__ void softmax_tile(f32x16& p0, f32x16& p1, bf16x8 (&pa)[4], float& lsum, int jb, int qrel, int hh, float mshift) {
    if (jb >= 0) {
#pragma unroll
        for (int r = 0; r < 16; ++r) { const int kr = 64 * jb + (r & 7) + 8 * hh + 16 * (r >> 3);
            if (kr > qrel) p0[r] = -INFINITY; if (kr + 32 > qrel) p1[r] = -INFINITY; }
    }
    float s = 0.f;
#pragma unroll
    for (int r = 0; r < 16; ++r) { p0[r] = __builtin_amdgcn_exp2f(p0[r] - mshift); p1[r] = __builtin_amdgcn_exp2f(p1[r] - mshift); s += p0[r] + p1[r]; }
    lsum += s;
    v4u w;
    w.x = cvtpk(p0[0], p0[1]); w.y = cvtpk(p0[2], p0[3]); w.z = cvtpk(p0[4], p0[5]); w.w = cvtpk(p0[6], p0[7]); pa[0] = __builtin_bit_cast(bf16x8, w);
    w.x = cvtpk(p0[8], p0[9]); w.y = cvtpk(p0[10], p0[11]); w.z = cvtpk(p0[12], p0[13]); w.w = cvtpk(p0[14], p0[15]); pa[1] = __builtin_bit_cast(bf16x8, w);
    w.x = cvtpk(p1[0], p1[1]); w.y = cvtpk(p1[2], p1[3]); w.z = cvtpk(p1[4], p1[5]); w.w = cvtpk(p1[6], p1[7]); pa[2] = __builtin_bit_cast(bf16x8, w);
    w.x = cvtpk(p1[8], p1[9]); w.y = cvtpk(p1[10], p1[11]); w.z = cvtpk(p1[12], p1[13]); w.w = cvtpk(p1[14], p1[15]); pa[3] = __builtin_bit_cast(bf16x8, w);
}
struct E16 { float v[16]; };
__device__ __forceinline__ void soft_half(f32x16& p, bf16x8& paA, bf16x8& paB, float& lsum, int jb, int wid, int half) {
    if (jb >= 0) {
        const int ln = (int)lane_id(), hh = ln >> 5, qrel = wid * 32 + (ln & 31);
#pragma unroll
        for (int r = 0; r < 16; ++r) { const int kr = 64 * jb + 32 * half + (r & 7) + 8 * hh + 16 * (r >> 3); if (kr > qrel) p[r] = -INFINITY; }
    }
    float e[16];
#pragma unroll
    for (int r = 0; r < 16; ++r) e[r] = __builtin_amdgcn_exp2f(p[r]);
    const float s0 = (e[0] + e[1]) + (e[2] + e[3]), s1 = (e[4] + e[5]) + (e[6] + e[7]), s2 = (e[8] + e[9]) + (e[10] + e[11]), s3 = (e[12] + e[13]) + (e[14] + e[15]);
    lsum += (s0 + s1) + (s2 + s3);
    v4u w;
    w.x = cvtpk(e[0], e[1]); w.y = cvtpk(e[2], e[3]); w.z = cvtpk(e[4], e[5]); w.w = cvtpk(e[6], e[7]); paA = __builtin_bit_cast(bf16x8, w);
    w.x = cvtpk(e[8], e[9]); w.y = cvtpk(e[10], e[11]); w.z = cvtpk(e[12], e[13]); w.w = cvtpk(e[14], e[15]); paB = __builtin_bit_cast(bf16x8, w);
    asm volatile("" : "+v"(paA), "+v"(paB), "+v"(lsum));
}
__device__ __forceinline__ void exp_half(f32x16& p, E16& e, int jb, int wid, int half) {
    if (jb >= 0) {
        const int ln = (int)lane_id(), hh = ln >> 5, qrel = wid * 32 + (ln & 31);
#pragma unroll
        for (int r = 0; r < 16; ++r) { const int kr = 64 * jb + 32 * half + (r & 7) + 8 * hh + 16 * (r >> 3); if (kr > qrel) p[r] = -INFINITY; }
    }
#pragma unroll
    for (int r = 0; r < 16; ++r) e.v[r] = __builtin_amdgcn_exp2f(p[r]);
    asm volatile("" : "+v"(e.v[0]), "+v"(e.v[1]), "+v"(e.v[2]), "+v"(e.v[3]), "+v"(e.v[4]), "+v"(e.v[5]), "+v"(e.v[6]), "+v"(e.v[7]),
                      "+v"(e.v[8]), "+v"(e.v[9]), "+v"(e.v[10]), "+v"(e.v[11]), "+v"(e.v[12]), "+v"(e.v[13]), "+v"(e.v[14]), "+v"(e.v[15]));
}
__device__ __forceinline__ void pack_half(const E16& e, bf16x8& paA, bf16x8& paB, float& lsum) {
    const float* p = e.v;
    float s0 = (p[0] + p[1]) + (p[2] + p[3]), s1 = (p[4] + p[5]) + (p[6] + p[7]), s2 = (p[8] + p[9]) + (p[10] + p[11]), s3 = (p[12] + p[13]) + (p[14] + p[15]);
    lsum += (s0 + s1) + (s2 + s3);
    v4u w;
    w.x = cvtpk(p[0], p[1]); w.y = cvtpk(p[2], p[3]); w.z = cvtpk(p[4], p[5]); w.w = cvtpk(p[6], p[7]); paA = __builtin_bit_cast(bf16x8, w);
    w.x = cvtpk(p[8], p[9]); w.y = cvtpk(p[10], p[11]); w.z = cvtpk(p[12], p[13]); w.w = cvtpk(p[14], p[15]); paB = __builtin_bit_cast(bf16x8, w);
}
__device__ __forceinline__ void softmax_half(f32x16& p, bf16x8& paA, bf16x8& paB, float& lsum, int jb, int qrel, int hh, float mshift, int half) {
    if (jb >= 0) {
#pragma unroll
        for (int r = 0; r < 16; ++r) { const int kr = 64 * jb + 32 * half + (r & 7) + 8 * hh + 16 * (r >> 3); if (kr > qrel) p[r] = -INFINITY; }
    }
    float s = 0.f;
#pragma unroll
    for (int r = 0; r < 16; ++r) { p[r] = __builtin_amdgcn_exp2f(p[r] - mshift); s += p[r]; }
    lsum += s;
    v4u w;
    w.x = cvtpk(p[0], p[1]); w.y = cvtpk(p[2], p[3]); w.z = cvtpk(p[4], p[5]); w.w = cvtpk(p[6], p[7]); paA = __builtin_bit_cast(bf16x8, w);
    w.x = cvtpk(p[8], p[9]); w.y = cvtpk(p[10], p[11]); w.z = cvtpk(p[12], p[13]); w.w = cvtpk(p[14], p[15]); paB = __builtin_bit_cast(bf16x8, w);
}
__device__ __forceinline__ void attn_unit(int bh, int qb, unsigned char* ws, LAS unsigned char* lds, float mshift, float lam, const float* gain) {
    int tid = tid_x(); asm volatile("" : "+v"(tid));
    const int lane = tid & 63, wid = __builtin_amdgcn_readfirstlane(tid >> 6), r32 = lane & 31, hh = lane >> 5;
    const int NTL = 4 * (qb + 1);
    const unsigned char* kgu = ws + WS_KIMG + ((size_t)bh << 20) + wid * 1024;
    const unsigned char* vgu = ws + WS_VIMG + ((size_t)bh << 20) + wid * 1024;

    {
        const unsigned char* Qg = ws + WS_QT + ((size_t)bh * 4096 + qb * 256 + wid * 32) * 256;
#pragma unroll
        for (int i = 0; i < 8; ++i) { const unsigned row = 8u * (i >> 1) + (((unsigned)lane >> 2) & 7u), ch = 4u * (2u * (i & 1) + ((unsigned)lane >> 5)) + (((unsigned)lane & 3u) ^ ((row >> 2) & 3u));
            __builtin_amdgcn_global_load_lds((const unsigned*)(Qg + row * 256 + ch * 16), (LAS unsigned*)(lds + LDS_STG + wid * 8192 + i * 1024), 16, 0, 0); }
    }
    const LAS unsigned char* Qb = lds + LDS_STG + wid * 8192;
#define ATT_DMA_K(t, slot) do { const unsigned char* tb_ = kgu + ((size_t)(t) << 14); \
        const unsigned lo16 = lane_id() * 16u; __builtin_amdgcn_global_load_lds((const unsigned*)(tb_ + lo16), (LAS unsigned*)(lds + LDS_K + (slot) * SLOT + wid * 1024), 16, 0, 0); \
        __builtin_amdgcn_global_load_lds((const unsigned*)(tb_ + 8192 + lo16), (LAS unsigned*)(lds + LDS_K + (slot) * SLOT + 8192 + wid * 1024), 16, 0, 0); } while (0)
#define ATT_DMA_V(t, slot) do { const unsigned char* tb_ = vgu + ((size_t)(t) << 14); \
        const unsigned lo16 = lane_id() * 16u; __builtin_amdgcn_global_load_lds((const unsigned*)(tb_ + lo16), (LAS unsigned*)(lds + LDS_V + (slot) * SLOT + wid * 1024), 16, 0, 0); \
        __builtin_amdgcn_global_load_lds((const unsigned*)(tb_ + 8192 + lo16), (LAS unsigned*)(lds + LDS_V + (slot) * SLOT + 8192 + wid * 1024), 16, 0, 0); } while (0)
    ATT_DMA_K(0, 0); ATT_DMA_V(0, 0);
    f32x16 o1[4], o2[4];
#pragma unroll
    for (int c = 0; c < 4; ++c)
#pragma unroll
        for (int r = 0; r < 16; ++r) { o1[c][r] = 0.f; o2[c][r] = 0.f; }
    float l1 = 0.f, l2 = 0.f;
    const unsigned krb = 2048u * ((unsigned)r32 >> 3) + 64u * ((unsigned)r32 & 7u), krs = ((unsigned)r32 >> 2) & 3u;
    const unsigned kr0 = krb + 16u * (hh ^ krs);
    const unsigned tq = ((unsigned)lane & 15u) >> 2, tp = (unsigned)lane & 3u, tblk = ((unsigned)lane >> 4) & 1u;
    const unsigned tvb = 2048u * hh + 64u * tq + 8u * (tp & 1u), tvx = (2u * tblk + (tp >> 1)) ^ (2u * hh);
    const unsigned tv0 = tvb + 16u * tvx;
    const int NPH = 2 * NTL;
#define ATT_BOUNDARY(ph_) do { const int ph__ = (ph_); \
        if (ph__ + 1 < NPH) asm volatile("s_waitcnt vmcnt(2) lgkmcnt(0)\n\ts_barrier" ::: "memory"); else asm volatile("s_waitcnt vmcnt(0) lgkmcnt(0)\n\ts_barrier" ::: "memory"); \
        const int m__ = ph__ + 2; if (m__ < NPH) { if (m__ & 1) ATT_DMA_V(m__ >> 1, (m__ >> 1) & 1); else ATT_DMA_K(m__ >> 1, (m__ >> 1) & 1); } } while (0)
#define ATT_SB() __builtin_amdgcn_sched_barrier(0)
#define ATT_KADDR(m_, j_) ((((j_) & 1) ? (kr0 ^ 32u) : kr0) + 512u * (2 * (m_) + ((j_) >> 1)))
#define ATT_LDQ(m_) do { _Pragma("unroll") for (int j = 0; j < 4; ++j) qF[j] = *(const LAS bf16x8*)(Qb + ATT_KADDR(m_, j)); } while (0)
#define ATT_LDK(m_, h_) do { _Pragma("unroll") for (int j = 0; j < 4; ++j) kF[j] = *(const LAS bf16x8*)(Kb + ATT_KADDR(m_, j) + 8192 * (h_)); } while (0)
#define ATT_CHAIN() do { _Pragma("unroll") for (int r = 0; r < 16; ++r) p[r] = -mshift; _Pragma("unroll") for (int j = 0; j < 4; ++j) p = ATT_MFMA(kF[j], qF[j], p); } while (0)
#define ATT_X(t_) do { const int jb = (t_) - (NTL - 4); const LAS unsigned char* Kb = lds + LDS_K + ((t_) & 1) * SLOT; bf16x8 qF[4], kF[4]; f32x16 p; \
        ATT_LDQ(0); ATT_LDK(0, 0); ATT_SB(); \
        ATT_CHAIN(); ATT_SB(); ATT_LDK(0, 1); ATT_SB(); soft_half(p, pa1[0], pa1[1], l1, jb, wid, 0); ATT_SB(); \
        ATT_CHAIN(); ATT_SB(); ATT_LDQ(1); ATT_LDK(1, 0); ATT_SB(); soft_half(p, pa1[2], pa1[3], l1, jb, wid, 1); ATT_SB(); \
        ATT_CHAIN(); ATT_SB(); ATT_LDK(1, 1); ATT_SB(); soft_half(p, pa2[0], pa2[1], l2, jb, wid, 0); ATT_SB(); \
        ATT_CHAIN(); ATT_SB(); soft_half(p, pa2[2], pa2[3], l2, jb, wid, 1); ATT_SB(); } while (0)
#define ATT_VLOAD(buf, i) asm volatile("ds_read_b64_tr_b16 %0, %2 offset:%c4\n\tds_read_b64_tr_b16 %1, %3 offset:%c4" : "=&v"(vlo[buf]), "=&v"(vhi[buf]) : "v"(va0), "v"(va1), "i"(4096 * ((i) & 3) + 512 * ((i) >> 2)) : "memory")
#define ATT_Y(t_) do { const unsigned va0 = (unsigned)(uintptr_t)(lds + LDS_V + ((t_) & 1) * SLOT) + tv0, va1 = (unsigned)(uintptr_t)(lds + LDS_V + ((t_) & 1) * SLOT) + (tv0 ^ 16u) + 256u; \
        s16x4 vlo[3], vhi[3]; ATT_VLOAD(0, 0); ATT_VLOAD(1, 1); \
        _Pragma("unroll") for (int i = 0; i < 16; ++i) { if (i + 2 < 16) ATT_VLOAD((i + 2) % 3, i + 2); \
            if (i + 2 < 16) asm volatile("s_waitcnt lgkmcnt(4)" : "+v"(vlo[i % 3]), "+v"(vhi[i % 3]) :: "memory"); \
            else if (i + 1 < 16) asm volatile("s_waitcnt lgkmcnt(2)" : "+v"(vlo[i % 3]), "+v"(vhi[i % 3]) :: "memory"); \
            else asm volatile("s_waitcnt lgkmcnt(0)" : "+v"(vlo[i % 3]), "+v"(vhi[i % 3]) :: "memory"); \
            const bf16x8 vf = __builtin_shufflevector(vlo[i % 3], vhi[i % 3], 0, 1, 2, 3, 4, 5, 6, 7); \
            o1[i >> 2] = ATT_MFMA(pa1[i & 3], vf, o1[i >> 2]); o2[i >> 2] = ATT_MFMA(pa2[i & 3], vf, o2[i >> 2]); } } while (0)
    if (wid < 4) {
        for (int t = 0; t < NTL; ++t) {
            const bool on = (t - (NTL - 4)) <= (wid >> 1);
            bf16x8 pa1[4], pa2[4];
            ATT_BOUNDARY(2 * t);
            if (on) { __builtin_amdgcn_s_setprio(3); ATT_X(t); __builtin_amdgcn_s_setprio(0); }
            ATT_BOUNDARY(2 * t + 1);
            if (on) ATT_Y(t);
        }
        ATT_BOUNDARY(NPH);
    } else {
        ATT_BOUNDARY(0);
        for (int t = 0; t < NTL; ++t) {
            const bool on = (t - (NTL - 4)) <= (wid >> 1);
            bf16x8 pa1[4], pa2[4];
            ATT_BOUNDARY(2 * t + 1);
            if (on) { __builtin_amdgcn_s_setprio(3); ATT_X(t); __builtin_amdgcn_s_setprio(0); }
            ATT_BOUNDARY(2 * t + 2);
            if (on) ATT_Y(t);
        }
    }
#undef ATT_BOUNDARY
#undef ATT_X
#undef ATT_Y
#undef ATT_KADDR
#undef ATT_LDQ
#undef ATT_LDK
#undef ATT_CHAIN
#undef ATT_VLOAD
#undef ATT_SB
    { auto rr = __builtin_amdgcn_permlane32_swap(__float_as_uint(l1), __float_as_uint(l1), false, false); l1 = __uint_as_float(rr[0]) + __uint_as_float(rr[1]); }
    { auto rr = __builtin_amdgcn_permlane32_swap(__float_as_uint(l2), __float_as_uint(l2), false, false); l2 = __uint_as_float(rr[0]) + __uint_as_float(rr[1]); }
    int lane_e = (int)lane_id(); asm volatile("" : "+v"(lane_e));
    const int hh_e = lane_e >> 5, r32_e = lane_e & 31;
    LAS float* lw = (LAS float*)(lds + LDS_L) + wid * 64;
    if (hh_e == 0) { lw[r32_e] = 1.0f / l1; lw[32 + r32_e] = lam / l2; }
    asm volatile("s_waitcnt lgkmcnt(0)" ::: "memory");
    float ssq[16];
#pragma unroll
    for (int r = 0; r < 16; ++r) { const int qr = (r & 3) + 8 * (r >> 2) + 4 * hh_e; const float i1 = lw[qr], i2 = lw[32 + qr]; float s = 0.f;
#pragma unroll
        for (int c = 0; c < 4; ++c) { const float o = o1[c][r] * i1 - o2[c][r] * i2; o1[c][r] = o; s += o * o; }
        ssq[r] = s; }
#pragma unroll
    for (int r = 0; r < 16; ++r) { float s = ssq[r]; s += swz_xor<1>(s); s += swz_xor<2>(s); s += swz_xor<4>(s); s += swz_xor<8>(s); s += swz_xor<16>(s); ssq[r] = 0.8f / sqrtf(s * (1.0f / 128.0f) + EPS); }
    LAS bf16* stg = (LAS bf16*)(lds + LDS_STG) + wid * 4096;
    float gn[4];
#pragma unroll
    for (int c = 0; c < 4; ++c) gn[c] = gain[32 * c + r32_e];
#pragma unroll
    for (int r = 0; r < 16; ++r) { const int qr = (r & 3) + 8 * (r >> 2) + 4 * hh_e;
#pragma unroll
        for (int c = 0; c < 4; ++c) stg[qr * 128 + 32 * c + r32_e] = (bf16)f2bf(o1[c][r] * ssq[r] * gn[c]); }
    asm volatile("s_waitcnt lgkmcnt(0)" ::: "memory");
    bf16* og = (bf16*)(ws + WS_ODA) + ((size_t)(bh >> 2) * 4096 + qb * 256 + wid * 32) * 512 + 128 * (bh & 3);
#pragma unroll
    for (int i = 0; i < 8; ++i) { const int row = i * 4 + (lane_e >> 4), chk = lane_e & 15; *(v4u*)(og + (size_t)row * 512 + chk * 8) = *(const LAS v4u*)(stg + row * 128 + chk * 8); }
    asm volatile("s_waitcnt vmcnt(0) lgkmcnt(0)\n\ts_barrier" ::: "memory");
#undef ATT_DMA_K
#undef ATT_DMA_V
}
__device__ __forceinline__ void attn_phase(unsigned char* ws, LAS unsigned char* lds, int vcu, int G, const float* gain) {
    const float* sm = (const float*)(ws + WS_SMALL);
    const float lam = __uint_as_float(__builtin_amdgcn_readfirstlane(__float_as_uint(sm[512]))), mshift = __uint_as_float(__builtin_amdgcn_readfirstlane(__float_as_uint(sm[513])));
    for (int p = vcu; p < 256; p += G) {
        const int bh = p >> 3, s = p & 7;
        for (int uu = 0; uu < 2; ++uu) attn_unit(bh, uu ? s : 15 - s, ws, lds, mshift, lam, gain);
    }
}
}

namespace hg {
constexpr int L_HQ = 0, L_HF = 16384, L_HI = 32768, L_HOG = 49152, L_QD = 65536, L_ST = 81920, L_O = 114688, L_PS = 147456;
#define HG_MFMA(a, b, c) __builtin_amdgcn_mfma_f32_32x32x16_bf16((a), (b), (c), 0, 0, 0)
__device__ __forceinline__ void dma16k(const unsigned char* g, LAS unsigned char* l, int wid, int lane) {
    __builtin_amdgcn_global_load_lds((const unsigned*)(g + wid * 1024 + lane * 16), (LAS unsigned*)(l + wid * 1024), 16, 0, 0);
    __builtin_amdgcn_global_load_lds((const unsigned*)(g + 8192 + wid * 1024 + lane * 16), (LAS unsigned*)(l + 8192 + wid * 1024), 16, 0, 0);
}
__device__ __forceinline__ bf16x8 trfrag(const LAS unsigned char* base, unsigned tv0, unsigned tv1, int c, int ks) {
    const s16x4 lo = att::vtr(base + tv0 + 4096 * ks + 512 * c), hi = att::vtr(base + tv1 + 4096 * ks + 512 * c);
    return __builtin_shufflevector(lo, hi, 0, 1, 2, 3, 4, 5, 6, 7);
}
__device__ __forceinline__ void tr3_asm(bf16x8& f0, bf16x8& f1, bf16x8& f2, unsigned a00, unsigned a01, unsigned a10, unsigned a11, unsigned a20, unsigned a21) {
    s16x4 l0, h0, l1, h1, l2, h2;
    asm volatile("ds_read_b64_tr_b16 %0, %6\n\tds_read_b64_tr_b16 %1, %7\n\tds_read_b64_tr_b16 %2, %8\n\tds_read_b64_tr_b16 %3, %9\n\tds_read_b64_tr_b16 %4, %10\n\tds_read_b64_tr_b16 %5, %11\n\ts_waitcnt lgkmcnt(0)"
                 : "=&v"(l0), "=&v"(h0), "=&v"(l1), "=&v"(h1), "=&v"(l2), "=&v"(h2) : "v"(a00), "v"(a01), "v"(a10), "v"(a11), "v"(a20), "v"(a21) : "memory");
    f0 = __builtin_shufflevector(l0, h0, 0, 1, 2, 3, 4, 5, 6, 7); f1 = __builtin_shufflevector(l1, h1, 0, 1, 2, 3, 4, 5, 6, 7); f2 = __builtin_shufflevector(l2, h2, 0, 1, 2, 3, 4, 5, 6, 7);
}
__device__ __forceinline__ void tr2_asm(bf16x8& f0, bf16x8& f1, unsigned a00, unsigned a01, unsigned a10, unsigned a11) {
    s16x4 l0, h0, l1, h1;
    asm volatile("ds_read_b64_tr_b16 %0, %4\n\tds_read_b64_tr_b16 %1, %5\n\tds_read_b64_tr_b16 %2, %6\n\tds_read_b64_tr_b16 %3, %7\n\ts_waitcnt lgkmcnt(0)"
                 : "=&v"(l0), "=&v"(h0), "=&v"(l1), "=&v"(h1) : "v"(a00), "v"(a01), "v"(a10), "v"(a11) : "memory");
    f0 = __builtin_shufflevector(l0, h0, 0, 1, 2, 3, 4, 5, 6, 7); f1 = __builtin_shufflevector(l1, h1, 0, 1, 2, 3, 4, 5, 6, 7);
}
__device__ __forceinline__ bf16x8 rowfrag(const LAS unsigned char* base, unsigned kr0, unsigned kr1, int rblk, int s) {
    return *(const LAS bf16x8*)(base + 8192 * rblk + ((s & 1) ? kr1 : kr0) + 512 * (s >> 1));
}
__device__ __forceinline__ bf16x8 pack_lo(const f32x16& p) { v4u w; w.x = cvtpk(p[0], p[1]); w.y = cvtpk(p[2], p[3]); w.z = cvtpk(p[4], p[5]); w.w = cvtpk(p[6], p[7]); return __builtin_bit_cast(bf16x8, w); }
__device__ __forceinline__ bf16x8 pack_hi(const f32x16& p) { v4u w; w.x = cvtpk(p[8], p[9]); w.y = cvtpk(p[10], p[11]); w.z = cvtpk(p[12], p[13]); w.w = cvtpk(p[14], p[15]); return __builtin_bit_cast(bf16x8, w); }

__device__ __forceinline__ void b1_group(int bh, int s8, unsigned char* ws, LAS unsigned char* lds) {
    int tid = tid_x(); asm volatile("" : "+v"(tid));
    const int lane = tid & 63, wid = __builtin_amdgcn_readfirstlane(tid >> 6), r32 = lane & 31, hh = lane >> 5;
    const int k2 = lane;
    const float lb0 = ((const float*)(ws + WS_SMALL))[128 * (bh & 3) + 2 * k2], lb1 = ((const float*)(ws + WS_SMALL))[128 * (bh & 3) + 2 * k2 + 1];
    LAS float* ps = (LAS float*)(lds + L_PS);
    const unsigned tq = ((unsigned)lane & 15u) >> 2, tp = (unsigned)lane & 3u, tblk = ((unsigned)lane >> 4) & 1u;
    const unsigned tvb = 2048u * hh + 64u * tq + 8u * (tp & 1u), tvx = (2u * tblk + (tp >> 1)) ^ (2u * hh);
    const unsigned tv0 = tvb + 16u * tvx, tv1 = tvb + 256u + 16u * (tvx ^ 1u);
    const int kb = wid >> 1, vb0 = 2 * (wid & 1);
    { const int item = bh * 64 + s8; dma16k(ws + WS_HF + ((size_t)item << 14), lds, wid, lane); dma16k(ws + WS_HI + ((size_t)item << 14), lds + 16384, wid, lane); }
    for (int j = 0; j < 8; ++j) {
        const int item = bh * 64 + s8 + 8 * j; LAS unsigned char* B = lds + (j & 1) * 32768;
        if (j + 1 < 8) { LAS unsigned char* Bn = lds + ((j + 1) & 1) * 32768; dma16k(ws + WS_HF + ((size_t)(item + 8) << 14), Bn, wid, lane); dma16k(ws + WS_HI + ((size_t)(item + 8) << 14), Bn + 16384, wid, lane);
            asm volatile("s_waitcnt vmcnt(4)\n\ts_barrier" ::: "memory"); }
        else asm volatile("s_waitcnt vmcnt(0)\n\ts_barrier" ::: "memory");
        float f0[8], f1[8], c0[8], c1[8]; float r0 = 0.f, r1 = 0.f;
#pragma unroll
        for (int i = 0; i < 8; ++i) { const unsigned w = *(const LAS unsigned*)(B + img_off_a(8 * wid + i, 2 * k2));
            const float h0 = __uint_as_float(w << 16), h1 = __uint_as_float(w & 0xffff0000u);
            f0[i] = lb0 + (1.0f - lb0) * rcpf_(1.0f + __expf(-h0)); f1[i] = lb1 + (1.0f - lb1) * rcpf_(1.0f + __expf(-h1));
            r0 += __logf(f0[i]); r1 += __logf(f1[i]); c0[i] = r0; c1[i] = r1; }
        *(LAS f32x2*)(ps + wid * 128 + 2 * k2) = (f32x2){r0, r1};
        asm volatile("s_waitcnt lgkmcnt(0)\n\ts_barrier" ::: "memory");
        float base0 = 0.f, base1 = 0.f, tot0 = 0.f, tot1 = 0.f;
#pragma unroll
        for (int w = 0; w < 8; ++w) { const f32x2 p = *(const LAS f32x2*)(ps + w * 128 + 2 * k2); if (w < wid) { base0 += p[0]; base1 += p[1]; } tot0 += p[0]; tot1 += p[1]; }
#pragma unroll
        for (int i = 0; i < 8; ++i) { const float b0 = base0 + c0[i], b1 = base1 + c1[i];
            *(LAS unsigned*)(B + img_off_a(8 * wid + i, 2 * k2)) = cvtpk((1.0f - f0[i]) * __expf(tot0 - b0), (1.0f - f1[i]) * __expf(tot1 - b1)); }
        if (wid == 0) *(f32x2*)((float*)(ws + WS_DECAY) + (size_t)item * 128 + 2 * k2) = (f32x2){__expf(tot0), __expf(tot1)};
        asm volatile("s_waitcnt lgkmcnt(0)\n\ts_barrier" ::: "memory");
        f32x16 a0, a1;
#pragma unroll
        for (int r = 0; r < 16; ++r) { a0[r] = 0.f; a1[r] = 0.f; }
        const unsigned bA = (unsigned)(uintptr_t)B, bI = bA + 16384u;
#pragma unroll
        for (int ks = 0; ks < 4; ++ks) { bf16x8 A, B0, B1;
            tr3_asm(A, B0, B1, bA + tv0 + 4096 * ks + 512 * kb, bA + tv1 + 4096 * ks + 512 * kb, bI + tv0 + 4096 * ks + 512 * vb0, bI + tv1 + 4096 * ks + 512 * vb0, bI + tv0 + 4096 * ks + 512 * (vb0 + 1), bI + tv1 + 4096 * ks + 512 * (vb0 + 1));
            a0 = HG_MFMA(A, B0, a0); a1 = HG_MFMA(A, B1, a1); }
        unsigned char* dst = ws + WS_DST + ((size_t)item << 15);
#pragma unroll
        for (int g = 0; g < 4; ++g) { const unsigned k0 = 32u * kb + 8u * g + 4u * hh;
            *(v2u*)(dst + off_a(32u * vb0 + r32, k0 >> 3) + (k0 & 7u) * 2u) = (v2u){cvtpk(a0[4 * g], a0[4 * g + 1]), cvtpk(a0[4 * g + 2], a0[4 * g + 3])};
            *(v2u*)(dst + off_a(32u * (vb0 + 1) + r32, k0 >> 3) + (k0 & 7u) * 2u) = (v2u){cvtpk(a1[4 * g], a1[4 * g + 1]), cvtpk(a1[4 * g + 2], a1[4 * g + 3])}; }
        asm volatile("s_waitcnt lgkmcnt(0)\n\ts_barrier" ::: "memory");
    }
}

__device__ __forceinline__ void scan_slice(unsigned char* ws, int bh, int e) {
    const unsigned pos = 8u * (unsigned)e;
    const unsigned row = 8u * (pos >> 11) + ((pos >> 6) & 7u), ch = 4u * ((pos >> 9) & 3u) + (((pos >> 4) & 3u) ^ ((row >> 2) & 3u)), k0 = 8u * ch + 4u * ((pos >> 3) & 1u);
    unsigned char* img = ws + WS_DST + ((size_t)bh << 21) + pos; const float* dec = (const float*)(ws + WS_DECAY) + (size_t)bh * 64 * 128 + k0;
    float S0 = 0.f, S1 = 0.f, S2 = 0.f, S3 = 0.f;
    for (int c0 = 0; c0 < 64; c0 += 8) {
        v2u d[8]; f32x4 dc[8];
#pragma unroll
        for (int j = 0; j < 8; ++j) { d[j] = *(const v2u*)(img + ((size_t)(c0 + j) << 15)); dc[j] = *(const f32x4*)(dec + (c0 + j) * 128); }
#pragma unroll
        for (int j = 0; j < 8; ++j) {
            *(v2u*)(img + ((size_t)(c0 + j) << 15)) = (v2u){cvtpk(S0, S1), cvtpk(S2, S3)};
            S0 = dc[j][0] * S0 + __uint_as_float(d[j].x << 16); S1 = dc[j][1] * S1 + __uint_as_float(d[j].x & 0xffff0000u);
            S2 = dc[j][2] * S2 + __uint_as_float(d[j].y << 16); S3 = dc[j][3] * S3 + __uint_as_float(d[j].y & 0xffff0000u);
        }
    }
}
__device__ __forceinline__ void group_barrier(unsigned* w, unsigned target) {
    asm volatile("s_waitcnt vmcnt(0)" ::: "memory");
    __syncthreads();
    if (tid_x() == 0) {
        __builtin_amdgcn_fence(__ATOMIC_RELEASE, "agent");
        asm volatile("s_waitcnt vmcnt(0)" ::: "memory");
        __hip_atomic_fetch_add(w, 1u, __ATOMIC_RELAXED, __HIP_MEMORY_SCOPE_AGENT);
        unsigned sp = 0;
        while (__hip_atomic_load(w, __ATOMIC_RELAXED, __HIP_MEMORY_SCOPE_AGENT) < target) { __builtin_amdgcn_s_sleep(2); if (++sp > (1u << 22)) break; }
        __builtin_amdgcn_fence(__ATOMIC_ACQUIRE, "agent");
        asm volatile("s_waitcnt vmcnt(0)" ::: "memory");
    }
    __syncthreads();
}

__device__ __forceinline__ void b3_group(int bh, int s8, unsigned char* ws, LAS unsigned char* lds, const float* gain) {
    constexpr int B_HQ = 0, B_HF = 16384, B_QD = 32768, B_HI = 49152, B_ST = 81920, B_O = 0;
    int tid = tid_x(); asm volatile("" : "+v"(tid));
    const int lane = tid & 63, wid = __builtin_amdgcn_readfirstlane(tid >> 6), r32 = lane & 31, hh = lane >> 5;
    const int k2 = lane;
    const float lb0 = ((const float*)(ws + WS_SMALL))[128 * (bh & 3) + 2 * k2], lb1 = ((const float*)(ws + WS_SMALL))[128 * (bh & 3) + 2 * k2 + 1];
    LAS float* ps = (LAS float*)(lds + L_PS);
    const unsigned krb = 2048u * ((unsigned)r32 >> 3) + 64u * ((unsigned)r32 & 7u), krs = ((unsigned)r32 >> 2) & 3u;
    const unsigned kr0 = krb + 16u * (hh ^ krs), kr1 = krb + 16u * ((2u + hh) ^ krs);
    const unsigned tq = ((unsigned)lane & 15u) >> 2, tp = (unsigned)lane & 3u, tblk = ((unsigned)lane >> 4) & 1u;
    const unsigned tvb = 2048u * hh + 64u * tq + 8u * (tp & 1u), tvx = (2u * tblk + (tp >> 1)) ^ (2u * hh);
    const unsigned tv0 = tvb + 16u * tvx, tv1 = tvb + 256u + 16u * (tvx ^ 1u);
    const int tb = wid >> 2, vb = wid & 3;
    const int erow = tid >> 3, seg = tid & 7;
    const f32x4 n0 = ((const f32x4*)(gain + 16 * seg))[0], n1 = ((const f32x4*)(gain + 16 * seg))[1], n2 = ((const f32x4*)(gain + 16 * seg))[2], n3 = ((const f32x4*)(gain + 16 * seg))[3];
    { const int item = bh * 64 + s8;
      dma16k(ws + WS_HI + ((size_t)item << 14), lds + B_HI, wid, lane);
      dma16k(ws + WS_DST + ((size_t)item << 15), lds + B_ST, wid, lane); dma16k(ws + WS_DST + ((size_t)item << 15) + 16384, lds + B_ST + 16384, wid, lane); }
    for (int j = 0; j < 8; ++j) {
        const int item = bh * 64 + s8 + 8 * j, bb = j & 1;
        dma16k(ws + WS_HQ + ((size_t)item << 14), lds + B_HQ, wid, lane);
        dma16k(ws + WS_HF + ((size_t)item << 14), lds + B_HF, wid, lane);
        if (j + 1 < 8) { const int nb = bb ^ 1;
            dma16k(ws + WS_HI + ((size_t)(item + 8) << 14), lds + B_HI + nb * 16384, wid, lane);
            dma16k(ws + WS_DST + ((size_t)(item + 8) << 15), lds + B_ST + nb * 32768, wid, lane); dma16k(ws + WS_DST + ((size_t)(item + 8) << 15) + 16384, lds + B_ST + nb * 32768 + 16384, wid, lane); }
        const unsigned char* hogp = ws + WS_HOG + ((size_t)item << 14);
        const v4u g0 = *(const v4u*)(hogp + off_a((unsigned)erow, 2u * seg)), g1 = *(const v4u*)(hogp + off_a((unsigned)erow, 2u * seg + 1u));
        if (j + 1 < 8) asm volatile("s_waitcnt vmcnt(8)\n\ts_barrier" ::: "memory"); else asm volatile("s_waitcnt vmcnt(2)\n\ts_barrier" ::: "memory");
        {
            float f0[8], f1[8], c0[8], c1[8]; float r0 = 0.f, r1 = 0.f;
#pragma unroll
            for (int i = 0; i < 8; ++i) { const unsigned w = *(const LAS unsigned*)(lds + B_HF + img_off_a(8 * wid + i, 2 * k2));
                const float h0 = __uint_as_float(w << 16), h1 = __uint_as_float(w & 0xffff0000u);
                f0[i] = lb0 + (1.0f - lb0) * rcpf_(1.0f + __expf(-h0)); f1[i] = lb1 + (1.0f - lb1) * rcpf_(1.0f + __expf(-h1));
                r0 += __logf(f0[i]); r1 += __logf(f1[i]); c0[i] = r0; c1[i] = r1; }
            *(LAS f32x2*)(ps + wid * 128 + 2 * k2) = (f32x2){r0, r1};
            asm volatile("s_waitcnt lgkmcnt(0)\n\ts_barrier" ::: "memory");
            float base0 = 0.f, base1 = 0.f, ref0 = 0.f, ref1 = 0.f;
#pragma unroll
            for (int w = 0; w < 7; ++w) { const f32x2 p = *(const LAS f32x2*)(ps + w * 128 + 2 * k2); if (w < wid) { base0 += p[0]; base1 += p[1]; } if (w < 4) { ref0 += p[0]; ref1 += p[1]; } }
#pragma unroll
            for (int i = 0; i < 8; ++i) { const unsigned row = 8u * wid + i; const float b0 = base0 + c0[i], b1 = base1 + c1[i];
                const unsigned qw = *(const LAS unsigned*)(lds + B_HQ + img_off_a(row, 2 * k2));
                const float q0 = __uint_as_float(qw << 16), q1 = __uint_as_float(qw & 0xffff0000u);
                *(LAS unsigned*)(lds + B_HQ + img_off_a(row, 2 * k2)) = cvtpk(q0 * __expf(b0 - ref0), q1 * __expf(b1 - ref1));
                *(LAS unsigned*)(lds + B_QD + img_off_a(row, 2 * k2)) = cvtpk(q0 * __expf(b0), q1 * __expf(b1));
                *(LAS unsigned*)(lds + B_HF + img_off_a(kappa(row), 2 * k2)) = cvtpk((1.0f - f0[i]) * __expf(ref0 - b0), (1.0f - f1[i]) * __expf(ref1 - b1)); }
        }
        asm volatile("s_waitcnt lgkmcnt(0)\n\ts_barrier" ::: "memory");
        f32x16 o;
#pragma unroll
        for (int r = 0; r < 16; ++r) o[r] = 0.f;
        const int tcol = 32 * tb + r32;
        const unsigned bI = (unsigned)(uintptr_t)(lds + B_HI + bb * 16384);
        {
            f32x16 p;
#pragma unroll
            for (int r = 0; r < 16; ++r) p[r] = 0.f;
#pragma unroll
            for (int sI = 0; sI < 8; ++sI) p = HG_MFMA(rowfrag(lds + B_HF, kr0, kr1, 0, sI), rowfrag(lds + B_HQ, kr0, kr1, tb, sI), p);
#pragma unroll
            for (int r = 0; r < 16; ++r) { const int srel = (r & 7) + 8 * hh + 16 * (r >> 3); if (srel > tcol) p[r] = 0.f; }
            bf16x8 v0, v1; tr2_asm(v0, v1, bI + tv0 + 512 * vb, bI + tv1 + 512 * vb, bI + tv0 + 4096 + 512 * vb, bI + tv1 + 4096 + 512 * vb);
            o = HG_MFMA(pack_lo(p), v0, o); o = HG_MFMA(pack_hi(p), v1, o);
        }
        if (tb == 1) {
            f32x16 p;
#pragma unroll
            for (int r = 0; r < 16; ++r) p[r] = 0.f;
#pragma unroll
            for (int sI = 0; sI < 8; ++sI) p = HG_MFMA(rowfrag(lds + B_HF, kr0, kr1, 1, sI), rowfrag(lds + B_HQ, kr0, kr1, 1, sI), p);
#pragma unroll
            for (int r = 0; r < 16; ++r) { const int srel = 32 + (r & 7) + 8 * hh + 16 * (r >> 3); if (srel > tcol) p[r] = 0.f; }
            bf16x8 v0, v1; tr2_asm(v0, v1, bI + tv0 + 8192 + 512 * vb, bI + tv1 + 8192 + 512 * vb, bI + tv0 + 12288 + 512 * vb, bI + tv1 + 12288 + 512 * vb);
            o = HG_MFMA(pack_lo(p), v0, o); o = HG_MFMA(pack_hi(p), v1, o);
        }
#pragma unroll
        for (int sI = 0; sI < 8; ++sI) o = HG_MFMA(rowfrag(lds + B_QD, kr0, kr1, tb, sI), rowfrag(lds + B_ST + bb * 32768, kr0, kr1, vb, sI), o);
        asm volatile("s_waitcnt lgkmcnt(0)\n\ts_barrier" ::: "memory");
        LAS float* O = (LAS float*)(lds + B_O);
#pragma unroll
        for (int r = 0; r < 16; ++r) O[(32 * tb + (r & 3) + 8 * (r >> 2) + 4 * hh) * 128 + 32 * vb + r32] = o[r];
        asm volatile("s_waitcnt lgkmcnt(0)\n\ts_barrier" ::: "memory");
        {
            const LAS f32x4* op = (const LAS f32x4*)(O + erow * 128 + 16 * seg);
            f32x4 v0 = op[0], v1 = op[1], v2 = op[2], v3 = op[3];
            float sq = 0.f;
#pragma unroll
            for (int e = 0; e < 4; ++e) sq += v0[e] * v0[e] + v1[e] * v1[e] + v2[e] * v2[e] + v3[e] * v3[e];
            sq += swz_xor<1>(sq); sq += swz_xor<2>(sq); sq += swz_xor<4>(sq);
            const float rstd = __builtin_amdgcn_rsqf(sq * (1.0f / 128.0f) + EPS);
            float y[16];
#pragma unroll
            for (int e = 0; e < 4; ++e) { y[e] = v0[e] * n0[e]; y[4 + e] = v1[e] * n1[e]; y[8 + e] = v2[e] * n2[e]; y[12 + e] = v3[e] * n3[e]; }
#pragma unroll
            for (int e = 0; e < 4; ++e) { const float a = __uint_as_float(g0[e] << 16), b = __uint_as_float(g0[e] & 0xffff0000u), c = __uint_as_float(g1[e] << 16), d = __uint_as_float(g1[e] & 0xffff0000u);
                y[2 * e] *= rstd * a * rcpf_(1.0f + __expf(-a)); y[2 * e + 1] *= rstd * b * rcpf_(1.0f + __expf(-b)); y[8 + 2 * e] *= rstd * c * rcpf_(1.0f + __expf(-c)); y[9 + 2 * e] *= rstd * d * rcpf_(1.0f + __expf(-d)); }
            const int c = item & 63;
            bf16* dst = (bf16*)(ws + WS_OHG) + ((size_t)(bh >> 2) * 4096 + 64 * c + erow) * 512 + 128 * (bh & 3) + 16 * seg;
            v4u w0, w1;
            w0.x = cvtpk(y[0], y[1]); w0.y = cvtpk(y[2], y[3]); w0.z = cvtpk(y[4], y[5]); w0.w = cvtpk(y[6], y[7]);
            w1.x = cvtpk(y[8], y[9]); w1.y = cvtpk(y[10], y[11]); w1.z = cvtpk(y[12], y[13]); w1.w = cvtpk(y[14], y[15]);
            *(v4u*)dst = w0; *(v4u*)(dst + 8) = w1;
        }
        asm volatile("s_waitcnt lgkmcnt(0)\n\ts_barrier" ::: "memory");
    }
}
}

__global__ void __launch_bounds__(NWAVES * 64, 2) mega(Args args) {
    LAS unsigned char* lds = (LAS unsigned char*)lds_raw;
    volatile LAS unsigned* MISC = (volatile LAS unsigned*)(lds + MISC_OFF);
    { const int t0_ = threadIdx.x; if ((t0_ & 63) == 0) *(volatile LAS int*)(lds + MISC_OFF + 256 + 4 * ((unsigned)__builtin_amdgcn_s_getreg((5 << 11) | 4) & 63u)) = t0_ >> 6; if (t0_ < 64) MISC[t0_] = 0u; }
    __syncthreads();
    const int wave = wave_idx();
    const int G = gridDim.x; const int bx = blockIdx.x; const int vcu = (G % 8 == 0) ? (bx % 8) * (G / 8) + bx / 8 : bx;
    unsigned char* ws = args.ws;
    const int lo = args.ph_lo, hi = args.ph_hi;
    XcdBarrier bar; bar.bar = (unsigned*)(ws + WS_CTL) + CW_BAR + args.li * XCD_BAR_WORDS; bar.x = 0; bar.st = nullptr;
    if (hi - lo > 1) bar = xcd_barrier_post((unsigned*)(ws + WS_CTL) + CW_BAR + args.li * XCD_BAR_WORDS, MISC + 8);
#define IN(k) (lo <= (k) && (k) < hi)
#define BOTH(k) (IN(k) && IN((k) + 1))
    if (IN(0)) { p0_prologue(args, lds, vcu, G, wave, (int)lane_id()); if (BOTH(0)) xcd_barrier(bar); }
    if (IN(1)) {
        pg8::DenseOrder S; S.init(ws + WS_H, ws + WS_WIN, NT, NCOLS, DM, G, bx);
        EpiProj E{ws, (bf16*)args.out, args.in[5], args.in[6]};
        pg8::gemm_phase<EpiProj, pg8::DenseOrder, true>(lds + RING_OFF, DM, S, E);
        if (BOTH(1)) xcd_barrier(bar);
    }
    if (IN(2)) {
        const int bh = vcu >> 3, s8 = vcu & 7; unsigned* gw = (unsigned*)(ws + WS_CTL) + CW_GRP + bh * 64;
        if (G != 256) { if (tid_x() == 0) __hip_atomic_store((unsigned*)(ws + WS_CTL) + CW_BAR + XB_TMO, 0x7f0u, __ATOMIC_RELAXED, __HIP_MEMORY_SCOPE_AGENT); }
        if (bh & 1) att::attn_phase(ws, lds, vcu, G, args.in[8]);
        w13_convert(args, lds, vcu, G, wave, (int)lane_id()); __syncthreads();
        hg::b1_group(bh, s8, ws, lds);
        hg::group_barrier(gw, 8u);
        hg::scan_slice(ws, bh, s8 * 512 + tid_x());
        hg::group_barrier(gw, 16u);
        hg::b3_group(bh, s8, ws, lds, args.in[4]);
        if (!(bh & 1)) att::attn_phase(ws, lds, vcu, G, args.in[8]);
        if (BOTH(2)) xcd_barrier(bar);
    }
    if (IN(5)) {
        BranchOrder S; S.d.init(ws + WS_OHG, ws + WS_WHG, NT, DM, 512, G, bx); S.A2 = (const char*)(ws + WS_ODA); S.B2 = (const char*)(ws + WS_WDA);
        EpiBranch E{(const bf16*)args.out, (bf16*)(ws + WS_MIXED)};
        pg8::gemm_phase<EpiBranch, BranchOrder, true>(lds + RING_OFF, 512, S, E);
        if (BOTH(5)) xcd_barrier(bar);
    }
    if (IN(6)) {
        pg8::DenseOrder S; S.init(ws + WS_MIXED, ws + WS_WOUT, NT, DM, DM, G, bx);
        EpiOut E{args.in[0], (bf16*)(ws + WS_X1B)};
        pg8::gemm_phase<EpiOut, pg8::DenseOrder, true>(lds + RING_OFF, DM, S, E);
        if (BOTH(6)) xcd_barrier(bar);
    }
    if (IN(7)) { router_phase(args, lds, G, wave, (int)lane_id()); if (BOTH(7)) xcd_barrier(bar); }
    if (IN(8)) {
        moe_sched_setup(args, lds);
        const LAS int* pref = (const LAS int*)(lds + SCHED_OFF); const LAS int* cnt = pref + 80;
        MoeOrderT<1> S{pref, cnt, (const v2u*)(ws + WS_ROWTOK), (const char*)(ws + WS_XN), (const char*)(ws + WS_W13T), DM / 2, (size_t)DM * DM, 1, 0, 64, 4, G, vcu};
        EpiUp E{pref, cnt, ws + WS_HID};
        pg8::gemm_phase<EpiUp, MoeOrderT<1>, true, true, 122>(lds + RING_OFF, DM / 2, S, E);
        if (BOTH(8)) xcd_barrier(bar);
    }
    if (IN(9)) {
        moe_sched_setup(args, lds);
        const LAS int* pref = (const LAS int*)(lds + SCHED_OFF); const LAS int* cnt = pref + 80;
        MoeOrderT<0> S{pref, cnt, (const v2u*)(ws + WS_ROWTOK), (const char*)(ws + WS_HID), (const char*)(ws + WS_W2T), DFF / 2, (size_t)DM * DFF, 0, 0, 64, 4, G, vcu};
        EpiDown E{pref, cnt, (bf16*)(ws + WS_YS)};
        pg8::gemm_phase<EpiDown, MoeOrderT<0>, true, true, 123>(lds + RING_OFF, DFF / 2, S, E);
        if (BOTH(9)) xcd_barrier(bar);
    }
    if (IN(10)) {
        moe_sched_setup(args, lds);
        const LAS int* pref = (const LAS int*)(lds + SCHED_OFF);
        float* out = args.out; const bf16* y = (const bf16*)(ws + WS_YS); const v2u* tp = (const v2u*)(ws + WS_TOKPOS); const bf16* x1b = (const bf16*)(ws + WS_X1B);
        for (int i = bx * 512 + tid_x(); i < NT * (DM / 8); i += G * 512) {
            const int t = i >> 7, c = (i & 127) * 8;
            const v2u p0 = tp[2 * (size_t)t], p1 = tp[2 * (size_t)t + 1];
            const size_t r0 = (size_t)(pref[p0.x >> 16] * 256 + (int)(p0.x & 0xffffu)), r1 = (size_t)(pref[p1.x >> 16] * 256 + (int)(p1.x & 0xffffu));
            const float w0 = __uint_as_float(p0.y), w1 = __uint_as_float(p1.y);
            f32x4* op = (f32x4*)(out + (size_t)t * DM + c);
            const v4u y0 = *(const v4u*)(y + r0 * DM + c), y1 = *(const v4u*)(y + r1 * DM + c), xb = *(const v4u*)(x1b + (size_t)t * DM + c);
            f32x4 a0, a1;
            a0[0] = __uint_as_float(xb.x << 16) + w0 * __uint_as_float(y0.x << 16) + w1 * __uint_as_float(y1.x << 16); a0[1] = __uint_as_float(xb.x & 0xffff0000u) + w0 * __uint_as_float(y0.x & 0xffff0000u) + w1 * __uint_as_float(y1.x & 0xffff0000u);
            a0[2] = __uint_as_float(xb.y << 16) + w0 * __uint_as_float(y0.y << 16) + w1 * __uint_as_float(y1.y << 16); a0[3] = __uint_as_float(xb.y & 0xffff0000u) + w0 * __uint_as_float(y0.y & 0xffff0000u) + w1 * __uint_as_float(y1.y & 0xffff0000u);
            a1[0] = __uint_as_float(xb.z << 16) + w0 * __uint_as_float(y0.z << 16) + w1 * __uint_as_float(y1.z << 16); a1[1] = __uint_as_float(xb.z & 0xffff0000u) + w0 * __uint_as_float(y0.z & 0xffff0000u) + w1 * __uint_as_float(y1.z & 0xffff0000u);
            a1[2] = __uint_as_float(xb.w << 16) + w0 * __uint_as_float(y0.w << 16) + w1 * __uint_as_float(y1.w << 16); a1[3] = __uint_as_float(xb.w & 0xffff0000u) + w0 * __uint_as_float(y0.w & 0xffff0000u) + w1 * __uint_as_float(y1.w & 0xffff0000u);
            op[0] = a0; op[1] = a1;
        }
    }
#undef IN
#undef BOTH
}

extern "C" void kernel_launch(void* const* d_in, const int* in_sizes, int n_in, void* d_out, int out_size, void* d_ws, size_t ws_size, hipStream_t stream) {
    static int grid = 0;
    if (grid == 0) {
        if (n_in != 20 || out_size != NT * DM || ws_size < WS_END) { fprintf(stderr, "kernel_launch: unexpected shapes (n_in %d out %d ws %zu)\n", n_in, out_size, ws_size); grid = -1; return; }
        int dev = 0, cus = 0, per_cu = 0;
        if (hipGetDevice(&dev) != hipSuccess || hipDeviceGetAttribute(&cus, hipDeviceAttributeMultiprocessorCount, dev) != hipSuccess) { grid = -1; return; }
        if (hipFuncSetAttribute((const void*)mega, hipFuncAttributeMaxDynamicSharedMemorySize, LDS_BYTES) != hipSuccess) { fprintf(stderr, "kernel_launch: hipFuncSetAttribute failed\n"); grid = -1; return; }
        if (hipOccupancyMaxActiveBlocksPerMultiprocessor(&per_cu, (const void*)mega, NWAVES * 64, LDS_BYTES) != hipSuccess || per_cu < 1) fprintf(stderr, "kernel_launch: occupancy query says %d\n", per_cu);
        (void)hipGetLastError();
        grid = cus;
    }
    if (grid < 0) return;
    (void)hipMemsetAsync((char*)d_ws + WS_CTL, 0, CTL_ZERO_BYTES, stream);
    Args a{};
    for (int i = 0; i < 20; ++i) a.in[i] = (const float*)d_in[i];
    a.out = (float*)d_out; a.ws = (unsigned char*)d_ws;
    unsigned char* ws = (unsigned char*)d_ws;
    a.ph_lo = 0; a.ph_hi = 11; a.li = 0; hipLaunchKernelGGL(mega, dim3(grid), dim3(NWAVES * 64), LDS_BYTES, stream, a);
}
```
